# Optimizing an MI355X kernel written in HIP

```python
import math
import jax, jax.numpy as jnp
from jax import lax
import numpy as np

D_MODEL = 1024
BATCH = 8
SEQ = 2048
DEPTH = 2

D_MIX = D_MODEL
GROUP_W = D_MIX // 4
CHUNK = 128

GM_HEADS = 4
GM_HEAD_DIM = GROUP_W // GM_HEADS

SSM_D_INNER = GROUP_W
SSM_HEAD_DIM = 64
SSM_HEADS = SSM_D_INNER // SSM_HEAD_DIM
SSM_GROUPS = 2
SSM_D_STATE = 128
SSM_CONV_K = 4
SSM_CONV_DIM = SSM_D_INNER + 2 * SSM_GROUPS * SSM_D_STATE
SSM_CHUNK = CHUNK

POOL_WINDOWS = (2, 4, 8, 16)
POOL_GROUPS = len(POOL_WINDOWS)
POOL_GROUP_DIM = GROUP_W // POOL_GROUPS

DA_HEADS = 4
DA_V_DIM = GROUP_W // DA_HEADS
DA_QK_DIM = DA_V_DIM // 2
Q_BLOCK = 128

D_FF = -(-8 * D_MODEL // (3 * 256)) * 256

GM_IN = 2 * GROUP_W
SSM_IN = SSM_D_INNER + SSM_CONV_DIM + SSM_HEADS
POOL_IN = GROUP_W
DA_IN = 3 * GROUP_W
D_IN = GM_IN + SSM_IN + POOL_IN + DA_IN
IN_SPLITS = (GM_IN, GM_IN + SSM_IN, GM_IN + SSM_IN + POOL_IN)

RMS_EPS = 1e-6

kernel_name = 'hybrid_parallel_heads_gmlp_ssd_pool_diffattn'


def rms_norm(x, w):
    xf = x.astype(jnp.float32)
    y = xf * lax.rsqrt(jnp.mean(xf * xf, axis=-1, keepdims=True) + RMS_EPS)
    return (y * w.astype(jnp.float32)).astype(x.dtype)


def gmlp_mixer(h, norm_w, ws, bs):
    b, L, _ = h.shape
    h = jax.nn.gelu(h)
    u, v = jnp.split(h, 2, axis=-1)
    v = rms_norm(v.reshape(b, L, GM_HEADS, GM_HEAD_DIM), norm_w)
    v = v.reshape(b, L // CHUNK, CHUNK, GM_HEADS, GM_HEAD_DIM)
    causal = jnp.tril(jnp.ones((CHUNK, CHUNK), dtype=bool))
    ws = jnp.where(causal[None], ws, jnp.zeros_like(ws))
    s = jnp.einsum('hts,bcshd->bcthd', ws, v) + bs.T[None, None, :, :, None]
    return u * s.reshape(b, L, GROUP_W)


def ssd_scan(x, dt, A, B, C):
    b, L, H, P = x.shape
    N = B.shape[-1]
    nc = L // SSM_CHUNK
    rep = H // SSM_GROUPS
    B = jnp.repeat(B, rep, axis=2).reshape(b, nc, SSM_CHUNK, H, N)
    C = jnp.repeat(C, rep, axis=2).reshape(b, nc, SSM_CHUNK, H, N)
    xdt = (x * dt[..., None]).reshape(b, nc, SSM_CHUNK, H, P)
    a_cs = jnp.cumsum((dt * A).reshape(b, nc, SSM_CHUNK, H), axis=2)
    causal = jnp.tril(jnp.ones((SSM_CHUNK, SSM_CHUNK), dtype=bool))[None, None, :, :, None]
    seg = a_cs[:, :, :, None, :] - a_cs[:, :, None, :, :]
    decay = jnp.exp(jnp.where(causal, seg, -jnp.inf))
    cb = jnp.einsum('bclhn,bcshn->bclsh', C, B)
    y_diag = jnp.einsum('bclsh,bcshp->bclhp', cb * decay, xdt)
    decay_to_end = jnp.exp(a_cs[:, :, -1:, :] - a_cs)
    states = jnp.einsum('bclhn,bclh,bclhp->bchpn', B, decay_to_end, xdt)
    chunk_decay = jnp.exp(a_cs[:, :, -1, :])

    def step(carry, inp):
        st, dec = inp
        return carry * dec[:, :, None, None] + st, carry

    init = jnp.zeros((b, H, P, N), dtype=states.dtype)
    _, prev_states = lax.scan(step, init, (jnp.moveaxis(states, 1, 0), jnp.moveaxis(chunk_decay, 1, 0)))
    prev_states = jnp.moveaxis(prev_states, 0, 1)
    y_off = jnp.einsum('bclhn,bchpn,bclh->bclhp', C, prev_states, jnp.exp(a_cs))
    return (y_diag + y_off).reshape(b, L, H, P)


def ssd_mixer(h, conv_w, conv_b, dt_bias, a_log, d_skip, norm_w):
    b, L, _ = h.shape
    z, xbc, dt = jnp.split(h, [SSM_D_INNER, SSM_D_INNER + SSM_CONV_DIM], axis=-1)
    xbc = lax.conv_general_dilated(
        xbc, conv_w.T[:, None, :], window_strides=(1,), padding=[(SSM_CONV_K - 1, 0)],
        dimension_numbers=('NWC', 'WIO', 'NWC'), feature_group_count=SSM_CONV_DIM)
    xbc = jax.nn.silu(xbc + conv_b)
    xs, Bm, Cm = jnp.split(xbc, [SSM_D_INNER, SSM_D_INNER + SSM_GROUPS * SSM_D_STATE], axis=-1)
    xs = xs.reshape(b, L, SSM_HEADS, SSM_HEAD_DIM).astype(jnp.float32)
    Bm = Bm.reshape(b, L, SSM_GROUPS, SSM_D_STATE).astype(jnp.float32)
    Cm = Cm.reshape(b, L, SSM_GROUPS, SSM_D_STATE).astype(jnp.float32)
    dt = jax.nn.softplus(dt.astype(jnp.float32) + dt_bias.astype(jnp.float32))
    A = -jnp.exp(a_log.astype(jnp.float32))
    y = ssd_scan(xs, dt, A, Bm, Cm) + d_skip.astype(jnp.float32)[:, None] * xs
    y = y.reshape(b, L, SSM_D_INNER) * jax.nn.silu(z.astype(jnp.float32))
    y = rms_norm(y.reshape(b, L, SSM_GROUPS, SSM_D_INNER // SSM_GROUPS),
                 norm_w.reshape(SSM_GROUPS, SSM_D_INNER // SSM_GROUPS))
    return y.reshape(b, L, SSM_D_INNER)


def pool_mixer(h, w, scale):
    b, L, _ = h.shape
    hf = h.astype(jnp.float32).reshape(b, L, POOL_GROUPS, POOL_GROUP_DIM)
    cs = jnp.concatenate([jnp.zeros((b, 1, POOL_GROUPS, POOL_GROUP_DIM), jnp.float32),
                          jnp.cumsum(hf, axis=1)], axis=1)
    hi = jnp.arange(1, L + 1)
    outs = []
    for g, win in enumerate(POOL_WINDOWS):
        lo = jnp.maximum(hi - win, 0)
        cs_g = cs[:, :, g]
        window_sum = cs_g[:, 1:] - jnp.take(cs_g, lo, axis=1)
        count = (hi - lo).astype(jnp.float32)[None, :, None]
        outs.append(window_sum / count - hf[:, :, g])
    p = jnp.stack(outs, axis=2)
    y = jnp.einsum('blgd,gde->blge', p, w.astype(jnp.float32)) * scale.astype(jnp.float32).reshape(POOL_GROUPS, POOL_GROUP_DIM)
    return y.reshape(b, L, GROUP_W)


def diff_attn_mixer(h, q_norm_w, k_norm_w, lq1, lk1, lq2, lk2, subln_w, layer_idx):
    b, L, _ = h.shape
    q, k, v = jnp.split(h, 3, axis=-1)
    q = rms_norm(q.reshape(b, L, DA_HEADS, 2, DA_QK_DIM), q_norm_w)
    k = rms_norm(k.reshape(b, L, DA_HEADS, 2, DA_QK_DIM), k_norm_w)
    v = v.reshape(b, L, DA_HEADS, DA_V_DIM)
    lam_init = 0.8 - 0.6 * math.exp(-0.3 * layer_idx)
    lam = (jnp.exp(jnp.sum(lq1.astype(jnp.float32) * lk1.astype(jnp.float32)))
           - jnp.exp(jnp.sum(lq2.astype(jnp.float32) * lk2.astype(jnp.float32))) + lam_init)
    slopes = jnp.exp2(-8.0 * jnp.arange(1, DA_HEADS + 1, dtype=jnp.float32) / DA_HEADS)
    kpos = jnp.arange(L)
    nb = L // Q_BLOCK
    q_blocks = jnp.moveaxis(q.reshape(b, nb, Q_BLOCK, DA_HEADS, 2, DA_QK_DIM), 1, 0)
    starts = jnp.arange(nb) * Q_BLOCK
    sm_scale = DA_QK_DIM ** -0.5

    def block(args):
        qi, start = args
        s = jnp.einsum('bqhcd,bkhcd->bhcqk', qi, k).astype(jnp.float32) * sm_scale
        dist = (start + jnp.arange(Q_BLOCK))[:, None] - kpos[None, :]
        bias = jnp.where(dist >= 0, -slopes[:, None, None] * dist.astype(jnp.float32), -jnp.inf)
        p = jax.nn.softmax(s + bias[None, :, None], axis=-1)
        a = p[:, :, 0] - lam * p[:, :, 1]
        return jnp.einsum('bhqk,bkhd->bqhd', a.astype(v.dtype), v)

    o = lax.map(block, (q_blocks, starts))
    o = jnp.moveaxis(o, 0, 1).reshape(b, L, DA_HEADS, DA_V_DIM)
    o = rms_norm(o, subln_w) * (1.0 - lam_init)
    return o.reshape(b, L, GROUP_W)


def setup_inputs(seed: int = 0) -> dict:
    key = jax.random.key(seed)
    ks = jax.random.split(key, 32)
    f32 = jnp.float32
    nrm = lambda k, shape, s: jax.random.normal(k, shape, f32) * s
    dt0 = jnp.exp(jax.random.uniform(ks[7], (DEPTH, SSM_HEADS), f32, math.log(1e-3), math.log(1e-1)))
    return {
        'x': jax.random.normal(ks[0], (BATCH, SEQ, D_MODEL), f32),
        'norm1_w': 1.0 + nrm(ks[1], (DEPTH, D_MODEL), 0.05),
        'w_in': nrm(ks[2], (DEPTH, D_MODEL, D_IN), D_MODEL ** -0.5),
        'gm_norm_w': 1.0 + nrm(ks[3], (DEPTH, GM_HEADS, GM_HEAD_DIM), 0.05),
        'gm_ws': nrm(ks[4], (DEPTH, GM_HEADS, CHUNK, CHUNK), CHUNK ** -0.5),
        'gm_bs': 1.0 + nrm(ks[5], (DEPTH, GM_HEADS, CHUNK), 0.05),
        'ssm_conv_w': nrm(ks[6], (DEPTH, SSM_CONV_DIM, SSM_CONV_K), SSM_CONV_K ** -0.5),
        'ssm_conv_b': nrm(ks[8], (DEPTH, SSM_CONV_DIM), 0.02),
        'ssm_dt_bias': dt0 + jnp.log(-jnp.expm1(-dt0)),
        'ssm_a_log': jnp.log(jax.random.uniform(ks[9], (DEPTH, SSM_HEADS), f32, 1.0, 16.0)),
        'ssm_d': 1.0 + nrm(ks[10], (DEPTH, SSM_HEADS), 0.1),
        'ssm_norm_w': 1.0 + nrm(ks[11], (DEPTH, SSM_D_INNER), 0.05),
        'pool_w': nrm(ks[12], (DEPTH, POOL_GROUPS, POOL_GROUP_DIM, POOL_GROUP_DIM), POOL_GROUP_DIM ** -0.5),
        'pool_scale': 1.0 + nrm(ks[13], (DEPTH, GROUP_W), 0.1),
        'da_q_norm_w': 1.0 + nrm(ks[14], (DEPTH, DA_QK_DIM), 0.05),
        'da_k_norm_w': 1.0 + nrm(ks[15], (DEPTH, DA_QK_DIM), 0.05),
        'da_lambda_q1': nrm(ks[16], (DEPTH, DA_QK_DIM), 0.1),
        'da_lambda_k1': nrm(ks[17], (DEPTH, DA_QK_DIM), 0.1),
        'da_lambda_q2': nrm(ks[18], (DEPTH, DA_QK_DIM), 0.1),
        'da_lambda_k2': nrm(ks[19], (DEPTH, DA_QK_DIM), 0.1),
        'da_subln_w': 1.0 + nrm(ks[20], (DEPTH, DA_V_DIM), 0.05),
        'w_out': nrm(ks[21], (DEPTH, D_MIX, D_MODEL), D_MIX ** -0.5),
        'norm2_w': 1.0 + nrm(ks[22], (DEPTH, D_MODEL), 0.05),
        'ffn_w_gate': nrm(ks[23], (DEPTH, D_MODEL, D_FF), D_MODEL ** -0.5),
        'ffn_w_up': nrm(ks[24], (DEPTH, D_MODEL, D_FF), D_MODEL ** -0.5),
        'ffn_w_down': nrm(ks[25], (DEPTH, D_FF, D_MODEL), D_FF ** -0.5),
    }


def reference(x, norm1_w, w_in, gm_norm_w, gm_ws, gm_bs, ssm_conv_w, ssm_conv_b, ssm_dt_bias,
              ssm_a_log, ssm_d, ssm_norm_w, pool_w, pool_scale, da_q_norm_w, da_k_norm_w,
              da_lambda_q1, da_lambda_k1, da_lambda_q2, da_lambda_k2, da_subln_w, w_out,
              norm2_w, ffn_w_gate, ffn_w_up, ffn_w_down):
    for i in range(DEPTH):
        h = rms_norm(x, norm1_w[i])
        proj = h @ w_in[i]
        pa, pb, pc, pd = jnp.split(proj, IN_SPLITS, axis=-1)
        ya = gmlp_mixer(pa, gm_norm_w[i], gm_ws[i], gm_bs[i])
        yb = ssd_mixer(pb, ssm_conv_w[i], ssm_conv_b[i], ssm_dt_bias[i], ssm_a_log[i], ssm_d[i], ssm_norm_w[i])
        yc = pool_mixer(pc, pool_w[i], pool_scale[i])
        yd = diff_attn_mixer(pd, da_q_norm_w[i], da_k_norm_w[i], da_lambda_q1[i], da_lambda_k1[i],
                             da_lambda_q2[i], da_lambda_k2[i], da_subln_w[i], i)
        mix = jnp.concatenate([ya.astype(x.dtype), yb.astype(x.dtype), yc.astype(x.dtype), yd.astype(x.dtype)], axis=-1)
        x = x + mix @ w_out[i]
        h = rms_norm(x, norm2_w[i])
        x = x + (jax.nn.silu(h @ ffn_w_gate[i]) * (h @ ffn_w_up[i])) @ ffn_w_down[i]
    return x
```

```cpp
#include <hip/hip_runtime.h>
#include <cstdio>
#include <cstdint>
#include <cmath>
namespace pg8 {
#define PG8_LAS __attribute__((address_space(3)))
typedef unsigned short bf16_t;
typedef short bf16x8 __attribute__((ext_vector_type(8)));
typedef float f32x4 __attribute__((ext_vector_type(4)));
typedef unsigned u32x4 __attribute__((ext_vector_type(4)));
constexpr int BM = 256, BK = 64, HALF = 128, HTB = HALF * BK * 2  , STAGE_BYTES = 8 * HTB, NXCD = 8, WGM = 8;

__host__ __device__ __forceinline__ int lds_byte(int r, int c) { const int st = (r >> 4) * 2 + (c >> 5), rr = r & 15, cc = c & 31, ob = rr * 64 + cc * 2; return st * 1024 + (ob ^ (((ob >> 9) & 1) << 5)); }
__host__ __device__ __forceinline__ void stage_rc(int b, int& R, int& C) { const int st = b / 1024, sb = b % 1024, swz = sb ^ (((sb >> 9) & 1) << 5); R = (st >> 1) * 16 + swz / 64; C = (st & 1) * 32 + (swz % 64) / 2; }
__host__ __device__ __forceinline__ int perm32(int rho) { const int n = rho >> 4, i = rho & 15; return 8 * (i >> 2) + 4 * n + (i & 3); }

struct Unit { int pm, pn; };
struct Gemm { const bf16_t* A; const bf16_t* Bt; int M, N, K; };

struct StaticOrder {
    int nM, nN, nwg, G, c;
    __host__ __device__ void init(int M, int N, int G_, int c_) { nM = M / BM; nN = N / BM; nwg = nM * nN; G = G_; c = c_; }
    __host__ __device__ bool next(int i, Unit& u) const {
        const long L = (long)i * G + c; if (L >= nwg) return false;
        int wgid = (int)L; { const int q = nwg / NXCD, r = nwg % NXCD, xcd = wgid % NXCD, off = wgid / NXCD; wgid = (xcd < r ? xcd * (q + 1) : r * (q + 1) + (xcd - r) * q) + off; }
        const int nig = WGM * nN, gid = wgid / nig, fm = gid * WGM, gsz = (nM - fm) < WGM ? (nM - fm) : WGM;
        u.pm = fm + ((wgid % nig) % gsz); u.pn = (wgid % nig) / gsz; return true;
    }
    __device__ __forceinline__ void a_ready(const Unit&) const {}
    __device__ __forceinline__ void done(const Unit&) const {}
};

__device__ __forceinline__ unsigned cvt_pk_bf16(float lo, float hi) { unsigned r; asm volatile("v_cvt_pk_bf16_f32 %0, %1, %2" : "=v"(r) : "v"(lo), "v"(hi)); return r; }
typedef float f32x2 __attribute__((ext_vector_type(2)));
__device__ __forceinline__ f32x2 gelu_pk(f32x2 v) {
    const f32x2 av = __builtin_elementwise_abs(v), d = av * 0.2316418882f + 1.0f;
    f32x2 t; t.x = __builtin_amdgcn_rcpf(d.x); t.y = __builtin_amdgcn_rcpf(d.y);
    f32x2 q = t * 0.5307027145f + (-0.7265760135f); q = q * t + 0.7107068705f; q = q * t + (-0.142248368f); q = q * t + 0.127414796f; q = q * t;
    const f32x2 s = (v * v) * (-0.72134752044f);
    f32x2 e; e.x = __builtin_amdgcn_exp2f(s.x); e.y = __builtin_amdgcn_exp2f(s.y);
    const f32x2 m = v * (q * e), r = v - m;
    f32x2 o; o.x = v.x < 0.f ? m.x : r.x; o.y = v.y < 0.f ? m.y : r.y; return o;
}

template <int ACT  > struct EpiBf16 {
    static constexpr bool PERM = true, AFTER_DRAIN = false; static_assert(ACT == 0 || ACT == 1, "EpiBf16: ACT is 0 (none) or 1 (gelu_pk)");
    bf16_t* O; int ldc; const float* bias; int split_cols; size_t split_stride; float scale0;
    __device__ __forceinline__ void operator()(const f32x4 (&acc)[2][2][4][2], const Unit& u, int wr, int wc, int fr, int fq) const {
        const int row0 = u.pm * BM + wr * 64 + fr; int colt = u.pn * BM; bf16_t* base = O;
        float sc = 1.f; if (split_cols) { const int t = colt / split_cols; base += (size_t)t * split_stride; colt -= t * split_cols; if (t == 0) sc = scale0; }
        const int col0 = colt + wc * 32 + 8 * fq, bcol0 = u.pn * BM + wc * 32 + 8 * fq;
        f32x4 bv[2][2];
#pragma unroll
        for (int bj = 0; bj < 2; ++bj)
#pragma unroll
            for (int n = 0; n < 2; ++n) bv[bj][n] = bias ? *(const f32x4*)(bias + bcol0 + bj * HALF + 4 * n) : (f32x4){0.f, 0.f, 0.f, 0.f};
#pragma unroll
        for (int ai = 0; ai < 2; ++ai)
#pragma unroll
            for (int m = 0; m < 4; ++m) { bf16_t* rowp = base + (size_t)(row0 + ai * HALF + m * 16) * ldc + col0;
#pragma unroll
                for (int bj = 0; bj < 2; ++bj) { f32x4 v0 = acc[ai][bj][m][0] + bv[bj][0], v1 = acc[ai][bj][m][1] + bv[bj][1];
                    if (ACT == 1) { f32x2 a = gelu_pk((f32x2){v0[0], v0[1]}), b = gelu_pk((f32x2){v0[2], v0[3]}), c = gelu_pk((f32x2){v1[0], v1[1]}), d = gelu_pk((f32x2){v1[2], v1[3]});
                        v0 = (f32x4){a.x, a.y, b.x, b.y}; v1 = (f32x4){c.x, c.y, d.x, d.y}; }
                    v0 = v0 * sc; v1 = v1 * sc; u32x4 w; w.x = cvt_pk_bf16(v0[0], v0[1]); w.y = cvt_pk_bf16(v0[2], v0[3]); w.z = cvt_pk_bf16(v1[0], v1[1]); w.w = cvt_pk_bf16(v1[2], v1[3]);
                    *(u32x4*)(rowp + bj * HALF) = w; } }
    }
};
template <class Epi, class Sched, bool ALIGN_EPI = false, bool SP2 = false>
__device__ __forceinline__ void gemm_phase(PG8_LAS unsigned char* lds, const Gemm g, const Sched& S, const Epi& E) {
    int tid_ = threadIdx.x; asm volatile("" : "+v"(tid_));
    const int tid = tid_, wid = __builtin_amdgcn_readfirstlane(tid >> 6), lane = tid & 63, wr = wid >> 2, wc = wid & 3, fr = lane & 15, fq = lane >> 4;
    const int K = g.K, nt = K / BK;
    unsigned voffA[2], voffB[2];
#pragma unroll
    for (int i = 0; i < 2; ++i) { int R, C; stage_rc(tid * 16 + i * 8192, R, C); const int Rb = Epi::PERM ? ((R & ~31) + perm32(R & 31)) : R;
        voffA[i] = (unsigned)(R * K + C) * 2u; voffB[i] = (unsigned)(Rb * K + C) * 2u; }
    const size_t kstep = (size_t)(BK * 2);
    const size_t hstep = (size_t)HALF * K * 2;
    const size_t tstep = 2 * hstep;
    const unsigned ldsw = (unsigned)wid * 1024u;
    const int aoff = lds_byte(wr * 64 + fr, fq * 8), boff = lds_byte(wc * 32 + fr, fq * 8);
#define PG8_SA(b, h) (((b) * 2 + (h)) * HTB)
#define PG8_SB(b, h) ((4 + (b) * 2 + (h)) * HTB)
#define PG8_STAGE(bufoff, gbase, voff) do { _Pragma("unroll") for (int _i = 0; _i < 2; ++_i) \
        __builtin_amdgcn_global_load_lds((const unsigned*)((const char*)(gbase) + (voff)[_i]), (PG8_LAS unsigned*)(lds + (bufoff) + ldsw + _i * 8192), 16, 0, 0); } while (0)
#define PG8_LDA(dst, b, h) do { _Pragma("unroll") for (int m = 0; m < 4; ++m) _Pragma("unroll") for (int k = 0; k < 2; ++k) dst[m][k] = *(const PG8_LAS bf16x8*)(lds + PG8_SA(b, h) + aoff + m * 2048 + k * 1024); } while (0)
#define PG8_LDB(dst, b, h) do { _Pragma("unroll") for (int n = 0; n < 2; ++n) _Pragma("unroll") for (int k = 0; k < 2; ++k) dst[n][k] = *(const PG8_LAS bf16x8*)(lds + PG8_SB(b, h) + boff + n * 2048 + k * 1024); } while (0)
#define PG8_MMA(ai, bj, At, Bt) do { __builtin_amdgcn_s_setprio(1); _Pragma("unroll") for (int m = 0; m < 4; ++m) _Pragma("unroll") for (int n = 0; n < 2; ++n) _Pragma("unroll") for (int k = 0; k < 2; ++k) \
        acc[ai][bj][m][n] = __builtin_amdgcn_mfma_f32_16x16x32_bf16(Bt[n][k], At[m][k], acc[ai][bj][m][n], 0, 0, 0); __builtin_amdgcn_s_setprio(0); } while (0)
#define PG8_WAIT_V(n) asm volatile("s_waitcnt vmcnt(" #n ")" ::: "memory")
#define PG8_WAIT_L(n) asm volatile("s_waitcnt lgkmcnt(" #n ")" ::: "memory")
#define PG8_BAR __builtin_amdgcn_s_barrier()
#define PG8_SCHED __builtin_amdgcn_sched_barrier(0)
    Unit cur, nxt; int ui = 0;
    if (!S.next(0, cur)) return;
    f32x4 acc[2][2][4][2];
#pragma unroll
    for (int a = 0; a < 2; ++a)
#pragma unroll
        for (int b = 0; b < 2; ++b)
#pragma unroll
            for (int m = 0; m < 4; ++m)
#pragma unroll
                for (int n = 0; n < 2; ++n) acc[a][b][m][n] = (f32x4){0.f, 0.f, 0.f, 0.f};
    bf16x8 At[4][2], B0[2][2], B1[2][2];
    const char* cA = (const char*)g.A + (size_t)cur.pm * tstep; const char* cB = (const char*)g.Bt + (size_t)cur.pn * tstep;
    S.a_ready(cur);
    if constexpr (SP2) {
        PG8_STAGE(PG8_SB(0, 0), cB, voffB); PG8_STAGE(PG8_SB(0, 1), cB + hstep, voffB); PG8_STAGE(PG8_SA(0, 0), cA, voffA); PG8_STAGE(PG8_SA(0, 1), cA + hstep, voffA);
        if (wr == 1) PG8_BAR;
        PG8_WAIT_V(2); PG8_BAR;
        PG8_STAGE(PG8_SB(1, 0), cB + kstep, voffB); PG8_STAGE(PG8_SA(1, 0), cA + kstep, voffA); PG8_STAGE(PG8_SB(1, 1), cB + hstep + kstep, voffB);
        PG8_WAIT_V(6); PG8_BAR;
    } else {
        PG8_STAGE(PG8_SB(0, 0), cB, voffB); PG8_STAGE(PG8_SA(0, 0), cA, voffA); PG8_STAGE(PG8_SB(0, 1), cB + hstep, voffB); PG8_STAGE(PG8_SA(0, 1), cA + hstep, voffA);
        if (wr == 1) PG8_BAR;
        PG8_WAIT_V(4); PG8_BAR;
        PG8_STAGE(PG8_SB(1, 0), cB + kstep, voffB); PG8_STAGE(PG8_SA(1, 0), cA + kstep, voffA); PG8_STAGE(PG8_SB(1, 1), cB + hstep + kstep, voffB);
        PG8_WAIT_V(6); PG8_BAR;
    }
    for (;;) {
        const bool has_next = S.next(ui + 1, nxt);
        const char* nA = has_next ? (const char*)g.A + (size_t)nxt.pm * tstep : cA; const char* nB = has_next ? (const char*)g.Bt + (size_t)nxt.pn * tstep : cB;
        for (int t = 0; t < nt; t += 2) {
            const bool last = (t == nt - 2);
            const char* a1 = cA + (size_t)(t + 1) * kstep;
            const char* a2 = last ? nA : cA + (size_t)(t + 2) * kstep; const char* b2 = last ? nB : cB + (size_t)(t + 2) * kstep;
            const char* a3 = a2 + kstep; const char* b3 = b2 + kstep;
            if (last && has_next) S.a_ready(nxt);
            if constexpr (SP2) {
            PG8_LDB(B0, 0, 0); PG8_LDB(B1, 0, 1); PG8_SCHED; PG8_LDA(At, 0, 0); PG8_STAGE(PG8_SA(1, 1), a1 + hstep, voffA);
            PG8_WAIT_V(8); PG8_WAIT_L(0); PG8_BAR; PG8_MMA(0, 0, At, B0); PG8_MMA(0, 1, At, B1); PG8_BAR; PG8_SCHED;
            PG8_LDA(At, 0, 1); PG8_STAGE(PG8_SB(0, 0), b2, voffB); PG8_STAGE(PG8_SB(0, 1), b2 + hstep, voffB); PG8_STAGE(PG8_SA(0, 0), a2, voffA);
            PG8_WAIT_V(8); PG8_WAIT_L(0); PG8_BAR; PG8_MMA(1, 0, At, B0); PG8_MMA(1, 1, At, B1); PG8_BAR; PG8_SCHED;
            PG8_LDB(B0, 1, 0); PG8_LDB(B1, 1, 1); PG8_SCHED; PG8_LDA(At, 1, 0); PG8_STAGE(PG8_SA(0, 1), a2 + hstep, voffA);
            PG8_WAIT_V(8); PG8_WAIT_L(0); PG8_BAR; PG8_MMA(0, 0, At, B0); PG8_MMA(0, 1, At, B1); PG8_BAR; PG8_SCHED;
            PG8_LDA(At, 1, 1); PG8_STAGE(PG8_SB(1, 0), b3, voffB); PG8_STAGE(PG8_SB(1, 1), b3 + hstep, voffB); PG8_STAGE(PG8_SA(1, 0), a3, voffA);
            PG8_WAIT_V(8); PG8_WAIT_L(0); PG8_BAR; PG8_MMA(1, 0, At, B0); PG8_MMA(1, 1, At, B1); PG8_BAR; PG8_SCHED;
            } else {
            PG8_LDB(B0, 0, 0); PG8_SCHED; PG8_LDA(At, 0, 0); PG8_STAGE(PG8_SA(1, 1), a1 + hstep, voffA);
            PG8_WAIT_L(8); PG8_BAR; PG8_WAIT_L(0); PG8_MMA(0, 0, At, B0); PG8_BAR; PG8_SCHED;
            PG8_LDB(B1, 0, 1); PG8_STAGE(PG8_SB(0, 0), b2, voffB);
            PG8_BAR; PG8_WAIT_L(0); PG8_MMA(0, 1, At, B1); PG8_BAR;
            PG8_LDA(At, 0, 1); PG8_STAGE(PG8_SA(0, 0), a2, voffA);
            PG8_BAR; PG8_WAIT_L(0); PG8_MMA(1, 0, At, B0); PG8_BAR; PG8_SCHED;
            PG8_STAGE(PG8_SB(0, 1), b2 + hstep, voffB);
            PG8_WAIT_V(6); PG8_BAR; PG8_MMA(1, 1, At, B1); PG8_BAR;
            PG8_LDB(B0, 1, 0); PG8_SCHED; PG8_LDA(At, 1, 0); PG8_STAGE(PG8_SA(0, 1), a2 + hstep, voffA);
            PG8_WAIT_L(8); PG8_BAR; PG8_WAIT_L(0); PG8_MMA(0, 0, At, B0); PG8_BAR; PG8_SCHED;
            PG8_LDB(B1, 1, 1); PG8_STAGE(PG8_SB(1, 0), b3, voffB);
            PG8_BAR; PG8_WAIT_L(0); PG8_MMA(0, 1, At, B1); PG8_BAR;
            PG8_LDA(At, 1, 1); PG8_STAGE(PG8_SA(1, 0), a3, voffA);
            PG8_BAR; PG8_WAIT_L(0); PG8_MMA(1, 0, At, B0); PG8_BAR; PG8_SCHED;
            PG8_STAGE(PG8_SB(1, 1), b3 + hstep, voffB);
            PG8_WAIT_V(6); PG8_BAR; PG8_MMA(1, 1, At, B1); PG8_BAR;
            }
        }
        if constexpr (ALIGN_EPI) { if (wr == 0) PG8_BAR; }
        if constexpr (!Epi::AFTER_DRAIN) { E(acc, cur, wr, wc, fr, fq); S.done(cur); }
        if (!has_next) break;
#pragma unroll
        for (int a = 0; a < 2; ++a)
#pragma unroll
            for (int b = 0; b < 2; ++b)
#pragma unroll
                for (int m = 0; m < 4; ++m)
#pragma unroll
                    for (int n = 0; n < 2; ++n) acc[a][b][m][n] = (f32x4){0.f, 0.f, 0.f, 0.f};
        cur = nxt; cA = nA; cB = nB; ++ui;
        if constexpr (ALIGN_EPI) { if (wr == 1) PG8_BAR; }
    }
    PG8_WAIT_V(0);
    if constexpr (!ALIGN_EPI) { if (wr == 0) PG8_BAR; }
    PG8_BAR;
    if constexpr (Epi::AFTER_DRAIN) { E.fused(acc, cur, wr, wc, fr, fq, lds, wid, lane); S.done(cur); }
#undef PG8_SA
#undef PG8_SB
#undef PG8_STAGE
#undef PG8_LDA
#undef PG8_LDB
#undef PG8_MMA
#undef PG8_WAIT_V
#undef PG8_WAIT_L
#undef PG8_BAR
#undef PG8_SCHED
}
}
#define GAS __attribute__((address_space(1)))
#define LAS __attribute__((address_space(3)))
typedef unsigned short bf16;
typedef unsigned v4u __attribute__((ext_vector_type(4)));
typedef float f32x4 __attribute__((ext_vector_type(4)));
typedef short bf16x8 __attribute__((ext_vector_type(8)));
typedef GAS unsigned gu32;
typedef GAS unsigned long long gu64;
#define RLX_AGENT __ATOMIC_RELAXED, __HIP_MEMORY_SCOPE_AGENT
#define LDS_WAIT() asm volatile("s_waitcnt lgkmcnt(0)" ::: "memory")
#define VM_WAIT() asm volatile("s_waitcnt vmcnt(0)" ::: "memory")
__device__ __forceinline__ unsigned long long rt() { return __builtin_amdgcn_s_memrealtime(); }
__device__ __forceinline__ unsigned f2bf(float f) { unsigned u = __builtin_bit_cast(unsigned, f); return (u + 0x7fffu + ((u >> 16) & 1u)) >> 16; }
__device__ __forceinline__ unsigned pk2(float lo, float hi) { return f2bf(lo) | (f2bf(hi) << 16); }

#define XB_TMO      128
#define XB_XCNT(j)  (256  + 64 * (j))
#define XB_XSUB(j)  (1280 + 64 * (j))
#define XB_XGEN(j)  (2304 + 64 * (j))
#define XB_TOP      3328
#define XB_TOPGEN   3392
#define XCD_BAR_WORDS 3456
#define XB_SPIN_CAP (1u << 18)

__device__ __forceinline__ unsigned xb_ld(unsigned* p)              { return __hip_atomic_load(p, __ATOMIC_RELAXED, __HIP_MEMORY_SCOPE_AGENT); }
__device__ __forceinline__ unsigned xb_add(unsigned* p, unsigned v) { return __hip_atomic_fetch_add(p, v, __ATOMIC_RELAXED, __HIP_MEMORY_SCOPE_AGENT); }
__device__ __forceinline__ unsigned xb_xcc_id() { return (unsigned)__builtin_amdgcn_s_getreg((3 << 11) | 20) & 0xFu; }
#define XB_SPIN(cond, bar) do { unsigned _sp = 0; while (cond) { __builtin_amdgcn_s_sleep(1); \
    if ((++_sp & 255u) == 0u) { if (xb_ld(&(bar)[XB_TMO])) break; if (_sp > XB_SPIN_CAP) { atomicAdd(&(bar)[XB_TMO], 1u); break; } } } } while (0)

struct XcdBarrier {
    unsigned* bar; unsigned x;
    volatile LAS unsigned* st;
};

__device__ __forceinline__ XcdBarrier xcd_barrier_post(unsigned* bar, volatile LAS unsigned* st) {
    XcdBarrier b; b.bar = bar; b.x = xb_xcc_id(); b.st = st;
    if (threadIdx.x == 0) (void)xb_add(&bar[XB_XCNT(b.x)], 1u);
    return b;
}
__device__ __forceinline__ void xcd_barrier_complete(unsigned* bar, unsigned x, unsigned& nloc, unsigned& nx) {
    const unsigned G = gridDim.x * gridDim.y * gridDim.z;
    unsigned sum, cnt, mine, sp = 0u;
    for (;;) {
        sum = 0u; cnt = 0u; mine = 0u;
#pragma unroll
        for (unsigned j = 0; j < 16; ++j) { const unsigned c = xb_ld(&bar[XB_XCNT(j)]); sum += c; cnt += (c > 0u) ? 1u : 0u; mine = (j == x) ? c : mine; }
        if (sum == G) break;
        __builtin_amdgcn_s_sleep(1);
        if ((++sp & 255u) == 0u) { if (xb_ld(&bar[XB_TMO])) break; if (sp > XB_SPIN_CAP) { atomicAdd(&bar[XB_TMO], 1u); break; } }
    }
    nloc = mine > 0u ? mine : 1u; nx = cnt > 0u ? cnt : 1u;
}

__device__ __forceinline__ void xcd_barrier(const XcdBarrier& b) {
    asm volatile("s_waitcnt vmcnt(0)" ::: "memory");
    __syncthreads();
    if (threadIdx.x == 0) {
        unsigned* bar = b.bar;
        __builtin_amdgcn_s_waitcnt(0);
        unsigned nloc = b.st[0], nx = b.st[1];
        if (nloc == 0u) { xcd_barrier_complete(bar, b.x, nloc, nx); b.st[0] = nloc; b.st[1] = nx; }
        const unsigned old = xb_add(&bar[XB_XSUB(b.x)], 1u);
        const unsigned gen = old / nloc;
        if (old + 1u == (gen + 1u) * nloc) {
            __builtin_amdgcn_fence(__ATOMIC_RELEASE, "agent");
            asm volatile("s_waitcnt vmcnt(0)" ::: "memory");
            const unsigned og = xb_add(&bar[XB_TOP], 1u);
            const unsigned tg = og / nx;
            if (og + 1u == (tg + 1u) * nx) xb_add(&bar[XB_TOPGEN], 1u);
            else XB_SPIN(xb_ld(&bar[XB_TOPGEN]) == tg, bar);
            __builtin_amdgcn_fence(__ATOMIC_ACQUIRE, "agent");
            xb_add(&bar[XB_XGEN(b.x)], 1u);
            asm volatile("s_waitcnt vmcnt(0)" ::: "memory");
        } else {
            XB_SPIN(xb_ld(&bar[XB_XGEN(b.x)]) == gen, bar);
            __builtin_amdgcn_fence(__ATOMIC_ACQUIRE, "agent");
            asm volatile("s_waitcnt vmcnt(0)" ::: "memory");
        }
    }
    __syncthreads();
}
typedef unsigned u32x4 __attribute__((ext_vector_type(4)));

constexpr int NWAVES = 8;
constexpr int BATCH = 8, SEQ = 2048, DM = 1024, M = BATCH * SEQ, DEPTH = 2;
constexpr int DIN = 2564, PP = 2304, NPROJ = 2560, DFF = 2816, NGU = 2 * DFF;
constexpr float EPS = 1e-6f;
constexpr float LOG2E = 1.4426950408889634f;
constexpr int C_U = 0, C_V = 256, C_Z = 512, C_XS = 768, C_B = 1024, C_C = 1280, C_POOL = 1536, C_Q = 1792, C_K = 2048;
enum { I_X = 0, I_N1W, I_WIN, I_GMNW, I_GMWS, I_GMBS, I_CONVW, I_CONVB, I_DTB, I_ALOG, I_SSMD, I_SSMNW, I_POOLW, I_POOLS,
       I_QNW, I_KNW, I_LQ1, I_LK1, I_LQ2, I_LK2, I_SUBLN, I_WOUT, I_N2W, I_WG, I_WU, I_WD, N_IN };

constexpr size_t MiB = 1u << 20;
constexpr size_t WS_CTL = 0, CTL_ZERO_BYTES = 64 * 1024;
constexpr size_t WS_W = 2 * MiB, W_LAYER = 24 * MiB, W_IN = 0, W_OUT = 5 * MiB, W_GU = 7 * MiB, W_DN = 18 * MiB;
constexpr size_t WS_XN = 50 * MiB, WS_DT = 82 * MiB, WS_CD = 82 * MiB + 512 * 1024, WS_ST = 83 * MiB, WS_VT = 99 * MiB;
constexpr size_t WS_PROJ = 107 * MiB, WS_MIX = 179 * MiB, WS_H = 107 * MiB, WS_END = 211 * MiB;
constexpr int CW_BAR = 4096;

constexpr int SCR_BYTES = 147456;
constexpr int LDSCTL_OFF = SCR_BYTES, MISC_OFF = LDSCTL_OFF + 320;
constexpr int LDS_BYTES = SCR_BYTES + 1024;

typedef float f32x16 __attribute__((ext_vector_type(16)));
typedef unsigned u32x2 __attribute__((ext_vector_type(2)));
#define DI __device__ __forceinline__
#define OPQ(x) asm volatile("" : "+v"(x))
#define MFMA32(a, b, c) __builtin_amdgcn_mfma_f32_32x32x16_bf16((a), (b), (c), 0, 0, 0)

DI float bf2f(bf16 u) { return __uint_as_float((unsigned)u << 16); }
DI float bflo(unsigned w) { return __uint_as_float(w << 16); }
DI float bfhi(unsigned w) { return __uint_as_float(w & 0xffff0000u); }
DI bf16 f2b(float f) { return (bf16)f2bf(f); }
DI int crow(int reg, int h) { return (reg & 3) + 8 * (reg >> 2) + 4 * h; }
DI float wave_sum(float v) {
#pragma unroll
    for (int o = 1; o < 64; o <<= 1) v += __shfl_xor(v, o);
    return v;
}
DI void unpack8(v4u w, float* f) { f[0] = bflo(w.x); f[1] = bfhi(w.x); f[2] = bflo(w.y); f[3] = bfhi(w.y); f[4] = bflo(w.z); f[5] = bfhi(w.z); f[6] = bflo(w.w); f[7] = bfhi(w.w); }
DI v4u pack8(const float* f) { v4u o; o.x = pk2(f[0], f[1]); o.y = pk2(f[2], f[3]); o.z = pk2(f[4], f[5]); o.w = pk2(f[6], f[7]); return o; }
DI float silu_f(float x) { return x * __builtin_amdgcn_rcpf(1.f + __builtin_amdgcn_exp2f(-x * LOG2E)); }
DI float gelu_tanh_f(float x) { const float y = 0.7978845608f * (x + 0.044715f * x * x * x); return x * __builtin_amdgcn_rcpf(1.f + __builtin_amdgcn_exp2f(-2.f * LOG2E * y)); }

DI f32x16 mma_tile(const LAS bf16* A, int pa, const LAS bf16* Bt, int pb, int K, f32x16 acc, int r, int lh) {
    const LAS bf16* ap = A + r * pa + 8 * lh; const LAS bf16* bp = Bt + r * pb + 8 * lh;
    for (int k = 0; k < K; k += 16) { const bf16x8 a = *(const LAS bf16x8*)(ap + k); const bf16x8 b = *(const LAS bf16x8*)(bp + k); acc = MFMA32(a, b, acc); }
    return acc;
}

struct Args { const float* in[N_IN]; float* out; unsigned char* ws; int ph_lo, ph_hi; };
typedef const Args __attribute__((address_space(4)))* KA;
DI KA kargs() { KA p = (KA)__builtin_amdgcn_kernarg_segment_ptr(); asm volatile("" : "+s"(p)); return p; }

namespace pg8 {
struct EpiInProj {
    static constexpr bool PERM = true, AFTER_DRAIN = false;
    bf16_t* O; const float* qw; const float* kw;
    __device__ __forceinline__ void operator()(const f32x4 (&acc)[2][2][4][2], const Unit& u, int wr, int wc, int fr, int fq) const {
        const int row0 = u.pm * BM + wr * 64 + fr, col0 = u.pn * BM + wc * 32 + 8 * fq;
        const int mode = (u.pn < 2) ? 1 : (u.pn == 7 ? 2 : (u.pn == 8 ? 3 : 0));
        f32x4 w0 = (f32x4){1.f, 1.f, 1.f, 1.f}, w1 = w0;
        if (mode >= 2) { const float* wp = (mode == 2 ? qw : kw) + 8 * fq; w0 = *(const f32x4*)wp; w1 = *(const f32x4*)(wp + 4);
            if (mode == 2) { const float sc = 0.17677669529663687f * 1.4426950408889634f; w0 = w0 * sc; w1 = w1 * sc; } }
#pragma unroll
        for (int ai = 0; ai < 2; ++ai)
#pragma unroll
            for (int m = 0; m < 4; ++m) { bf16_t* rowp = O + (size_t)(row0 + ai * HALF + m * 16) * PP + col0;
#pragma unroll
                for (int bj = 0; bj < 2; ++bj) { f32x4 v0 = acc[ai][bj][m][0], v1 = acc[ai][bj][m][1];
                    if (mode == 1) {
#pragma unroll
                        for (int j = 0; j < 4; ++j) { v0[j] = gelu_tanh_f(v0[j]); v1[j] = gelu_tanh_f(v1[j]); }
                    } else if (mode >= 2) {
                        float ss = (v0[0] * v0[0] + v0[1] * v0[1]) + (v0[2] * v0[2] + v0[3] * v0[3]) + (v1[0] * v1[0] + v1[1] * v1[1]) + (v1[2] * v1[2] + v1[3] * v1[3]);
                        ss += __shfl_xor(ss, 16); ss += __shfl_xor(ss, 32);
                        const float rstd = 1.0f / sqrtf(ss * (1.0f / 32.0f) + EPS);
                        v0 = v0 * rstd * w0; v1 = v1 * rstd * w1;
                    }
                    u32x4 w; w.x = cvt_pk_bf16(v0[0], v0[1]); w.y = cvt_pk_bf16(v0[2], v0[3]); w.z = cvt_pk_bf16(v1[0], v1[1]); w.w = cvt_pk_bf16(v1[2], v1[3]);
                    *(u32x4*)(rowp + bj * HALF) = w; } }
    }
};
struct EpiResid {
    static constexpr bool PERM = false, AFTER_DRAIN = false;
    const float* base; float* out;
    __device__ __forceinline__ void operator()(const f32x4 (&acc)[2][2][4][2], const Unit& u, int wr, int wc, int fr, int fq) const {
        const int row0 = u.pm * BM + wr * 64 + fr, col0 = u.pn * BM + wc * 32 + 4 * fq;
#pragma unroll
        for (int ai = 0; ai < 2; ++ai)
#pragma unroll
            for (int m = 0; m < 4; ++m) { const size_t off = (size_t)(row0 + ai * HALF + m * 16) * DM + col0;
#pragma unroll
                for (int bj = 0; bj < 2; ++bj)
#pragma unroll
                    for (int n = 0; n < 2; ++n) { const size_t o = off + bj * HALF + n * 16; const f32x4 bs = *(const f32x4*)(base + o); *(f32x4*)(out + o) = bs + acc[ai][bj][m][n]; } }
    }
};
struct EpiSwiGLU {
    static constexpr bool PERM = true, AFTER_DRAIN = false;
    bf16_t* O;
    __device__ __forceinline__ void operator()(const f32x4 (&acc)[2][2][4][2], const Unit& u, int wr, int wc, int fr, int fq) const {
        const int row0 = u.pm * BM + wr * 64 + fr, col0 = u.pn * HALF + wc * 32 + 8 * fq;
#pragma unroll
        for (int ai = 0; ai < 2; ++ai)
#pragma unroll
            for (int m = 0; m < 4; ++m) { bf16_t* rowp = O + (size_t)(row0 + ai * HALF + m * 16) * DFF + col0;
                f32x4 h0, h1;
#pragma unroll
                for (int j = 0; j < 4; ++j) { h0[j] = silu_f(acc[ai][0][m][0][j]) * acc[ai][1][m][0][j]; h1[j] = silu_f(acc[ai][0][m][1][j]) * acc[ai][1][m][1][j]; }
                u32x4 w; w.x = cvt_pk_bf16(h0[0], h0[1]); w.y = cvt_pk_bf16(h0[2], h0[3]); w.z = cvt_pk_bf16(h1[0], h1[1]); w.w = cvt_pk_bf16(h1[2], h1[3]);
                *(u32x4*)rowp = w; }
    }
};
}

DI void tr_item(const float* src, int pitch, int k0, int c0, bf16* dst, int drow0, int Kd, LAS float* scr, int lane) {
#pragma unroll 8
    for (int i = 0; i < 32; ++i) { const int kk = 2 * i + (lane >> 5); scr[kk * 33 + (lane & 31)] = src[(size_t)(k0 + kk) * pitch + c0 + (lane & 31)]; }
    LDS_WAIT(); asm volatile("" ::: "memory");
    const int c = lane & 7;
#pragma unroll
    for (int j = 0; j < 4; ++j) { const int n = (lane >> 3) + 8 * j; const LAS float* s = scr + (8 * c) * 33 + n;
        v4u o; o.x = pk2(s[0 * 33], s[1 * 33]); o.y = pk2(s[2 * 33], s[3 * 33]); o.z = pk2(s[4 * 33], s[5 * 33]); o.w = pk2(s[6 * 33], s[7 * 33]);
        *(v4u*)(dst + (size_t)(drow0 + n) * Kd + k0 + 8 * c) = o; }
    LDS_WAIT(); asm volatile("" ::: "memory");
}
DI void weights_phase(KA a, LAS unsigned char* lds, int vcu, int G, int wave, int lane) {
    OPQ(lane);
    LAS float* scr = (LAS float*)(lds + wave * 16384);
    constexpr int N_INP = 16 * 80, N_OUT = 16 * 32, N_G = 16 * 88, N_D = 44 * 32, PER_L = N_INP + N_OUT + 2 * N_G + N_D;
    for (int it = vcu * NWAVES + wave; it < DEPTH * PER_L; it += G * NWAVES) {
        const int L = it / PER_L; int r = it % PER_L;
        unsigned char* wb = a->ws + WS_W + (size_t)L * W_LAYER;
        if (r < N_INP) { const int kb = r / 80, nb = r % 80, d0 = nb * 32; tr_item(a->in[I_WIN] + (size_t)L * DM * DIN, DIN, kb * 64, d0 < 1536 ? d0 : d0 + 4, (bf16*)(wb + W_IN), d0, DM, scr, lane); continue; } r -= N_INP;
        if (r < N_OUT) { const int kb = r / 32, nb = r % 32; tr_item(a->in[I_WOUT] + (size_t)L * DM * DM, DM, kb * 64, nb * 32, (bf16*)(wb + W_OUT), nb * 32, DM, scr, lane); continue; } r -= N_OUT;
        if (r < N_G) { const int kb = r / 88, nb = r % 88, c0 = nb * 32; tr_item(a->in[I_WG] + (size_t)L * DM * DFF, DFF, kb * 64, c0, (bf16*)(wb + W_GU), (c0 >> 7) * 256 + (c0 & 127), DM, scr, lane); continue; } r -= N_G;
        if (r < N_G) { const int kb = r / 88, nb = r % 88, c0 = nb * 32; tr_item(a->in[I_WU] + (size_t)L * DM * DFF, DFF, kb * 64, c0, (bf16*)(wb + W_GU), (c0 >> 7) * 256 + 128 + (c0 & 127), DM, scr, lane); continue; } r -= N_G;
        { const int kb = r / 32, nb = r % 32; tr_item(a->in[I_WD] + (size_t)L * DFF * DM, DM, kb * 64, nb * 32, (bf16*)(wb + W_DN), nb * 32, DFF, scr, lane); }
    }
}
DI void norm_phase(const float* xsrc, const float* nw, bf16* XN, bool with_dt, const float* win_l, float* DT, LAS unsigned char* lds, int vcu, int G, int wave, int lane, int tid) {
    OPQ(lane); OPQ(tid);
    LAS f32x4* Wl = (LAS f32x4*)lds;
    if (with_dt) { for (int i = tid; i < DM; i += NWAVES * 64) Wl[i] = *(const f32x4*)(win_l + (size_t)i * DIN + 1536); }
    __syncthreads();
    for (int m = vcu * NWAVES + wave; m < M; m += G * NWAVES) {
        const f32x4* xr = (const f32x4*)(xsrc + (size_t)m * DM) + lane;
        f32x4 v[4]; float s = 0.f;
#pragma unroll
        for (int j = 0; j < 4; ++j) { v[j] = xr[64 * j]; s += (v[j].x * v[j].x + v[j].y * v[j].y) + (v[j].z * v[j].z + v[j].w * v[j].w); }
        const float rstd = 1.0f / sqrtf(wave_sum(s) * (1.0f / DM) + EPS);
        unsigned long long* o8 = (unsigned long long*)(XN + (size_t)m * DM) + lane;
        f32x4 dacc = (f32x4){0.f, 0.f, 0.f, 0.f};
#pragma unroll
        for (int j = 0; j < 4; ++j) { const f32x4 w4 = ((const f32x4*)nw)[lane + 64 * j]; v[j] = v[j] * rstd * w4;
            o8[64 * j] = (unsigned long long)pk2(v[j].x, v[j].y) | ((unsigned long long)pk2(v[j].z, v[j].w) << 32);
            if (with_dt) { const int k = 4 * (lane + 64 * j); dacc += v[j].x * Wl[k] + v[j].y * Wl[k + 1] + v[j].z * Wl[k + 2] + v[j].w * Wl[k + 3]; } }
        if (with_dt) { dacc.x = wave_sum(dacc.x); dacc.y = wave_sum(dacc.y); dacc.z = wave_sum(dacc.z); dacc.w = wave_sum(dacc.w); if (lane == 0) *(f32x4*)(DT + (size_t)m * 4) = dacc; }
    }
    __syncthreads();
}

DI void gmlp_item(KA a, int L, int b, int c, int h, LAS unsigned char* lds, int tid, int wave, int lane) {
    OPQ(lane); OPQ(tid);
    LAS bf16* Wm = (LAS bf16*)lds; LAS bf16* vT = (LAS bf16*)(lds + 34816);
    const bf16* PROJ = (const bf16*)(a->ws + WS_PROJ); bf16* MIX = (bf16*)(a->ws + WS_MIX);
    const int tok0 = b * SEQ + c * 128;
    const float* ws = a->in[I_GMWS] + (size_t)(L * 4 + h) * 16384;
#pragma unroll
    for (int i = 0; i < 8; ++i) { const int idx = tid + 512 * i, t = idx >> 5, s4 = (idx & 31) * 4; const f32x4 w = *(const f32x4*)(ws + t * 128 + s4);
        u32x2 p; p.x = pk2(s4 <= t ? w.x : 0.f, s4 + 1 <= t ? w.y : 0.f); p.y = pk2(s4 + 2 <= t ? w.z : 0.f, s4 + 3 <= t ? w.w : 0.f);
        *(LAS u32x2*)(Wm + t * 136 + s4) = p; }
    { const int t = tid >> 2, qd = tid & 3; const bf16* vp = PROJ + (size_t)(tok0 + t) * PP + C_V + h * 64 + qd * 16;
      float f[16]; unpack8(*(const v4u*)vp, f); unpack8(*(const v4u*)(vp + 8), f + 8);
      float ss = 0.f;
#pragma unroll
      for (int i = 0; i < 16; ++i) ss += f[i] * f[i];
      ss += __shfl_xor(ss, 1); ss += __shfl_xor(ss, 2);
      const float rstd = 1.0f / sqrtf(ss * (1.0f / 64.0f) + EPS); const float* gw = a->in[I_GMNW] + L * 256 + h * 64 + qd * 16;
#pragma unroll
      for (int i = 0; i < 16; ++i) vT[(qd * 16 + i) * 136 + t] = f2b(f[i] * rstd * gw[i]); }
    __syncthreads();
    { const int tt = wave >> 1, dtl = wave & 1, r = lane & 31, lh = lane >> 5;
      f32x16 acc = {}; acc = mma_tile(Wm + tt * 32 * 136, 136, vT + dtl * 32 * 136, 136, 32 * (tt + 1), acc, r, lh);
      const float* bs = a->in[I_GMBS] + (L * 4 + h) * 128; const int d = dtl * 32 + r;
#pragma unroll
      for (int reg = 0; reg < 16; ++reg) { const int t = tt * 32 + crow(reg, lh); const float u = bf2f(PROJ[(size_t)(tok0 + t) * PP + C_U + h * 64 + d]);
          MIX[(size_t)(tok0 + t) * DM + h * 64 + d] = f2b(u * (acc[reg] + bs[t])); } }
    __syncthreads();
}
DI void pool_item(KA a, int L, int b, int c, int g, LAS unsigned char* lds, int tid, int wave, int lane) {
    OPQ(lane); OPQ(tid);
    LAS bf16* P = (LAS bf16*)lds; LAS bf16* WT = (LAS bf16*)(lds + 18432);
    const bf16* PROJ = (const bf16*)(a->ws + WS_PROJ); bf16* MIX = (bf16*)(a->ws + WS_MIX);
    const int tok0 = b * SEQ + c * 128;
    { const int t = tid >> 2, qd = tid & 3, win = 2 << g, tpos = c * 128 + t, cnt = (tpos + 1 < win) ? tpos + 1 : win;
      const bf16* hp = PROJ + (size_t)(b * SEQ + tpos) * PP + C_POOL + g * 64 + qd * 16;
      float s[16], cur[16];
#pragma unroll
      for (int i = 0; i < 16; ++i) { s[i] = 0.f; cur[i] = 0.f; }
      for (int j = 0; j < cnt; ++j) { float f[16]; unpack8(*(const v4u*)(hp - (size_t)j * PP), f); unpack8(*(const v4u*)(hp - (size_t)j * PP + 8), f + 8);
#pragma unroll
          for (int i = 0; i < 16; ++i) { s[i] += f[i]; if (j == 0) cur[i] = f[i]; } }
      const float inv = 1.0f / (float)cnt;
#pragma unroll
      for (int i = 0; i < 16; ++i) s[i] = s[i] * inv - cur[i];
      *(LAS v4u*)(P + t * 72 + qd * 16) = pack8(s); *(LAS v4u*)(P + t * 72 + qd * 16 + 8) = pack8(s + 8); }
    { const float* pw = a->in[I_POOLW] + (size_t)(L * 4 + g) * 4096;
#pragma unroll
      for (int i = 0; i < 8; ++i) { const int idx = tid + 512 * i, d = idx >> 6, e = idx & 63; WT[e * 72 + d] = f2b(pw[d * 64 + e]); } }
    __syncthreads();
    { const int tt = wave >> 1, et = wave & 1, r = lane & 31, lh = lane >> 5;
      f32x16 acc = {}; acc = mma_tile(P + tt * 32 * 72, 72, WT + et * 32 * 72, 72, 64, acc, r, lh);
      const int e = et * 32 + r; const float sc = a->in[I_POOLS][L * 256 + g * 64 + e];
#pragma unroll
      for (int reg = 0; reg < 16; ++reg) { const int t = tt * 32 + crow(reg, lh); MIX[(size_t)(tok0 + t) * DM + 512 + g * 64 + e] = f2b(acc[reg] * sc); } }
    __syncthreads();
}
constexpr int SSD_DT = 139264, SSD_AR = SSD_DT + 1024, SSD_ACS = SSD_AR + 1024;
DI void ssd_dt(KA a, int L, int g, int tok0, LAS unsigned char* lds, int tid) {
    LAS float* dtv = (LAS float*)(lds + SSD_DT); LAS float* araw = (LAS float*)(lds + SSD_AR); LAS float* acs = (LAS float*)(lds + SSD_ACS);
    const float* DT = (const float*)(a->ws + WS_DT);
    const int hh = (tid >> 7) & 1, t = tid & 127, h = 2 * g + hh;
    if (tid < 256) { const float x = DT[(size_t)(tok0 + t) * 4 + h] + a->in[I_DTB][L * 4 + h]; const float sp = x > 20.f ? x : log1pf(expf(x));
        dtv[t * 2 + hh] = sp; araw[t * 2 + hh] = -sp * expf(a->in[I_ALOG][L * 4 + h]); }
    __syncthreads();
    if (tid < 256) { float s = 0.f; for (int j = 0; j <= t; ++j) s += araw[j * 2 + hh]; acs[t * 2 + hh] = s; }
    __syncthreads();
}
DI void conv8(const bf16* p, int tpos, const float* cw, const float* cb, float* out) {
    float acc[8];
#pragma unroll
    for (int i = 0; i < 8; ++i) acc[i] = cb[i];
    f32x4 w[8];
#pragma unroll
    for (int i = 0; i < 8; ++i) w[i] = *(const f32x4*)(cw + 4 * i);
#pragma unroll
    for (int j = 0; j < 4; ++j) { if (tpos - 3 + j >= 0) { float x[8]; unpack8(*(const v4u*)(p - (ptrdiff_t)(3 - j) * PP), x);
#pragma unroll
        for (int i = 0; i < 8; ++i) acc[i] += x[i] * w[i][j]; } }
#pragma unroll
    for (int i = 0; i < 8; ++i) out[i] = silu_f(acc[i]);
}
DI void ssd_pass1(KA a, int L, int b, int c, int g, LAS unsigned char* lds, int tid, int wave, int lane) {
    OPQ(lane); OPQ(tid);
    LAS bf16* XwT = (LAS bf16*)lds; LAS bf16* BT = (LAS bf16*)(lds + 34816);
    LAS float* dtv = (LAS float*)(lds + SSD_DT); LAS float* acs = (LAS float*)(lds + SSD_ACS);
    const bf16* PROJ = (const bf16*)(a->ws + WS_PROJ); float* ST = (float*)(a->ws + WS_ST); float* CD = (float*)(a->ws + WS_CD);
    const int tok0 = b * SEQ + c * 128;
    ssd_dt(a, L, g, tok0, lds, tid);
    { const int t = tid >> 2, qd = tid & 3, tpos = c * 128 + t; const bf16* rowp = PROJ + (size_t)(tok0 + t) * PP;
      const float* cwb = a->in[I_CONVW] + (size_t)L * 768 * 4; const float* cbb = a->in[I_CONVB] + L * 768;
#pragma unroll
      for (int grp = 0; grp < 4; ++grp) { const int ch = qd * 32 + grp * 8, hh = ch >> 6; float x8[8];
          conv8(rowp + C_XS + g * 128 + ch, tpos, cwb + (g * 128 + ch) * 4, cbb + g * 128 + ch, x8);
          const float wgt = dtv[t * 2 + hh] * expf(acs[127 * 2 + hh] - acs[t * 2 + hh]);
#pragma unroll
          for (int i = 0; i < 8; ++i) XwT[(ch + i) * 136 + t] = f2b(x8[i] * wgt);
          conv8(rowp + C_B + g * 128 + ch, tpos, cwb + (256 + g * 128 + ch) * 4, cbb + 256 + g * 128 + ch, x8);
#pragma unroll
          for (int i = 0; i < 8; ++i) BT[(ch + i) * 136 + t] = f2b(x8[i]); } }
    __syncthreads();
    { const int rt = wave >> 1, r = lane & 31, lh = lane >> 5, hh = rt >> 1, h = 2 * g + hh;
#pragma unroll
      for (int q = 0; q < 2; ++q) { const int ct = (wave & 1) * 2 + q; f32x16 acc = {}; acc = mma_tile(XwT + rt * 32 * 136, 136, BT + ct * 32 * 136, 136, 128, acc, r, lh);
#pragma unroll
          for (int reg = 0; reg < 16; ++reg) { const int p = (rt & 1) * 32 + crow(reg, lh); ST[((size_t)((b * 16 + c) * 4 + h) * 64 + p) * 128 + ct * 32 + r] = acc[reg]; } } }
    if (tid < 2) CD[(b * 16 + c) * 4 + 2 * g + tid] = expf(acs[127 * 2 + tid]);
    __syncthreads();
}
DI void ssd_pass2(KA a, int L, int b, int c, int g, LAS unsigned char* lds, int tid, int wave, int lane) {
    OPQ(lane); OPQ(tid);
    LAS bf16* Cm = (LAS bf16*)lds; LAS bf16* Bm = (LAS bf16*)(lds + 34816); LAS bf16* XT = (LAS bf16*)(lds + 69632); LAS bf16* PV = (LAS bf16*)(lds + 104448);
    LAS float* dtv = (LAS float*)(lds + SSD_DT); LAS float* acs = (LAS float*)(lds + SSD_ACS);
    const bf16* PROJ = (const bf16*)(a->ws + WS_PROJ); const float* ST = (const float*)(a->ws + WS_ST); const float* CD = (const float*)(a->ws + WS_CD); bf16* MIX = (bf16*)(a->ws + WS_MIX);
    const int tok0 = b * SEQ + c * 128, r = lane & 31, lh = lane >> 5;
    ssd_dt(a, L, g, tok0, lds, tid);
    { const int t = tid >> 2, qd = tid & 3, tpos = c * 128 + t; const bf16* rowp = PROJ + (size_t)(tok0 + t) * PP;
      const float* cwb = a->in[I_CONVW] + (size_t)L * 768 * 4; const float* cbb = a->in[I_CONVB] + L * 768;
#pragma unroll
      for (int grp = 0; grp < 4; ++grp) { const int ch = qd * 32 + grp * 8; float x8[8];
          conv8(rowp + C_XS + g * 128 + ch, tpos, cwb + (g * 128 + ch) * 4, cbb + g * 128 + ch, x8);
#pragma unroll
          for (int i = 0; i < 8; ++i) XT[(ch + i) * 136 + t] = f2b(x8[i]);
          conv8(rowp + C_B + g * 128 + ch, tpos, cwb + (256 + g * 128 + ch) * 4, cbb + 256 + g * 128 + ch, x8);
          *(LAS v4u*)(Bm + t * 136 + ch) = pack8(x8);
          conv8(rowp + C_C + g * 128 + ch, tpos, cwb + (512 + g * 128 + ch) * 4, cbb + 512 + g * 128 + ch, x8);
          *(LAS v4u*)(Cm + t * 136 + ch) = pack8(x8); } }
    { const int row = tid >> 2, n0 = (tid & 3) * 32, hh = row >> 6, p = row & 63, h = 2 * g + hh;
      float pv[32];
#pragma unroll
      for (int i = 0; i < 32; ++i) pv[i] = 0.f;
      for (int jc = 0; jc < c; ++jc) { const float dec = CD[(b * 16 + jc) * 4 + h]; const f32x4* sp = (const f32x4*)(ST + ((size_t)((b * 16 + jc) * 4 + h) * 64 + p) * 128 + n0);
#pragma unroll
          for (int i = 0; i < 8; ++i) { const f32x4 s4 = sp[i]; pv[4 * i] = pv[4 * i] * dec + s4.x; pv[4 * i + 1] = pv[4 * i + 1] * dec + s4.y; pv[4 * i + 2] = pv[4 * i + 2] * dec + s4.z; pv[4 * i + 3] = pv[4 * i + 3] * dec + s4.w; } }
#pragma unroll
      for (int i = 0; i < 4; ++i) *(LAS v4u*)(PV + row * 136 + n0 + 8 * i) = pack8(pv + 8 * i); }
    __syncthreads();
    const int lt = wave >> 1, pt = wave & 1;
    f32x16 cb[2];
#pragma unroll
    for (int q = 0; q < 2; ++q) { const int st = (wave & 1) * 2 + q; cb[q] = (f32x16){}; if (st <= lt) cb[q] = mma_tile(Cm + lt * 32 * 136, 136, Bm + st * 32 * 136, 136, 128, cb[q], r, lh); }
    f32x16 y[2];
#pragma unroll
    for (int hh = 0; hh < 2; ++hh) {
        __syncthreads();
#pragma unroll
        for (int q = 0; q < 2; ++q) { const int s = ((wave & 1) * 2 + q) * 32 + r; const float as = acs[s * 2 + hh], ds = dtv[s * 2 + hh];
#pragma unroll
            for (int reg = 0; reg < 16; ++reg) { const int l = lt * 32 + crow(reg, lh); const float val = (s <= l) ? cb[q][reg] * expf(acs[l * 2 + hh] - as) * ds : 0.f; Bm[l * 136 + s] = f2b(val); } }
        __syncthreads();
        f32x16 a1 = {}, a2 = {};
        a1 = mma_tile(Bm + lt * 32 * 136, 136, XT + (hh * 64 + pt * 32) * 136, 136, 32 * (lt + 1), a1, r, lh);
        a2 = mma_tile(Cm + lt * 32 * 136, 136, PV + (hh * 64 + pt * 32) * 136, 136, 128, a2, r, lh);
        const int ch = hh * 64 + pt * 32 + r; const float Dh = a->in[I_SSMD][L * 4 + 2 * g + hh];
#pragma unroll
        for (int reg = 0; reg < 16; ++reg) { const int l = lt * 32 + crow(reg, lh); const float xsv = bf2f(XT[ch * 136 + l]); const float zz = bf2f(PROJ[(size_t)(tok0 + l) * PP + C_Z + g * 128 + ch]);
            const float yv = a1[reg] + expf(acs[l * 2 + hh]) * a2[reg] + Dh * xsv; y[hh][reg] = yv * silu_f(zz); }
    }
    __syncthreads();
    LAS float* ybuf = (LAS float*)lds;
#pragma unroll
    for (int hh = 0; hh < 2; ++hh)
#pragma unroll
        for (int reg = 0; reg < 16; ++reg) { const int l = lt * 32 + crow(reg, lh); ybuf[l * 129 + hh * 64 + pt * 32 + r] = y[hh][reg]; }
    __syncthreads();
    { const int t = tid >> 2, ch0 = (tid & 3) * 32; float v[32]; float ss = 0.f;
#pragma unroll
      for (int i = 0; i < 32; ++i) { v[i] = ybuf[t * 129 + ch0 + i]; ss += v[i] * v[i]; }
      ss += __shfl_xor(ss, 1); ss += __shfl_xor(ss, 2);
      const float rstd = 1.0f / sqrtf(ss * (1.0f / 128.0f) + EPS); const float* nw = a->in[I_SSMNW] + L * 256 + g * 128 + ch0;
#pragma unroll
      for (int i = 0; i < 32; ++i) v[i] = v[i] * rstd * nw[i];
      bf16* op = MIX + (size_t)(tok0 + t) * DM + 256 + g * 128 + ch0;
#pragma unroll
      for (int i = 0; i < 4; ++i) *(v4u*)(op + 8 * i) = pack8(v + 8 * i); }
    __syncthreads();
}
DI void attn_wave(KA a, int L, int b, int h, int j, int lane) {
    OPQ(lane);
    const bf16* PROJ = (const bf16*)(a->ws + WS_PROJ); const bf16* VT = (const bf16*)(a->ws + WS_VT); bf16* MIX = (bf16*)(a->ws + WS_MIX);
    const int r = lane & 31, lh = lane >> 5; const size_t tokb = (size_t)b * SEQ;
    float p1 = 0.f, p2 = 0.f;
    if (lane < 32) { p1 = a->in[I_LQ1][L * 32 + lane] * a->in[I_LK1][L * 32 + lane]; p2 = a->in[I_LQ2][L * 32 + lane] * a->in[I_LK2][L * 32 + lane]; }
    p1 = wave_sum(p1); p2 = wave_sum(p2);
    const float lam_init = (L == 0) ? 0.2f : 0.35550906f;
    const float lam = expf(p1) - expf(p2) + lam_init;
    const float slope2 = exp2f(-2.0f * (float)(h + 1)) * LOG2E;
    const bf16* qp = PROJ + (tokb + j * 32 + r) * PP + C_Q + h * 64 + 8 * lh;
    bf16x8 qf[2][2];
#pragma unroll
    for (int c = 0; c < 2; ++c)
#pragma unroll
        for (int s = 0; s < 2; ++s) qf[c][s] = *(const bf16x8*)(qp + c * 32 + s * 16);
    const bf16* kbase = PROJ + (tokb + r) * PP + C_K + h * 64 + 8 * lh;
    const bf16* vbase = VT + (size_t)(h * 64 + r) * M + tokb + 4 * lh;
    f32x16 o[2][2];
#pragma unroll
    for (int c = 0; c < 2; ++c)
#pragma unroll
        for (int d = 0; d < 2; ++d) o[c][d] = (f32x16){};
    float mrun[2] = {-1e30f, -1e30f}, lrun[2] = {0.f, 0.f};
    bf16x8 kf[2][2]; u32x2 vlo[2][2], vhi[2][2];
#define ATT_LOAD(KF, VLO, VHI, kt_) do { const bf16* kp_ = kbase + (size_t)(kt_) * 32 * PP; const bf16* vp_ = vbase + (kt_) * 32; \
        _Pragma("unroll") for (int c = 0; c < 2; ++c) _Pragma("unroll") for (int s = 0; s < 2; ++s) KF[c][s] = *(const bf16x8*)(kp_ + c * 32 + s * 16); \
        _Pragma("unroll") for (int d = 0; d < 2; ++d) _Pragma("unroll") for (int s = 0; s < 2; ++s) { VLO[d][s] = *(const u32x2*)(vp_ + (size_t)d * 32 * M + 16 * s); VHI[d][s] = *(const u32x2*)(vp_ + (size_t)d * 32 * M + 16 * s + 8); } } while (0)
    ATT_LOAD(kf, vlo, vhi, 0);
    const int qpos = j * 32 + r;
    for (int kt = 0; kt <= j; ++kt) {
        bf16x8 kn[2][2]; u32x2 nlo[2][2], nhi[2][2];
        const int ktn = kt < j ? kt + 1 : kt;
        ATT_LOAD(kn, nlo, nhi, ktn);
        const int key0 = kt * 32;
#pragma unroll
        for (int c = 0; c < 2; ++c) {
            f32x16 S = {}; S = MFMA32(kf[c][0], qf[c][0], S); S = MFMA32(kf[c][1], qf[c][1], S);
            float mx = -INFINITY;
#pragma unroll
            for (int reg = 0; reg < 16; ++reg) { const int dist = qpos - (key0 + crow(reg, lh)); float v = S[reg] - slope2 * (float)dist; v = dist < 0 ? -INFINITY : v; S[reg] = v; mx = fmaxf(mx, v); }
            mx = fmaxf(mx, __shfl_xor(mx, 32));
            const float mnew = fmaxf(mrun[c], mx), alpha = __builtin_amdgcn_exp2f(mrun[c] - mnew);
            float rs = 0.f;
#pragma unroll
            for (int reg = 0; reg < 16; ++reg) { S[reg] = __builtin_amdgcn_exp2f(S[reg] - mnew); rs += S[reg]; }
            rs += __shfl_xor(rs, 32);
            lrun[c] = lrun[c] * alpha + rs; mrun[c] = mnew;
            u32x4 w0, w1;
            w0.x = pk2(S[0], S[1]); w0.y = pk2(S[2], S[3]); w0.z = pk2(S[4], S[5]); w0.w = pk2(S[6], S[7]);
            w1.x = pk2(S[8], S[9]); w1.y = pk2(S[10], S[11]); w1.z = pk2(S[12], S[13]); w1.w = pk2(S[14], S[15]);
            const bf16x8 pb0 = __builtin_bit_cast(bf16x8, w0), pb1 = __builtin_bit_cast(bf16x8, w1);
#pragma unroll
            for (int d = 0; d < 2; ++d) {
                o[c][d] = o[c][d] * alpha;
                const u32x4 v0 = (u32x4){vlo[d][0].x, vlo[d][0].y, vhi[d][0].x, vhi[d][0].y}, v1 = (u32x4){vlo[d][1].x, vlo[d][1].y, vhi[d][1].x, vhi[d][1].y};
                o[c][d] = MFMA32(__builtin_bit_cast(bf16x8, v0), pb0, o[c][d]);
                o[c][d] = MFMA32(__builtin_bit_cast(bf16x8, v1), pb1, o[c][d]);
            }
        }
#pragma unroll
        for (int c = 0; c < 2; ++c)
#pragma unroll
            for (int s = 0; s < 2; ++s) { kf[c][s] = kn[c][s]; vlo[c][s] = nlo[c][s]; vhi[c][s] = nhi[c][s]; }
    }
#undef ATT_LOAD
    const float inv0 = 1.0f / lrun[0], inv1 = lam / lrun[1];
    float ss = 0.f;
#pragma unroll
    for (int d = 0; d < 2; ++d)
#pragma unroll
        for (int reg = 0; reg < 16; ++reg) { const float v = o[0][d][reg] * inv0 - o[1][d][reg] * inv1; o[0][d][reg] = v; ss += v * v; }
    ss += __shfl_xor(ss, 32);
    const float rstd = (1.0f - lam_init) / sqrtf(ss * (1.0f / 64.0f) + EPS);
    bf16* op = MIX + (tokb + j * 32 + r) * DM + 768 + h * 64;
#pragma unroll
    for (int d = 0; d < 2; ++d)
#pragma unroll
        for (int g4 = 0; g4 < 4; ++g4) { const int d0 = d * 32 + 8 * g4 + 4 * lh; const f32x4 w4 = *(const f32x4*)(a->in[I_SUBLN] + L * 64 + d0);
            u32x2 pk; pk.x = pk2(o[0][d][4 * g4] * rstd * w4.x, o[0][d][4 * g4 + 1] * rstd * w4.y); pk.y = pk2(o[0][d][4 * g4 + 2] * rstd * w4.z, o[0][d][4 * g4 + 3] * rstd * w4.w);
            *(u32x2*)(op + d0) = pk; }
}

#ifndef DIS_SSD1
#define DIS_SSD1 0
#endif
#ifndef DIS_SSD2
#define DIS_SSD2 0
#endif
#ifndef DIS_GMLP
#define DIS_GMLP 0
#endif
#ifndef DIS_POOL
#define DIS_POOL 0
#endif
#ifndef DIS_ATTN
#define DIS_ATTN 0
#endif
#ifndef DIS_GEMM
#define DIS_GEMM 0
#endif
#ifndef MK_SPLIT
#define MK_SPLIT 0
#endif
constexpr int N_PHASES = 16;
__global__ void __launch_bounds__(NWAVES * 64, 2) hybrid_fwd(Args args) {
    extern __shared__ __attribute__((aligned(16))) unsigned char lds_raw[];
    LAS unsigned char* lds = (LAS unsigned char*)lds_raw;
    const int tid = threadIdx.x, lane = tid & 63, wave = __builtin_amdgcn_readfirstlane(tid >> 6);
    const int G = gridDim.x; const int bx = blockIdx.x; const int vcu = (G % 8 == 0) ? (bx % 8) * (G / 8) + bx / 8 : bx;
    for (int u = tid; u < (LDS_BYTES - LDSCTL_OFF) / 4; u += NWAVES * 64) ((LAS unsigned*)(lds + LDSCTL_OFF))[u] = 0u;
    __syncthreads();
    int lo, hi;
    XcdBarrier bar;
    { KA ka = kargs(); lo = ka->ph_lo; hi = ka->ph_hi; gu32* ctl = (gu32*)(ka->ws + WS_CTL);
      bar.bar = (unsigned*)(ctl + CW_BAR); bar.x = 0; bar.st = nullptr;
      if (!MK_SPLIT) bar = xcd_barrier_post((unsigned*)(ctl + CW_BAR), (volatile LAS unsigned*)(lds + MISC_OFF) + 8); }
#define IN(k) (lo <= (k) && (k) < hi)
#define SEAM(k) do { if (IN(k) && IN((k) + 1)) xcd_barrier(bar); } while (0)
    if (IN(0)) { KA ka = kargs(); weights_phase(ka, lds, vcu, G, wave, lane); __syncthreads();
        norm_phase(ka->in[I_X], ka->in[I_N1W], (bf16*)(ka->ws + WS_XN), true, ka->in[I_WIN], (float*)(ka->ws + WS_DT), lds, vcu, G, wave, lane, tid); }
    SEAM(0);
#pragma unroll 1
    for (int L = 0; L < DEPTH; ++L) {
        const int pb = 1 + 8 * L;
        if (IN(pb)) { KA ka = kargs(); unsigned char* ws = ka->ws; const bf16* wb = (const bf16*)(ws + WS_W + (size_t)L * W_LAYER + W_IN); const bf16* XN = (const bf16*)(ws + WS_XN);
            { pg8::Gemm g{XN, wb, M, PP, DM}; pg8::StaticOrder S; S.init(M, PP, G, bx);
              pg8::EpiInProj E{(bf16*)(ws + WS_PROJ), ka->in[I_QNW] + L * 32, ka->in[I_KNW] + L * 32};
              pg8::gemm_phase<pg8::EpiInProj, pg8::StaticOrder, true, true>(lds, g, S, E); }
            { pg8::Gemm g{wb + (size_t)PP * DM, XN, 256, M, DM}; pg8::StaticOrder S; S.init(256, M, G, (bx + 192) % G);
              pg8::EpiBf16<0> E{(bf16*)(ws + WS_VT), M, nullptr, 0, 0, 1.f};
              pg8::gemm_phase<pg8::EpiBf16<0>, pg8::StaticOrder, true, true>(lds, g, S, E); }
        }
        SEAM(pb);
        if (IN(pb + 1)) { KA ka = kargs();
            __syncthreads();
            if (!DIS_SSD1) for (int it = vcu; it < 256; it += G) ssd_pass1(ka, L, it >> 5, (it >> 1) & 15, it & 1, lds, tid, wave, lane);
            if (!DIS_GMLP) for (int it = vcu; it < 512; it += G) gmlp_item(ka, L, it >> 6, (it >> 2) & 15, it & 3, lds, tid, wave, lane);
            if (!DIS_POOL) for (int it = vcu; it < 512; it += G) pool_item(ka, L, it >> 6, (it >> 2) & 15, it & 3, lds, tid, wave, lane);
        }
        SEAM(pb + 1);
        if (IN(pb + 2)) { KA ka = kargs();
            __syncthreads();
            if (!DIS_SSD2) for (int it = vcu; it < 256; it += G) ssd_pass2(ka, L, it >> 5, (it >> 1) & 15, it & 1, lds, tid, wave, lane);
            if (!DIS_ATTN) for (int it = vcu; it < 256; it += G) { const int s = it & 7, jj = s * 4 + (wave & 3); attn_wave(ka, L, it >> 5, (it >> 3) & 3, wave < 4 ? jj : 63 - jj, lane); }
        }
        SEAM(pb + 2);
        if (IN(pb + 3)) { KA ka = kargs(); unsigned char* ws = ka->ws;
            pg8::Gemm g{(const bf16*)(ws + WS_MIX), (const bf16*)(ws + WS_W + (size_t)L * W_LAYER + W_OUT), M, DM, DM}; pg8::StaticOrder S; S.init(M, DM, G, bx);
            pg8::EpiResid E{(L == 0) ? ka->in[I_X] : (const float*)ka->out, ka->out};
            pg8::gemm_phase<pg8::EpiResid, pg8::StaticOrder, false, true>(lds, g, S, E); }
        SEAM(pb + 3);
        if (IN(pb + 4)) { KA ka = kargs(); norm_phase(ka->out, ka->in[I_N2W] + L * DM, (bf16*)(ka->ws + WS_XN), false, nullptr, nullptr, lds, vcu, G, wave, lane, tid); }
        SEAM(pb + 4);
        if (IN(pb + 5)) { KA ka = kargs(); unsigned char* ws = ka->ws;
            pg8::Gemm g{(const bf16*)(ws + WS_XN), (const bf16*)(ws + WS_W + (size_t)L * W_LAYER + W_GU), M, NGU, DM}; pg8::StaticOrder S; S.init(M, NGU, G, bx);
            pg8::EpiSwiGLU E{(bf16*)(ws + WS_H)};
            pg8::gemm_phase<pg8::EpiSwiGLU, pg8::StaticOrder, true, true>(lds, g, S, E); }
        SEAM(pb + 5);
        if (IN(pb + 6)) { KA ka = kargs(); unsigned char* ws = ka->ws;
            pg8::Gemm g{(const bf16*)(ws + WS_H), (const bf16*)(ws + WS_W + (size_t)L * W_LAYER + W_DN), M, DM, DFF}; pg8::StaticOrder S; S.init(M, DM, G, bx);
            pg8::EpiResid E{ka->out, ka->out};
            pg8::gemm_phase<pg8::EpiResid, pg8::StaticOrder, false, true>(lds, g, S, E); }
        if (L + 1 < DEPTH) {
            SEAM(pb + 6);
            if (IN(pb + 7)) { KA ka = kargs(); norm_phase(ka->out, ka->in[I_N1W] + (L + 1) * DM, (bf16*)(ka->ws + WS_XN), true, ka->in[I_WIN] + (size_t)(L + 1) * DM * DIN, (float*)(ka->ws + WS_DT), lds, vcu, G, wave, lane, tid); }
            SEAM(pb + 7);
        }
    }
#undef IN
#undef SEAM
}

extern "C" void kernel_launch(void* const* d_in, const int* in_sizes, int n_in, void* d_out, int out_size, void* d_ws, size_t ws_size, hipStream_t stream) {
    static int grid = 0;
    if (grid == 0) {
        if (n_in != N_IN || in_sizes[0] != M * DM || out_size != M * DM || ws_size < WS_END) { fprintf(stderr, "kernel_launch: unexpected problem shape (n_in %d, in0 %d, out %d, ws %zu); nothing launched\n", n_in, n_in > 0 ? in_sizes[0] : -1, out_size, ws_size); grid = -1; return; }
        int dev = 0, cus = 0;
        if (hipGetDevice(&dev) != hipSuccess || hipDeviceGetAttribute(&cus, hipDeviceAttributeMultiprocessorCount, dev) != hipSuccess) { grid = -1; return; }
        if (hipFuncSetAttribute((const void*)hybrid_fwd, hipFuncAttributeMaxDynamicSharedMemorySize, LDS_BYTES) != hipSuccess) { fprintf(stderr, "kernel_launch: hipFuncSetAttribute failed\n"); grid = -1; return; }
        int per_cu = 0;
        if (hipOccupancyMaxActiveBlocksPerMultiprocessor(&per_cu, (const void*)hybrid_fwd, NWAVES * 64, LDS_BYTES) != hipSuccess || per_cu < 1) fprintf(stderr, "kernel_launch: occupancy query reports %d\n", per_cu);
        (void)hipGetLastError();
        grid = cus;
    }
    if (grid < 0) return;
    (void)hipMemsetAsync((char*)d_ws + WS_CTL, 0, CTL_ZERO_BYTES, stream);
    Args a{};
    for (int i = 0; i < N_IN; ++i) a.in[i] = (const float*)d_in[i];
    a.out = (float*)d_out; a.ws = (unsigned char*)d_ws;
#if MK_SPLIT
    for (int p = 0; p < N_PHASES; ++p) { a.ph_lo = p; a.ph_hi = p + 1; hipLaunchKernelGGL(hybrid_fwd, dim3(grid), dim3(NWAVES * 64), LDS_BYTES, stream, a); }
#else
    a.ph_lo = 0; a.ph_hi = N_PHASES;
    hipLaunchKernelGGL(hybrid_fwd, dim3(grid), dim3(NWAVES * 64), LDS_BYTES, stream, a);
#endif
}
```

```cpp
#include <hip/hip_runtime.h>
#include <cstdio>
#include <cstdint>
#include <cmath>
namespace pg8 {
#define PG8_LAS __attribute__((address_space(3)))
typedef unsigned short bf16_t;
typedef short bf16x8 __attribute__((ext_vector_type(8)));
typedef float f32x4 __attribute__((ext_vector_type(4)));
typedef unsigned u32x4 __attribute__((ext_vector_type(4)));
constexpr int BM = 256, BK = 64, HALF = 128, HTB = HALF * BK * 2  , STAGE_BYTES = 8 * HTB, NXCD = 8, WGM = 8;

__host__ __device__ __forceinline__ int lds_byte(int r, int c) { const int st = (r >> 4) * 2 + (c >> 5), rr = r & 15, cc = c & 31, ob = rr * 64 + cc * 2; return st * 1024 + (ob ^ (((ob >> 9) & 1) << 5)); }
__host__ __device__ __forceinline__ void stage_rc(int b, int& R, int& C) { const int st = b / 1024, sb = b % 1024, swz = sb ^ (((sb >> 9) & 1) << 5); R = (st >> 1) * 16 + swz / 64; C = (st & 1) * 32 + (swz % 64) / 2; }
__host__ __device__ __forceinline__ int perm32(int rho) { const int n = rho >> 4, i = rho & 15; return 8 * (i >> 2) + 4 * n + (i & 3); }

struct Unit { int pm, pn; };
struct Gemm { const bf16_t* A; const bf16_t* Bt; int M, N, K; };

struct StaticOrder {
    int nM, nN, nwg, G, c;
    __host__ __device__ void init(int M, int N, int G_, int c_) { nM = M / BM; nN = N / BM; nwg = nM * nN; G = G_; c = c_; }
    __host__ __device__ bool next(int i, Unit& u) const {
        const long L = (long)i * G + c; if (L >= nwg) return false;
        int wgid = (int)L; { const int q = nwg / NXCD, r = nwg % NXCD, xcd = wgid % NXCD, off = wgid / NXCD; wgid = (xcd < r ? xcd * (q + 1) : r * (q + 1) + (xcd - r) * q) + off; }
        const int nig = WGM * nN, gid = wgid / nig, fm = gid * WGM, gsz = (nM - fm) < WGM ? (nM - fm) : WGM;
        u.pm = fm + ((wgid % nig) % gsz); u.pn = (wgid % nig) / gsz; return true;
    }
    __device__ __forceinline__ void a_ready(const Unit&) const {}
    __device__ __forceinline__ void done(const Unit&) const {}
};

__device__ __forceinline__ unsigned cvt_pk_bf16(float lo, float hi) { unsigned r; asm volatile("v_cvt_pk_bf16_f32 %0, %1, %2" : "=v"(r) : "v"(lo), "v"(hi)); return r; }
typedef float f32x2 __attribute__((ext_vector_type(2)));
__device__ __forceinline__ f32x2 gelu_pk(f32x2 v) {
    const f32x2 av = __builtin_elementwise_abs(v), d = av * 0.2316418882f + 1.0f;
    f32x2 t; t.x = __builtin_amdgcn_rcpf(d.x); t.y = __builtin_amdgcn_rcpf(d.y);
    f32x2 q = t * 0.5307027145f + (-0.7265760135f); q = q * t + 0.7107068705f; q = q * t + (-0.142248368f); q = q * t + 0.127414796f; q = q * t;
    const f32x2 s = (v * v) * (-0.72134752044f);
    f32x2 e; e.x = __builtin_amdgcn_exp2f(s.x); e.y = __builtin_amdgcn_exp2f(s.y);
    const f32x2 m = v * (q * e), r = v - m;
    f32x2 o; o.x = v.x < 0.f ? m.x : r.x; o.y = v.y < 0.f ? m.y : r.y; return o;
}

template <int ACT  > struct EpiBf16 {
    static constexpr bool PERM = true, AFTER_DRAIN = false; static_assert(ACT == 0 || ACT == 1, "EpiBf16: ACT is 0 (none) or 1 (gelu_pk)");
    bf16_t* O; int ldc; const float* bias; int split_cols; size_t split_stride; float scale0;
    __device__ __forceinline__ void operator()(const f32x4 (&acc)[2][2][4][2], const Unit& u, int wr, int wc, int fr, int fq) const {
        const int row0 = u.pm * BM + wr * 64 + fr; int colt = u.pn * BM; bf16_t* base = O;
        float sc = 1.f; if (split_cols) { const int t = colt / split_cols; base += (size_t)t * split_stride; colt -= t * split_cols; if (t == 0) sc = scale0; }
        const int col0 = colt + wc * 32 + 8 * fq, bcol0 = u.pn * BM + wc * 32 + 8 * fq;
        f32x4 bv[2][2];
#pragma unroll
        for (int bj = 0; bj < 2; ++bj)
#pragma unroll
            for (int n = 0; n < 2; ++n) bv[bj][n] = bias ? *(const f32x4*)(bias + bcol0 + bj * HALF + 4 * n) : (f32x4){0.f, 0.f, 0.f, 0.f};
#pragma unroll
        for (int ai = 0; ai < 2; ++ai)
#pragma unroll
            for (int m = 0; m < 4; ++m) { bf16_t* rowp = base + (size_t)(row0 + ai * HALF + m * 16) * ldc + col0;
#pragma unroll
                for (int bj = 0; bj < 2; ++bj) { f32x4 v0 = acc[ai][bj][m][0] + bv[bj][0], v1 = acc[ai][bj][m][1] + bv[bj][1];
                    if (ACT == 1) { f32x2 a = gelu_pk((f32x2){v0[0], v0[1]}), b = gelu_pk((f32x2){v0[2], v0[3]}), c = gelu_pk((f32x2){v1[0], v1[1]}), d = gelu_pk((f32x2){v1[2], v1[3]});
                        v0 = (f32x4){a.x, a.y, b.x, b.y}; v1 = (f32x4){c.x, c.y, d.x, d.y}; }
                    v0 = v0 * sc; v1 = v1 * sc; u32x4 w; w.x = cvt_pk_bf16(v0[0], v0[1]); w.y = cvt_pk_bf16(v0[2], v0[3]); w.z = cvt_pk_bf16(v1[0], v1[1]); w.w = cvt_pk_bf16(v1[2], v1[3]);
                    *(u32x4*)(rowp + bj * HALF) = w; } }
    }
};
template <class Epi, class Sched, bool ALIGN_EPI = false, bool SP2 = false>
__device__ __forceinline__ void gemm_phase(PG8_LAS unsigned char* lds, const Gemm g, const Sched& S, const Epi& E) {
    int tid_ = threadIdx.x; asm volatile("" : "+v"(tid_));
    const int tid = tid_, wid = __builtin_amdgcn_readfirstlane(tid >> 6), lane = tid & 63, wr = wid >> 2, wc = wid & 3, fr = lane & 15, fq = lane >> 4;
    const int K = g.K, nt = K / BK;
    unsigned voffA[2], voffB[2];
#pragma unroll
    for (int i = 0; i < 2; ++i) { int R, C; stage_rc(tid * 16 + i * 8192, R, C); const int Rb = Epi::PERM ? ((R & ~31) + perm32(R & 31)) : R;
        voffA[i] = (unsigned)(R * K + C) * 2u; voffB[i] = (unsigned)(Rb * K + C) * 2u; }
    const size_t kstep = (size_t)(BK * 2);
    const size_t hstep = (size_t)HALF * K * 2;
    const size_t tstep = 2 * hstep;
    const unsigned ldsw = (unsigned)wid * 1024u;
    const int aoff = lds_byte(wr * 64 + fr, fq * 8), boff = lds_byte(wc * 32 + fr, fq * 8);
#define PG8_SA(b, h) (((b) * 2 + (h)) * HTB)
#define PG8_SB(b, h) ((4 + (b) * 2 + (h)) * HTB)
#define PG8_STAGE(bufoff, gbase, voff) do { _Pragma("unroll") for (int _i = 0; _i < 2; ++_i) \
        __builtin_amdgcn_global_load_lds((const unsigned*)((const char*)(gbase) + (voff)[_i]), (PG8_LAS unsigned*)(lds + (bufoff) + ldsw + _i * 8192), 16, 0, 0); } while (0)
#define PG8_LDA(dst, b, h) do { _Pragma("unroll") for (int m = 0; m < 4; ++m) _Pragma("unroll") for (int k = 0; k < 2; ++k) dst[m][k] = *(const PG8_LAS bf16x8*)(lds + PG8_SA(b, h) + aoff + m * 2048 + k * 1024); } while (0)
#define PG8_LDB(dst, b, h) do { _Pragma("unroll") for (int n = 0; n < 2; ++n) _Pragma("unroll") for (int k = 0; k < 2; ++k) dst[n][k] = *(const PG8_LAS bf16x8*)(lds + PG8_SB(b, h) + boff + n * 2048 + k * 1024); } while (0)
#define PG8_MMA(ai, bj, At, Bt) do { __builtin_amdgcn_s_setprio(1); _Pragma("unroll") for (int m = 0; m < 4; ++m) _Pragma("unroll") for (int n = 0; n < 2; ++n) _Pragma("unroll") for (int k = 0; k < 2; ++k) \
        acc[ai][bj][m][n] = __builtin_amdgcn_mfma_f32_16x16x32_bf16(Bt[n][k], At[m][k], acc[ai][bj][m][n], 0, 0, 0); __builtin_amdgcn_s_setprio(0); } while (0)
#define PG8_WAIT_V(n) asm volatile("s_waitcnt vmcnt(" #n ")" ::: "memory")
#define PG8_WAIT_L(n) asm volatile("s_waitcnt lgkmcnt(" #n ")" ::: "memory")
#define PG8_BAR __builtin_amdgcn_s_barrier()
#define PG8_SCHED __builtin_amdgcn_sched_barrier(0)
    Unit cur, nxt; int ui = 0;
    if (!S.next(0, cur)) return;
    f32x4 acc[2][2][4][2];
#pragma unroll
    for (int a = 0; a < 2; ++a)
#pragma unroll
        for (int b = 0; b < 2; ++b)
#pragma unroll
            for (int m = 0; m < 4; ++m)
#pragma unroll
                for (int n = 0; n < 2; ++n) acc[a][b][m][n] = (f32x4){0.f, 0.f, 0.f, 0.f};
    bf16x8 At[4][2], B0[2][2], B1[2][2];
    const char* cA = (const char*)g.A + (size_t)cur.pm * tstep; const char* cB = (const char*)g.Bt + (size_t)cur.pn * tstep;
    S.a_ready(cur);
    if constexpr (SP2) {
        PG8_STAGE(PG8_SB(0, 0), cB, voffB); PG8_STAGE(PG8_SB(0, 1), cB + hstep, voffB); PG8_STAGE(PG8_SA(0, 0), cA, voffA); PG8_STAGE(PG8_SA(0, 1), cA + hstep, voffA);
        if (wr == 1) PG8_BAR;
        PG8_WAIT_V(2); PG8_BAR;
        PG8_STAGE(PG8_SB(1, 0), cB + kstep, voffB); PG8_STAGE(PG8_SA(1, 0), cA + kstep, voffA); PG8_STAGE(PG8_SB(1, 1), cB + hstep + kstep, voffB);
        PG8_WAIT_V(6); PG8_BAR;
    } else {
        PG8_STAGE(PG8_SB(0, 0), cB, voffB); PG8_STAGE(PG8_SA(0, 0), cA, voffA); PG8_STAGE(PG8_SB(0, 1), cB + hstep, voffB); PG8_STAGE(PG8_SA(0, 1), cA + hstep, voffA);
        if (wr == 1) PG8_BAR;
        PG8_WAIT_V(4); PG8_BAR;
        PG8_STAGE(PG8_SB(1, 0), cB + kstep, voffB); PG8_STAGE(PG8_SA(1, 0), cA + kstep, voffA); PG8_STAGE(PG8_SB(1, 1), cB + hstep + kstep, voffB);
        PG8_WAIT_V(6); PG8_BAR;
    }
    for (;;) {
        const bool has_next = S.next(ui + 1, nxt);
        const char* nA = has_next ? (const char*)g.A + (size_t)nxt.pm * tstep : cA; const char* nB = has_next ? (const char*)g.Bt + (size_t)nxt.pn * tstep : cB;
        for (int t = 0; t < nt; t += 2) {
            const bool last = (t == nt - 2);
            const char* a1 = cA + (size_t)(t + 1) * kstep;
            const char* a2 = last ? nA : cA + (size_t)(t + 2) * kstep; const char* b2 = last ? nB : cB + (size_t)(t + 2) * kstep;
            const char* a3 = a2 + kstep; const char* b3 = b2 + kstep;
            if (last && has_next) S.a_ready(nxt);
            if constexpr (SP2) {
            PG8_LDB(B0, 0, 0); PG8_LDB(B1, 0, 1); PG8_SCHED; PG8_LDA(At, 0, 0); PG8_STAGE(PG8_SA(1, 1), a1 + hstep, voffA);
            PG8_WAIT_V(8); PG8_WAIT_L(0); PG8_BAR; PG8_MMA(0, 0, At, B0); PG8_MMA(0, 1, At, B1); PG8_BAR; PG8_SCHED;
            PG8_LDA(At, 0, 1); PG8_STAGE(PG8_SB(0, 0), b2, voffB); PG8_STAGE(PG8_SB(0, 1), b2 + hstep, voffB); PG8_STAGE(PG8_SA(0, 0), a2, voffA);
            PG8_WAIT_V(8); PG8_WAIT_L(0); PG8_BAR; PG8_MMA(1, 0, At, B0); PG8_MMA(1, 1, At, B1); PG8_BAR; PG8_SCHED;
            PG8_LDB(B0, 1, 0); PG8_LDB(B1, 1, 1); PG8_SCHED; PG8_LDA(At, 1, 0); PG8_STAGE(PG8_SA(0, 1), a2 + hstep, voffA);
            PG8_WAIT_V(8); PG8_WAIT_L(0); PG8_BAR; PG8_MMA(0, 0, At, B0); PG8_MMA(0, 1, At, B1); PG8_BAR; PG8_SCHED;
            PG8_LDA(At, 1, 1); PG8_STAGE(PG8_SB(1, 0), b3, voffB); PG8_STAGE(PG8_SB(1, 1), b3 + hstep, voffB); PG8_STAGE(PG8_SA(1, 0), a3, voffA);
            PG8_WAIT_V(8); PG8_WAIT_L(0); PG8_BAR; PG8_MMA(1, 0, At, B0); PG8_MMA(1, 1, At, B1); PG8_BAR; PG8_SCHED;
            } else {
            PG8_LDB(B0, 0, 0); PG8_SCHED; PG8_LDA(At, 0, 0); PG8_STAGE(PG8_SA(1, 1), a1 + hstep, voffA);
            PG8_WAIT_L(8); PG8_BAR; PG8_WAIT_L(0); PG8_MMA(0, 0, At, B0); PG8_BAR; PG8_SCHED;
            PG8_LDB(B1, 0, 1); PG8_STAGE(PG8_SB(0, 0), b2, voffB);
            PG8_BAR; PG8_WAIT_L(0); PG8_MMA(0, 1, At, B1); PG8_BAR;
            PG8_LDA(At, 0, 1); PG8_STAGE(PG8_SA(0, 0), a2, voffA);
            PG8_BAR; PG8_WAIT_L(0); PG8_MMA(1, 0, At, B0); PG8_BAR; PG8_SCHED;
            PG8_STAGE(PG8_SB(0, 1), b2 + hstep, voffB);
            PG8_WAIT_V(6); PG8_BAR; PG8_MMA(1, 1, At, B1); PG8_BAR;
            PG8_LDB(B0, 1, 0); PG8_SCHED; PG8_LDA(At, 1, 0); PG8_STAGE(PG8_SA(0, 1), a2 + hstep, voffA);
            PG8_WAIT_L(8); PG8_BAR; PG8_WAIT_L(0); PG8_MMA(0, 0, At, B0); PG8_BAR; PG8_SCHED;
            PG8_LDB(B1, 1, 1); PG8_STAGE(PG8_SB(1, 0), b3, voffB);
            PG8_BAR; PG8_WAIT_L(0); PG8_MMA(0, 1, At, B1); PG8_BAR;
            PG8_LDA(At, 1, 1); PG8_STAGE(PG8_SA(1, 0), a3, voffA);
            PG8_BAR; PG8_WAIT_L(0); PG8_MMA(1, 0, At, B0); PG8_BAR; PG8_SCHED;
            PG8_STAGE(PG8_SB(1, 1), b3 + hstep, voffB);
            PG8_WAIT_V(6); PG8_BAR; PG8_MMA(1, 1, At, B1); PG8_BAR;
            }
        }
        if constexpr (ALIGN_EPI) { if (wr == 0) PG8_BAR; }
        if constexpr (!Epi::AFTER_DRAIN) { E(acc, cur, wr, wc, fr, fq); S.done(cur); }
        if (!has_next) break;
#pragma unroll
        for (int a = 0; a < 2; ++a)
#pragma unroll
            for (int b = 0; b < 2; ++b)
#pragma unroll
                for (int m = 0; m < 4; ++m)
#pragma unroll
                    for (int n = 0; n < 2; ++n) acc[a][b][m][n] = (f32x4){0.f, 0.f, 0.f, 0.f};
        cur = nxt; cA = nA; cB = nB; ++ui;
        if constexpr (ALIGN_EPI) { if (wr == 1) PG8_BAR; }
    }
    PG8_WAIT_V(0);
    if constexpr (!ALIGN_EPI) { if (wr == 0) PG8_BAR; }
    PG8_BAR;
    if constexpr (Epi::AFTER_DRAIN) { E.fused(acc, cur, wr, wc, fr, fq, lds, wid, lane); S.done(cur); }
#undef PG8_SA
#undef PG8_SB
#undef PG8_STAGE
#undef PG8_LDA
#undef PG8_LDB
#undef PG8_MMA
#undef PG8_WAIT_V
#undef PG8_WAIT_L
#undef PG8_BAR
#undef PG8_SCHED
}
}
#define GAS __attribute__((address_space(1)))
#define LAS __attribute__((address_space(3)))
typedef unsigned short bf16;
typedef unsigned v4u __attribute__((ext_vector_type(4)));
typedef float f32x4 __attribute__((ext_vector_type(4)));
typedef short bf16x8 __attribute__((ext_vector_type(8)));
typedef GAS unsigned gu32;
typedef GAS unsigned long long gu64;
#define RLX_AGENT __ATOMIC_RELAXED, __HIP_MEMORY_SCOPE_AGENT
#define LDS_WAIT() asm volatile("s_waitcnt lgkmcnt(0)" ::: "memory")
#define VM_WAIT() asm volatile("s_waitcnt vmcnt(0)" ::: "memory")
__device__ __forceinline__ unsigned long long rt() { return __builtin_amdgcn_s_memrealtime(); }
__device__ __forceinline__ unsigned f2bf(float f) { unsigned u = __builtin_bit_cast(unsigned, f); return (u + 0x7fffu + ((u >> 16) & 1u)) >> 16; }
__device__ __forceinline__ unsigned pk2(float lo, float hi) { return f2bf(lo) | (f2bf(hi) << 16); }

#define XB_TMO      128
#define XB_XCNT(j)  (256  + 64 * (j))
#define XB_XSUB(j)  (1280 + 64 * (j))
#define XB_XGEN(j)  (2304 + 64 * (j))
#define XB_TOP      3328
#define XB_TOPGEN   3392
#define XCD_BAR_WORDS 3456
#define XB_SPIN_CAP (1u << 18)

__device__ __forceinline__ unsigned xb_ld(unsigned* p)              { return __hip_atomic_load(p, __ATOMIC_RELAXED, __HIP_MEMORY_SCOPE_AGENT); }
__device__ __forceinline__ unsigned xb_add(unsigned* p, unsigned v) { return __hip_atomic_fetch_add(p, v, __ATOMIC_RELAXED, __HIP_MEMORY_SCOPE_AGENT); }
__device__ __forceinline__ unsigned xb_xcc_id() { return (unsigned)__builtin_amdgcn_s_getreg((3 << 11) | 20) & 0xFu; }
#define XB_SPIN(cond, bar) do { unsigned _sp = 0; while (cond) { __builtin_amdgcn_s_sleep(1); \
    if ((++_sp & 255u) == 0u) { if (xb_ld(&(bar)[XB_TMO])) break; if (_sp > XB_SPIN_CAP) { atomicAdd(&(bar)[XB_TMO], 1u); break; } } } } while (0)

struct XcdBarrier {
    unsigned* bar; unsigned x;
    volatile LAS unsigned* st;
};

__device__ __forceinline__ XcdBarrier xcd_barrier_post(unsigned* bar, volatile LAS unsigned* st) {
    XcdBarrier b; b.bar = bar; b.x = xb_xcc_id(); b.st = st;
    if (threadIdx.x == 0) (void)xb_add(&bar[XB_XCNT(b.x)], 1u);
    return b;
}
__device__ __forceinline__ void xcd_barrier_complete(unsigned* bar, unsigned x, unsigned& nloc, unsigned& nx) {
    const unsigned G = gridDim.x * gridDim.y * gridDim.z;
    unsigned sum, cnt, mine, sp = 0u;
    for (;;) {
        sum = 0u; cnt = 0u; mine = 0u;
#pragma unroll
        for (unsigned j = 0; j < 16; ++j) { const unsigned c = xb_ld(&bar[XB_XCNT(j)]); sum += c; cnt += (c > 0u) ? 1u : 0u; mine = (j == x) ? c : mine; }
        if (sum == G) break;
        __builtin_amdgcn_s_sleep(1);
        if ((++sp & 255u) == 0u) { if (xb_ld(&bar[XB_TMO])) break; if (sp > XB_SPIN_CAP) { atomicAdd(&bar[XB_TMO], 1u); break; } }
    }
    nloc = mine > 0u ? mine : 1u; nx = cnt > 0u ? cnt : 1u;
}

__device__ __forceinline__ void xcd_barrier(const XcdBarrier& b) {
    asm volatile("s_waitcnt vmcnt(0)" ::: "memory");
    __syncthreads();
    if (threadIdx.x == 0) {
        unsigned* bar = b.bar;
        __builtin_amdgcn_s_waitcnt(0);
        unsigned nloc = b.st[0], nx = b.st[1];
        if (nloc == 0u) { xcd_barrier_complete(bar, b.x, nloc, nx); b.st[0] = nloc; b.st[1] = nx; }
        const unsigned old = xb_add(&bar[XB_XSUB(b.x)], 1u);
        const unsigned gen = old / nloc;
        if (old + 1u == (gen + 1u) * nloc) {
            __builtin_amdgcn_fence(__ATOMIC_RELEASE, "agent");
            asm volatile("s_waitcnt vmcnt(0)" ::: "memory");
            const unsigned og = xb_add(&bar[XB_TOP], 1u);
            const unsigned tg = og / nx;
            if (og + 1u == (tg + 1u) * nx) xb_add(&bar[XB_TOPGEN], 1u);
            else XB_SPIN(xb_ld(&bar[XB_TOPGEN]) == tg, bar);
            __builtin_amdgcn_fence(__ATOMIC_ACQUIRE, "agent");
            xb_add(&bar[XB_XGEN(b.x)], 1u);
            asm volatile("s_waitcnt vmcnt(0)" ::: "memory");
        } else {
            XB_SPIN(xb_ld(&bar[XB_TOPGEN]) == gen, bar);
            __builtin_amdgcn_fence(__ATOMIC_ACQUIRE, "agent");
            asm volatile("s_waitcnt vmcnt(0)" ::: "memory");
        }
    }
    __syncthreads();
}
typedef unsigned u32x4 __attribute__((ext_vector_type(4)));

constexpr int NWAVES = 8;
constexpr int BATCH = 8, SEQ = 2048, DM = 1024, M = BATCH * SEQ, DEPTH = 2;
constexpr int DIN = 2564, PP = 2304, NPROJ = 2560, DFF = 2816, NGU = 2 * DFF;
constexpr float EPS = 1e-6f;
constexpr float LOG2E = 1.4426950408889634f;
constexpr int C_U = 0, C_V = 256, C_Z = 512, C_XS = 768, C_B = 1024, C_C = 1280, C_POOL = 1536, C_Q = 1792, C_K = 2048;
enum { I_X = 0, I_N1W, I_WIN, I_GMNW, I_GMWS, I_GMBS, I_CONVW, I_CONVB, I_DTB, I_ALOG, I_SSMD, I_SSMNW, I_POOLW, I_POOLS,
       I_QNW, I_KNW, I_LQ1, I_LK1, I_LQ2, I_LK2, I_SUBLN, I_WOUT, I_N2W, I_WG, I_WU, I_WD, N_IN };

constexpr size_t MiB = 1u << 20;
constexpr size_t WS_CTL = 0, WS_RS = 64 * 1024, RS_STRIDE = (size_t)16384 * 4, CTL_ZERO_BYTES = 64 * 1024 + 4 * 262144;
constexpr size_t WS_W = 2 * MiB, W_LAYER = 24 * MiB, W_IN = 0, W_OUT = 5 * MiB, W_GU = 7 * MiB, W_DN = 18 * MiB;
constexpr size_t WS_XN = 50 * MiB, WS_DT = 82 * MiB, WS_CD = 82 * MiB + 512 * 1024, WS_ST = 83 * MiB, WS_VT = 99 * MiB;
constexpr size_t WS_PROJ = 107 * MiB, WS_MIX = 179 * MiB, WS_H = 107 * MiB, WS_END = 211 * MiB;
constexpr int CW_BAR = 4096;

constexpr int SCR_BYTES = 147456;
constexpr int LDSCTL_OFF = SCR_BYTES, MISC_OFF = LDSCTL_OFF + 320;
constexpr int LDS_BYTES = SCR_BYTES + 1024;

typedef float f32x16 __attribute__((ext_vector_type(16)));
typedef unsigned u32x2 __attribute__((ext_vector_type(2)));
#define DI __device__ __forceinline__
#define OPQ(x) asm volatile("" : "+v"(x))
#define MFMA32(a, b, c) __builtin_amdgcn_mfma_f32_32x32x16_bf16((a), (b), (c), 0, 0, 0)

DI float bf2f(bf16 u) { return __uint_as_float((unsigned)u << 16); }
DI float bflo(unsigned w) { return __uint_as_float(w << 16); }
DI float bfhi(unsigned w) { return __uint_as_float(w & 0xffff0000u); }
DI bf16 f2b(float f) { return (bf16)f2bf(f); }
DI int crow(int reg, int h) { return (reg & 3) + 8 * (reg >> 2) + 4 * h; }
DI float wave_sum(float v) {
#pragma unroll
    for (int o = 1; o < 64; o <<= 1) v += __shfl_xor(v, o);
    return v;
}
DI void unpack8(v4u w, float* f) { f[0] = bflo(w.x); f[1] = bfhi(w.x); f[2] = bflo(w.y); f[3] = bfhi(w.y); f[4] = bflo(w.z); f[5] = bfhi(w.z); f[6] = bflo(w.w); f[7] = bfhi(w.w); }
DI v4u pack8(const float* f) { v4u o; o.x = pk2(f[0], f[1]); o.y = pk2(f[2], f[3]); o.z = pk2(f[4], f[5]); o.w = pk2(f[6], f[7]); return o; }
DI float silu_f(float x) { return x * __builtin_amdgcn_rcpf(1.f + __builtin_amdgcn_exp2f(-x * LOG2E)); }
DI float gelu_tanh_f(float x) { const float y = 0.7978845608f * (x + 0.044715f * x * x * x); return x * __builtin_amdgcn_rcpf(1.f + __builtin_amdgcn_exp2f(-2.f * LOG2E * y)); }

DI f32x16 mma_tile(const LAS bf16* A, int pa, const LAS bf16* Bt, int pb, int K, f32x16 acc, int r, int lh) {
    const LAS bf16* ap = A + r * pa + 8 * lh; const LAS bf16* bp = Bt + r * pb + 8 * lh;
    for (int k = 0; k < K; k += 16) { const bf16x8 a = *(const LAS bf16x8*)(ap + k); const bf16x8 b = *(const LAS bf16x8*)(bp + k); acc = MFMA32(a, b, acc); }
    return acc;
}

DI int swz136(int row, int t) { return row * 136 + ((((t >> 3) ^ (row >> 3)) & 15) << 3) + (t & 7); }
template <bool SWA, bool SWB>
DI f32x16 mma_tile_sw(const LAS bf16* Abuf, int rowA0, const LAS bf16* Bbuf, int rowB0, int K, f32x16 acc, int r, int lh) {
    const int ra = rowA0 + r, rb = rowB0 + r; const int xa = SWA ? ((ra >> 3) & 15) : 0, xb = SWB ? ((rb >> 3) & 15) : 0;
    const LAS bf16* ap = Abuf + ra * 136; const LAS bf16* bp = Bbuf + rb * 136;
    for (int k = 0; k < K; k += 16) { const int kb = (k >> 3) + lh; const bf16x8 a = *(const LAS bf16x8*)(ap + ((kb ^ xa) << 3)); const bf16x8 b = *(const LAS bf16x8*)(bp + ((kb ^ xb) << 3)); acc = MFMA32(a, b, acc); }
    return acc;
}

struct Args { const float* in[N_IN]; float* out; unsigned char* ws; int ph_lo, ph_hi; };
typedef const Args __attribute__((address_space(4)))* KA;
DI KA kargs() { KA p = (KA)__builtin_amdgcn_kernarg_segment_ptr(); asm volatile("" : "+s"(p)); return p; }

namespace pg8 {
struct EpiInProj {
    static constexpr bool PERM = true, AFTER_DRAIN = false;
    bf16_t* O; const float* qw; const float* kw; const float* rs;
    __device__ __forceinline__ void operator()(const f32x4 (&acc)[2][2][4][2], const Unit& u, int wr, int wc, int fr, int fq) const {
        const int row0 = u.pm * BM + wr * 64 + fr, col0 = u.pn * BM + wc * 32 + 8 * fq;
        const int mode = (u.pn < 2) ? 1 : (u.pn == 7 ? 2 : (u.pn == 8 ? 3 : 0));
        f32x4 w0 = (f32x4){1.f, 1.f, 1.f, 1.f}, w1 = w0;
        if (mode >= 2) { const float* wp = (mode == 2 ? qw : kw) + 8 * fq; w0 = *(const f32x4*)wp; w1 = *(const f32x4*)(wp + 4);
            if (mode == 2) { const float sc = 0.17677669529663687f * 1.4426950408889634f; w0 = w0 * sc; w1 = w1 * sc; } }
        float rstv[2][4];
#pragma unroll
        for (int ai = 0; ai < 2; ++ai)
#pragma unroll
            for (int m = 0; m < 4; ++m) { const f32x4 q4 = *(const f32x4*)(rs + (size_t)(row0 + ai * HALF + m * 16) * 4); rstv[ai][m] = 1.0f / sqrtf(((q4[0] + q4[1]) + (q4[2] + q4[3])) * (1.0f / DM) + EPS); }
#pragma unroll
        for (int ai = 0; ai < 2; ++ai)
#pragma unroll
            for (int m = 0; m < 4; ++m) { bf16_t* rowp = O + (size_t)(row0 + ai * HALF + m * 16) * PP + col0;
                const float rst = rstv[ai][m];
#pragma unroll
                for (int bj = 0; bj < 2; ++bj) { f32x4 v0 = acc[ai][bj][m][0] * rst, v1 = acc[ai][bj][m][1] * rst;
                    if (mode == 1) {
#pragma unroll
                        for (int j = 0; j < 4; ++j) { v0[j] = gelu_tanh_f(v0[j]); v1[j] = gelu_tanh_f(v1[j]); }
                    } else if (mode >= 2) {
                        float ss = (v0[0] * v0[0] + v0[1] * v0[1]) + (v0[2] * v0[2] + v0[3] * v0[3]) + (v1[0] * v1[0] + v1[1] * v1[1]) + (v1[2] * v1[2] + v1[3] * v1[3]);
                        ss += __shfl_xor(ss, 16); ss += __shfl_xor(ss, 32);
                        const float rstd = 1.0f / sqrtf(ss * (1.0f / 32.0f) + EPS);
                        v0 = v0 * rstd * w0; v1 = v1 * rstd * w1;
                    }
                    u32x4 w; w.x = cvt_pk_bf16(v0[0], v0[1]); w.y = cvt_pk_bf16(v0[2], v0[3]); w.z = cvt_pk_bf16(v1[0], v1[1]); w.w = cvt_pk_bf16(v1[2], v1[3]);
                    *(u32x4*)(rowp + bj * HALF) = w; } }
    }
};
struct EpiResid {
    static constexpr bool PERM = false, AFTER_DRAIN = false;
    const float* base32; const bf16_t* base16; float* out32; bf16_t* xb; float* rs;
    __device__ __forceinline__ void operator()(const f32x4 (&acc)[2][2][4][2], const Unit& u, int wr, int wc, int fr, int fq) const {
        typedef unsigned u32x2v __attribute__((ext_vector_type(2)));
        const int row0 = u.pm * BM + wr * 64 + fr, col0 = u.pn * BM + wc * 32 + 4 * fq;
#pragma unroll
        for (int ai = 0; ai < 2; ++ai) {
            f32x4 pre[4][2][2];
            if (base32) {
#pragma unroll
                for (int m = 0; m < 4; ++m) { const size_t off = (size_t)(row0 + ai * HALF + m * 16) * DM + col0;
#pragma unroll
                    for (int bj = 0; bj < 2; ++bj)
#pragma unroll
                        for (int n = 0; n < 2; ++n) pre[m][bj][n] = *(const f32x4*)(base32 + off + bj * HALF + n * 16); }
            } else {
                u32x2v raw[4][2][2];
#pragma unroll
                for (int m = 0; m < 4; ++m) { const size_t off = (size_t)(row0 + ai * HALF + m * 16) * DM + col0;
#pragma unroll
                    for (int bj = 0; bj < 2; ++bj)
#pragma unroll
                        for (int n = 0; n < 2; ++n) raw[m][bj][n] = *(const u32x2v*)(base16 + off + bj * HALF + n * 16); }
#pragma unroll
                for (int m = 0; m < 4; ++m)
#pragma unroll
                    for (int bj = 0; bj < 2; ++bj)
#pragma unroll
                        for (int n = 0; n < 2; ++n) { const u32x2v w = raw[m][bj][n]; pre[m][bj][n] = (f32x4){__uint_as_float(w.x << 16), __uint_as_float(w.x & 0xffff0000u), __uint_as_float(w.y << 16), __uint_as_float(w.y & 0xffff0000u)}; }
            }
            asm volatile("" ::: "memory");
#pragma unroll
            for (int m = 0; m < 4; ++m) { const int row = row0 + ai * HALF + m * 16; const size_t off = (size_t)row * DM + col0; float ss = 0.f;
#pragma unroll
                for (int bj = 0; bj < 2; ++bj)
#pragma unroll
                    for (int n = 0; n < 2; ++n) { const size_t o = off + bj * HALF + n * 16; const f32x4 v = pre[m][bj][n] + acc[ai][bj][m][n];
                        if (out32) *(f32x4*)(out32 + o) = v;
                        if (xb) { ss += (v[0] * v[0] + v[1] * v[1]) + (v[2] * v[2] + v[3] * v[3]); unsigned long long w = (unsigned long long)cvt_pk_bf16(v[0], v[1]) | ((unsigned long long)cvt_pk_bf16(v[2], v[3]) << 32); *(unsigned long long*)(xb + o) = w; } }
                if (xb) { ss += __shfl_xor(ss, 16); ss += __shfl_xor(ss, 32); if (fq == 0) __hip_atomic_fetch_add(rs + (size_t)row * 4 + u.pn, ss, __ATOMIC_RELAXED, __HIP_MEMORY_SCOPE_WORKGROUP); }     }
            asm volatile("" ::: "memory");
        }
    }
};
struct EpiSwiGLU {
    static constexpr bool PERM = true, AFTER_DRAIN = false;
    bf16_t* O; const float* rs;
    __device__ __forceinline__ void operator()(const f32x4 (&acc)[2][2][4][2], const Unit& u, int wr, int wc, int fr, int fq) const {
        const int row0 = u.pm * BM + wr * 64 + fr, col0 = u.pn * HALF + wc * 32 + 8 * fq;
        float rstv[2][4];
#pragma unroll
        for (int ai = 0; ai < 2; ++ai)
#pragma unroll
            for (int m = 0; m < 4; ++m) { const f32x4 q4 = *(const f32x4*)(rs + (size_t)(row0 + ai * HALF + m * 16) * 4); rstv[ai][m] = 1.0f / sqrtf(((q4[0] + q4[1]) + (q4[2] + q4[3])) * (1.0f / DM) + EPS); }
#pragma unroll
        for (int ai = 0; ai < 2; ++ai)
#pragma unroll
            for (int m = 0; m < 4; ++m) { bf16_t* rowp = O + (size_t)(row0 + ai * HALF + m * 16) * DFF + col0;
                f32x4 h0, h1; const float rst = rstv[ai][m];
#pragma unroll
                for (int j = 0; j < 4; ++j) { h0[j] = silu_f(acc[ai][0][m][0][j] * rst) * (acc[ai][1][m][0][j] * rst); h1[j] = silu_f(acc[ai][0][m][1][j] * rst) * (acc[ai][1][m][1][j] * rst); }
                u32x4 w; w.x = cvt_pk_bf16(h0[0], h0[1]); w.y = cvt_pk_bf16(h0[2], h0[3]); w.z = cvt_pk_bf16(h1[0], h1[1]); w.w = cvt_pk_bf16(h1[2], h1[3]);
                *(u32x4*)rowp = w; }
    }
};
struct EpiVT {
    static constexpr bool PERM = true, AFTER_DRAIN = false;
    bf16_t* O; const float* rs;
    __device__ __forceinline__ void operator()(const f32x4 (&acc)[2][2][4][2], const Unit& u, int wr, int wc, int fr, int fq) const {
        const int row0 = u.pm * BM + wr * 64 + fr, col0 = u.pn * BM + wc * 32 + 8 * fq;
        f32x4 sc[2][2];
#pragma unroll
        for (int bj = 0; bj < 2; ++bj)
#pragma unroll
            for (int n = 0; n < 2; ++n) {
#pragma unroll
                for (int j = 0; j < 4; ++j) { const f32x4 q4 = *(const f32x4*)(rs + (size_t)(col0 + bj * HALF + 4 * n + j) * 4); sc[bj][n][j] = 1.0f / sqrtf(((q4[0] + q4[1]) + (q4[2] + q4[3])) * (1.0f / DM) + EPS); } }
#pragma unroll
        for (int ai = 0; ai < 2; ++ai)
#pragma unroll
            for (int m = 0; m < 4; ++m) { bf16_t* rowp = O + (size_t)(row0 + ai * HALF + m * 16) * M + col0;
#pragma unroll
                for (int bj = 0; bj < 2; ++bj) { const f32x4 v0 = acc[ai][bj][m][0] * sc[bj][0], v1 = acc[ai][bj][m][1] * sc[bj][1];
                    u32x4 w; w.x = cvt_pk_bf16(v0[0], v0[1]); w.y = cvt_pk_bf16(v0[2], v0[3]); w.z = cvt_pk_bf16(v1[0], v1[1]); w.w = cvt_pk_bf16(v1[2], v1[3]);
                    *(u32x4*)(rowp + bj * HALF) = w; } }
    }
};
}

DI void tr_item(const float* src, int pitch, int k0, int c0, bf16* dst, int drow0, int Kd, LAS float* scr, int lane, const float* ksc) {
#pragma unroll 8
    for (int i = 0; i < 32; ++i) { const int kk = 2 * i + (lane >> 5); scr[kk * 33 + (lane & 31)] = src[(size_t)(k0 + kk) * pitch + c0 + (lane & 31)]; }
    LDS_WAIT(); asm volatile("" ::: "memory");
    const int c = lane & 7;
    f32x4 k0v = (f32x4){1.f, 1.f, 1.f, 1.f}, k1v = k0v; if (ksc) { k0v = *(const f32x4*)(ksc + k0 + 8 * c); k1v = *(const f32x4*)(ksc + k0 + 8 * c + 4); }
#pragma unroll
    for (int j = 0; j < 4; ++j) { const int n = (lane >> 3) + 8 * j; const LAS float* s = scr + (8 * c) * 33 + n;
        v4u o; o.x = pk2(s[0 * 33] * k0v[0], s[1 * 33] * k0v[1]); o.y = pk2(s[2 * 33] * k0v[2], s[3 * 33] * k0v[3]); o.z = pk2(s[4 * 33] * k1v[0], s[5 * 33] * k1v[1]); o.w = pk2(s[6 * 33] * k1v[2], s[7 * 33] * k1v[3]);
        *(v4u*)(dst + (size_t)(drow0 + n) * Kd + k0 + 8 * c) = o; }
    LDS_WAIT(); asm volatile("" ::: "memory");
}
constexpr int WI_INP = 16 * 80, WI_OUT = 16 * 32, WI_G = 16 * 88, WI_D = 44 * 32, WI_PER_L = WI_INP + WI_OUT + 2 * WI_G + WI_D;
DI void weights_phase(KA a, LAS unsigned char* lds, int L, int lo, int hi, int rank, int nranks, int wave, int lane) {
    OPQ(lane);
    LAS float* scr = (LAS float*)(lds + wave * 16384);
    unsigned char* wb = a->ws + WS_W + (size_t)L * W_LAYER;
    for (int it = lo + rank; it < hi; it += nranks) {
        int r = it;
        if (r < WI_INP) { const int kb = r / 80, nb = r % 80, d0 = nb * 32; tr_item(a->in[I_WIN] + (size_t)L * DM * DIN, DIN, kb * 64, d0 < 1536 ? d0 : d0 + 4, (bf16*)(wb + W_IN), d0, DM, scr, lane, a->in[I_N1W] + L * DM); continue; } r -= WI_INP;
        if (r < WI_OUT) { const int kb = r / 32, nb = r % 32; tr_item(a->in[I_WOUT] + (size_t)L * DM * DM, DM, kb * 64, nb * 32, (bf16*)(wb + W_OUT), nb * 32, DM, scr, lane, nullptr); continue; } r -= WI_OUT;
        if (r < WI_G) { const int kb = r / 88, nb = r % 88, c0 = nb * 32; tr_item(a->in[I_WG] + (size_t)L * DM * DFF, DFF, kb * 64, c0, (bf16*)(wb + W_GU), (c0 >> 7) * 256 + (c0 & 127), DM, scr, lane, a->in[I_N2W] + L * DM); continue; } r -= WI_G;
        if (r < WI_G) { const int kb = r / 88, nb = r % 88, c0 = nb * 32; tr_item(a->in[I_WU] + (size_t)L * DM * DFF, DFF, kb * 64, c0, (bf16*)(wb + W_GU), (c0 >> 7) * 256 + 128 + (c0 & 127), DM, scr, lane, a->in[I_N2W] + L * DM); continue; } r -= WI_G;
        { const int kb = r / 32, nb = r % 32; tr_item(a->in[I_WD] + (size_t)L * DFF * DM, DM, kb * 64, nb * 32, (bf16*)(wb + W_DN), nb * 32, DFF, scr, lane, nullptr); }
    }
}
DI void prep_phase(const float* xsrc, bf16* XB, float* rs, int vcu, int G, int wave, int lane) {
    OPQ(lane);
    for (int m = vcu * NWAVES + wave; m < M; m += G * NWAVES) {
        const f32x4* xr = (const f32x4*)(xsrc + (size_t)m * DM) + lane;
        f32x4 v[4]; float s = 0.f;
#pragma unroll
        for (int j = 0; j < 4; ++j) { v[j] = xr[64 * j]; s += (v[j].x * v[j].x + v[j].y * v[j].y) + (v[j].z * v[j].z + v[j].w * v[j].w); }
        s = wave_sum(s);
        unsigned long long* o8 = (unsigned long long*)(XB + (size_t)m * DM) + lane;
#pragma unroll
        for (int j = 0; j < 4; ++j) o8[64 * j] = (unsigned long long)pk2(v[j].x, v[j].y) | ((unsigned long long)pk2(v[j].z, v[j].w) << 32);
        if (lane == 0) rs[(size_t)m * 4] = s;
    }
}

DI void gmlp_item(KA a, int L, int b, int c, int h, LAS unsigned char* lds, int tid, int wave, int lane) {
    OPQ(lane); OPQ(tid);
    LAS bf16* Wm = (LAS bf16*)lds; LAS bf16* vT = (LAS bf16*)(lds + 34816);
    const bf16* PROJ = (const bf16*)(a->ws + WS_PROJ); bf16* MIX = (bf16*)(a->ws + WS_MIX);
    const int tok0 = b * SEQ + c * 128;
    const float* ws = a->in[I_GMWS] + (size_t)(L * 4 + h) * 16384;
#pragma unroll
    for (int i = 0; i < 8; ++i) { const int idx = tid + 512 * i, t = idx >> 5, s4 = (idx & 31) * 4; const f32x4 w = *(const f32x4*)(ws + t * 128 + s4);
        u32x2 p; p.x = pk2(s4 <= t ? w.x : 0.f, s4 + 1 <= t ? w.y : 0.f); p.y = pk2(s4 + 2 <= t ? w.z : 0.f, s4 + 3 <= t ? w.w : 0.f);
        *(LAS u32x2*)(Wm + t * 136 + s4) = p; }
    { const int t = tid >> 2, qd = tid & 3; const bf16* vp = PROJ + (size_t)(tok0 + t) * PP + C_V + h * 64 + qd * 16;
      float f[16]; unpack8(*(const v4u*)vp, f); unpack8(*(const v4u*)(vp + 8), f + 8);
      float ss = 0.f;
#pragma unroll
      for (int i = 0; i < 16; ++i) ss += f[i] * f[i];
      ss += __shfl_xor(ss, 1); ss += __shfl_xor(ss, 2);
      const float rstd = 1.0f / sqrtf(ss * (1.0f / 64.0f) + EPS); const float* gw = a->in[I_GMNW] + L * 256 + h * 64 + qd * 16;
#pragma unroll
      for (int i = 0; i < 16; ++i) vT[(qd * 16 + i) * 136 + t] = f2b(f[i] * rstd * gw[i]); }
    __syncthreads();
    { const int tt = wave >> 1, dtl = wave & 1, r = lane & 31, lh = lane >> 5;
      f32x16 acc = {}; acc = mma_tile(Wm + tt * 32 * 136, 136, vT + dtl * 32 * 136, 136, 32 * (tt + 1), acc, r, lh);
      const float* bs = a->in[I_GMBS] + (L * 4 + h) * 128; const int d = dtl * 32 + r;
#pragma unroll
      for (int reg = 0; reg < 16; ++reg) { const int t = tt * 32 + crow(reg, lh); const float u = bf2f(PROJ[(size_t)(tok0 + t) * PP + C_U + h * 64 + d]);
          MIX[(size_t)(tok0 + t) * DM + h * 64 + d] = f2b(u * (acc[reg] + bs[t])); } }
    __syncthreads();
}
template <int WIN> DI void pool_win(const bf16* hp, int tpos, float* s) {
    float cur[16];
#pragma unroll
    for (int i = 0; i < 16; ++i) s[i] = 0.f;
#pragma unroll
    for (int j = 0; j < WIN; ++j) { const bool ok = tpos - j >= 0; const bf16* pp = ok ? hp - (size_t)j * PP : hp; float f[16]; unpack8(*(const v4u*)pp, f); unpack8(*(const v4u*)(pp + 8), f + 8);
#pragma unroll
        for (int i = 0; i < 16; ++i) { if (j == 0) cur[i] = f[i]; s[i] += ok ? f[i] : 0.f; } }
    const int cnt = (tpos + 1 < WIN) ? tpos + 1 : WIN; const float inv = 1.0f / (float)cnt;
#pragma unroll
    for (int i = 0; i < 16; ++i) s[i] = s[i] * inv - cur[i];
}
DI void pool_item(KA a, int L, int b, int c, int g, LAS unsigned char* lds, int tid, int wave, int lane) {
    OPQ(lane); OPQ(tid);
    LAS bf16* P = (LAS bf16*)lds; LAS bf16* WT = (LAS bf16*)(lds + 18432);
    const bf16* PROJ = (const bf16*)(a->ws + WS_PROJ); bf16* MIX = (bf16*)(a->ws + WS_MIX);
    const int tok0 = b * SEQ + c * 128;
    { const int t = tid >> 2, qd = tid & 3, tpos = c * 128 + t;
      const bf16* hp = PROJ + (size_t)(b * SEQ + tpos) * PP + C_POOL + g * 64 + qd * 16;
      float s[16];
      switch (g) { case 0: pool_win<2>(hp, tpos, s); break; case 1: pool_win<4>(hp, tpos, s); break; case 2: pool_win<8>(hp, tpos, s); break; default: pool_win<16>(hp, tpos, s); break; }
      *(LAS v4u*)(P + t * 72 + qd * 16) = pack8(s); *(LAS v4u*)(P + t * 72 + qd * 16 + 8) = pack8(s + 8); }
    { const float* pw = a->in[I_POOLW] + (size_t)(L * 4 + g) * 4096;
#pragma unroll
      for (int i = 0; i < 8; ++i) { const int idx = tid + 512 * i, d = idx >> 6, e = idx & 63; WT[e * 72 + d] = f2b(pw[d * 64 + e]); } }
    __syncthreads();
    { const int tt = wave >> 1, et = wave & 1, r = lane & 31, lh = lane >> 5;
      f32x16 acc = {}; acc = mma_tile(P + tt * 32 * 72, 72, WT + et * 32 * 72, 72, 64, acc, r, lh);
      const int e = et * 32 + r; const float sc = a->in[I_POOLS][L * 256 + g * 64 + e];
#pragma unroll
      for (int reg = 0; reg < 16; ++reg) { const int t = tt * 32 + crow(reg, lh); MIX[(size_t)(tok0 + t) * DM + 512 + g * 64 + e] = f2b(acc[reg] * sc); } }
    __syncthreads();
}
DI void gmlp_pair(KA a, int L, int itA, int itB, LAS unsigned char* lds, int tid, int wave, int lane) {
    OPQ(lane); OPQ(tid);
    const bf16* PROJ = (const bf16*)(a->ws + WS_PROJ); bf16* MIX = (bf16*)(a->ws + WS_MIX);
    constexpr int REG = 52224;
    int tok0[2], hq[2]; const int its[2] = {itA, itB};
#pragma unroll
    for (int q = 0; q < 2; ++q) { tok0[q] = (its[q] >> 6) * SEQ + ((its[q] >> 2) & 15) * 128; hq[q] = its[q] & 3; }
    f32x4 wv[2][8]; v4u vv[2][2];
    const int vt = tid >> 2, vqd = tid & 3;
#pragma unroll
    for (int q = 0; q < 2; ++q) { const float* ws = a->in[I_GMWS] + (size_t)(L * 4 + hq[q]) * 16384;
#pragma unroll
        for (int i = 0; i < 8; ++i) { const int idx = tid + 512 * i; wv[q][i] = *(const f32x4*)(ws + (idx >> 5) * 128 + (idx & 31) * 4); }
        const bf16* vp = PROJ + (size_t)(tok0[q] + vt) * PP + C_V + hq[q] * 64 + vqd * 16; vv[q][0] = *(const v4u*)vp; vv[q][1] = *(const v4u*)(vp + 8); }
#pragma unroll
    for (int q = 0; q < 2; ++q) { LAS bf16* Wm = (LAS bf16*)(lds + q * REG); LAS bf16* vT = (LAS bf16*)(lds + q * REG + 34816);
#pragma unroll
        for (int i = 0; i < 8; ++i) { const int idx = tid + 512 * i, t = idx >> 5, s4 = (idx & 31) * 4; const f32x4 w = wv[q][i];
            u32x2 p; p.x = pk2(s4 <= t ? w.x : 0.f, s4 + 1 <= t ? w.y : 0.f); p.y = pk2(s4 + 2 <= t ? w.z : 0.f, s4 + 3 <= t ? w.w : 0.f);
            *(LAS u32x2*)(Wm + t * 136 + s4) = p; }
        float f[16]; unpack8(vv[q][0], f); unpack8(vv[q][1], f + 8);
        float ss = 0.f;
#pragma unroll
        for (int i = 0; i < 16; ++i) ss += f[i] * f[i];
        ss += __shfl_xor(ss, 1); ss += __shfl_xor(ss, 2);
        const float rstd = 1.0f / sqrtf(ss * (1.0f / 64.0f) + EPS); const float* gw = a->in[I_GMNW] + L * 256 + hq[q] * 64 + vqd * 16;
#pragma unroll
        for (int i = 0; i < 16; ++i) vT[(vqd * 16 + i) * 136 + vt] = f2b(f[i] * rstd * gw[i]); }
    __syncthreads();
    { const int tt = wave >> 1, dtl = wave & 1, r = lane & 31, lh = lane >> 5, d = dtl * 32 + r;
      float uu[2][16];
#pragma unroll
      for (int q = 0; q < 2; ++q)
#pragma unroll
          for (int reg = 0; reg < 16; ++reg) uu[q][reg] = bf2f(PROJ[(size_t)(tok0[q] + tt * 32 + crow(reg, lh)) * PP + C_U + hq[q] * 64 + d]);
      f32x16 acc[2];
#pragma unroll
      for (int q = 0; q < 2; ++q) { acc[q] = (f32x16){}; acc[q] = mma_tile((LAS bf16*)(lds + q * REG) + tt * 32 * 136, 136, (LAS bf16*)(lds + q * REG + 34816) + dtl * 32 * 136, 136, 32 * (tt + 1), acc[q], r, lh); }
#pragma unroll
      for (int q = 0; q < 2; ++q) { const float* bs = a->in[I_GMBS] + (L * 4 + hq[q]) * 128;
#pragma unroll
          for (int reg = 0; reg < 16; ++reg) { const int t = tt * 32 + crow(reg, lh); MIX[(size_t)(tok0[q] + t) * DM + hq[q] * 64 + d] = f2b(uu[q][reg] * (acc[q][reg] + bs[t])); } } }
    __syncthreads();
}
DI void pool_pair(KA a, int L, int itA, int itB, LAS unsigned char* lds, int tid, int wave, int lane) {
    OPQ(lane); OPQ(tid);
    const bf16* PROJ = (const bf16*)(a->ws + WS_PROJ); bf16* MIX = (bf16*)(a->ws + WS_MIX);
    constexpr int R_OFF = 0, P_OFF = 144 * 72 * 2, W_OFF = P_OFF + 128 * 72 * 2, REG = W_OFF + 64 * 72 * 2;
    const int its[2] = {itA, itB};
    v4u rv[2][3]; float wq[2][8];
#pragma unroll
    for (int q = 0; q < 2; ++q) { const int b = its[q] >> 6, c = (its[q] >> 2) & 15, g = its[q] & 3;
#pragma unroll
        for (int i = 0; i < 3; ++i) { const int idx = tid + 512 * i, row = idx >> 3, ch = idx & 7, tp = c * 128 - 16 + row; const bool ok = (idx < 144 * 8) && tp >= 0;
            rv[q][i] = *(const v4u*)(PROJ + (size_t)(b * SEQ + (ok ? tp : c * 128)) * PP + C_POOL + g * 64 + ch * 8); if (!ok) rv[q][i] = (v4u){0u, 0u, 0u, 0u}; }
        const float* pw = a->in[I_POOLW] + (size_t)(L * 4 + g) * 4096;
#pragma unroll
        for (int i = 0; i < 8; ++i) wq[q][i] = pw[((tid >> 6) * 8 + i) * 64 + (tid & 63)]; }
#pragma unroll
    for (int q = 0; q < 2; ++q) { LAS bf16* R = (LAS bf16*)(lds + q * REG + R_OFF); LAS bf16* WT = (LAS bf16*)(lds + q * REG + W_OFF);
#pragma unroll
        for (int i = 0; i < 3; ++i) { const int idx = tid + 512 * i; if (idx < 144 * 8) *(LAS v4u*)(R + (idx >> 3) * 72 + (idx & 7) * 8) = rv[q][i]; }
        *(LAS v4u*)(WT + (tid & 63) * 72 + (tid >> 6) * 8) = pack8(wq[q]); }
    __syncthreads();
    { const int t = tid >> 2, qd = tid & 3;
#pragma unroll
      for (int q = 0; q < 2; ++q) { const int c = (its[q] >> 2) & 15, g = its[q] & 3, win = 2 << g, tpos = c * 128 + t, cnt = (tpos + 1 < win) ? tpos + 1 : win;
          const LAS bf16* R = (const LAS bf16*)(lds + q * REG + R_OFF) + (t + 16) * 72 + qd * 16; LAS bf16* P = (LAS bf16*)(lds + q * REG + P_OFF);
          float sacc[16], cur[16];
          unpack8(*(const LAS v4u*)R, cur); unpack8(*(const LAS v4u*)(R + 8), cur + 8);
#pragma unroll
          for (int i = 0; i < 16; ++i) sacc[i] = cur[i];
          for (int jw = 1; jw < win; ++jw) { float f[16]; unpack8(*(const LAS v4u*)(R - jw * 72), f); unpack8(*(const LAS v4u*)(R - jw * 72 + 8), f + 8);
#pragma unroll
              for (int i = 0; i < 16; ++i) sacc[i] += f[i]; }
          const float inv = 1.0f / (float)cnt;
#pragma unroll
          for (int i = 0; i < 16; ++i) sacc[i] = sacc[i] * inv - cur[i];
          *(LAS v4u*)(P + t * 72 + qd * 16) = pack8(sacc); *(LAS v4u*)(P + t * 72 + qd * 16 + 8) = pack8(sacc + 8); } }
    __syncthreads();
    { const int tt = wave >> 1, et = wave & 1, r = lane & 31, lh = lane >> 5, e = et * 32 + r;
#pragma unroll
      for (int q = 0; q < 2; ++q) { const int b = its[q] >> 6, c = (its[q] >> 2) & 15, g = its[q] & 3, tok0 = b * SEQ + c * 128;
          f32x16 acc = {}; acc = mma_tile((LAS bf16*)(lds + q * REG + P_OFF) + tt * 32 * 72, 72, (LAS bf16*)(lds + q * REG + W_OFF) + et * 32 * 72, 72, 64, acc, r, lh);
          const float sc = a->in[I_POOLS][L * 256 + g * 64 + e];
#pragma unroll
          for (int reg = 0; reg < 16; ++reg) { const int tr = tt * 32 + crow(reg, lh); MIX[(size_t)(tok0 + tr) * DM + 512 + g * 64 + e] = f2b(acc[reg] * sc); } } }
    __syncthreads();
}
constexpr int SSD_DT = 139264, SSD_AR = SSD_DT + 1024, SSD_ACS = SSD_AR + 1024;
DI void ssd_dt(KA a, int L, int g, int tok0, LAS unsigned char* lds, int tid, const LAS float* dtraw) {
    LAS float* dtv = (LAS float*)(lds + SSD_DT); LAS float* wtot = (LAS float*)(lds + SSD_AR); LAS float* acs = (LAS float*)(lds + SSD_ACS);
    const float* DT = (const float*)(a->ws + WS_DT);
    const int hh = (tid >> 7) & 1, t = tid & 127, h = 2 * g + hh, ln = tid & 63, wv = tid >> 6;
    if (tid < 256) { const float x = (dtraw ? dtraw[t * 2 + hh] : DT[(size_t)(tok0 + t) * 4 + h]) + a->in[I_DTB][L * 4 + h]; const float ey = __expf(x); const float sp = x > 20.f ? x : (ey < 0.01f ? ey * (1.f - ey * (0.5f - ey * (1.f / 3.f))) : __logf(1.f + ey));
        float s = -sp * __expf(a->in[I_ALOG][L * 4 + h]);
#pragma unroll
        for (int o = 1; o < 64; o <<= 1) { const float n = __shfl_up(s, o); if (ln >= o) s += n; }
        dtv[t * 2 + hh] = sp; acs[t * 2 + hh] = s; if (ln == 63) wtot[wv] = s; }
    __syncthreads();
    if (tid < 256 && (wv & 1)) acs[t * 2 + hh] += wtot[wv - 1];
    __syncthreads();
}
DI void conv_load(const bf16* p, int tpos0, v4u (&raw)[7]) {
#pragma unroll
    for (int rr = 0; rr < 7; ++rr) { const bool ok = tpos0 - 3 + rr >= 0; raw[rr] = *(const v4u*)(ok ? p + (ptrdiff_t)(rr - 3) * PP : p); if (!ok) raw[rr] = (v4u){0u, 0u, 0u, 0u}; }
}
DI void conv_apply(const v4u (&raw)[7], const float* cw, const float* cb, float (&out)[4][8]) {
    f32x4 w[8];
#pragma unroll
    for (int i = 0; i < 8; ++i) w[i] = *(const f32x4*)(cw + 4 * i);
    const f32x4 b0 = *(const f32x4*)cb, b1 = *(const f32x4*)(cb + 4);
    const float bias[8] = {b0.x, b0.y, b0.z, b0.w, b1.x, b1.y, b1.z, b1.w};
    float x[7][8];
#pragma unroll
    for (int rr = 0; rr < 7; ++rr) unpack8(raw[rr], x[rr]);
#pragma unroll
    for (int k = 0; k < 4; ++k)
#pragma unroll
        for (int i = 0; i < 8; ++i) { float acc = bias[i];
#pragma unroll
            for (int jj = 0; jj < 4; ++jj) acc += x[k + jj][i] * w[i][jj];
            out[k][i] = silu_f(acc); }
}
DI void ssd_pass1(KA a, int L, int b, int c, int g, LAS unsigned char* lds, int tid, int wave, int lane) {
    OPQ(lane); OPQ(tid);
    LAS bf16* XwT = (LAS bf16*)lds; LAS bf16* BT = (LAS bf16*)(lds + 34816);
    LAS float* dtv = (LAS float*)(lds + SSD_DT); LAS float* acs = (LAS float*)(lds + SSD_ACS);
    const bf16* PROJ = (const bf16*)(a->ws + WS_PROJ); bf16* ST = (bf16*)(a->ws + WS_ST); float* CD = (float*)(a->ws + WS_CD);
    const int tok0 = b * SEQ + c * 128;
    v4u rawx[7], rawb[7];
    { const int cg = tid & 15, t0 = (tid >> 4) * 4; const bf16* rowp = PROJ + (size_t)(tok0 + t0) * PP + g * 128 + cg * 8; conv_load(rowp + C_XS, c * 128 + t0, rawx); conv_load(rowp + C_B, c * 128 + t0, rawb); }
    {
      LAS float* Wd = (LAS float*)(lds + 69632); LAS float* dtraw = (LAS float*)(lds + SSD_DT + 3072);
      const float* win = a->in[I_WIN] + (size_t)L * DM * DIN + 1536 + 2 * g; const float* nw = a->in[I_N1W] + L * DM;
      for (int k = tid; k < DM; k += NWAVES * 64) { const float w = nw[k]; Wd[2 * k] = w * win[(size_t)k * DIN]; Wd[2 * k + 1] = w * win[(size_t)k * DIN + 1]; }
      __syncthreads();
      const bf16* XB = (const bf16*)(a->ws + WS_XN); const float* rs = (const float*)(a->ws + WS_RS) + (size_t)(2 * L) * RS_STRIDE; float* DTg = (float*)(a->ws + WS_DT);
      const int t4 = tid >> 4, l16 = tid & 15; const bf16* xr = XB + (size_t)(tok0 + t4) * DM + l16 * 8;
      float a0[4] = {0.f, 0.f, 0.f, 0.f}, a1[4] = {0.f, 0.f, 0.f, 0.f};
#pragma unroll 4
      for (int mm = 0; mm < 8; ++mm) { const int k = mm * 128 + l16 * 8; f32x4 w[4];
#pragma unroll
          for (int e = 0; e < 4; ++e) w[e] = *(const LAS f32x4*)(Wd + 2 * k + 4 * e);
#pragma unroll
          for (int i = 0; i < 4; ++i) { float f[8]; unpack8(*(const v4u*)(xr + (size_t)i * 32 * DM + mm * 128), f);
#pragma unroll
              for (int e = 0; e < 4; ++e) { a0[i] += f[2 * e] * w[e][0] + f[2 * e + 1] * w[e][2]; a1[i] += f[2 * e] * w[e][1] + f[2 * e + 1] * w[e][3]; } } }
#pragma unroll
      for (int i = 0; i < 4; ++i) {
#pragma unroll
          for (int o = 1; o < 16; o <<= 1) { a0[i] += __shfl_xor(a0[i], o); a1[i] += __shfl_xor(a1[i], o); }
          if (l16 == 0) { const int t = t4 + 32 * i; const f32x4 q4 = *(const f32x4*)(rs + (size_t)(tok0 + t) * 4); const float rst = 1.0f / sqrtf(((q4[0] + q4[1]) + (q4[2] + q4[3])) * (1.0f / DM) + EPS);
              const float d0 = a0[i] * rst, d1 = a1[i] * rst; dtraw[t * 2] = d0; dtraw[t * 2 + 1] = d1; DTg[(size_t)(tok0 + t) * 4 + 2 * g] = d0; DTg[(size_t)(tok0 + t) * 4 + 2 * g + 1] = d1; } }
      __syncthreads();
      ssd_dt(a, L, g, tok0, lds, tid, dtraw); }
    { const int cg = tid & 15, t0 = (tid >> 4) * 4, tpos0 = c * 128 + t0, ch = cg * 8, hh = cg >> 3; const bf16* rowp = PROJ + (size_t)(tok0 + t0) * PP;
      const float* cwb = a->in[I_CONVW] + (size_t)L * 768 * 4; const float* cbb = a->in[I_CONVB] + L * 768;
      float o[4][8];
      conv_apply(rawx, cwb + (g * 128 + ch) * 4, cbb + g * 128 + ch, o);
      float wg[4]; const float aend = acs[127 * 2 + hh];
#pragma unroll
      for (int k = 0; k < 4; ++k) wg[k] = dtv[(t0 + k) * 2 + hh] * __expf(aend - acs[(t0 + k) * 2 + hh]);
#pragma unroll
      for (int i = 0; i < 8; ++i) { u32x2 w; w.x = pk2(o[0][i] * wg[0], o[1][i] * wg[1]); w.y = pk2(o[2][i] * wg[2], o[3][i] * wg[3]); *(LAS u32x2*)(XwT + swz136(ch + i, t0)) = w; }
      conv_apply(rawb, cwb + (256 + g * 128 + ch) * 4, cbb + 256 + g * 128 + ch, o);
#pragma unroll
      for (int i = 0; i < 8; ++i) { u32x2 w; w.x = pk2(o[0][i], o[1][i]); w.y = pk2(o[2][i], o[3][i]); *(LAS u32x2*)(BT + swz136(ch + i, t0)) = w; } }
    __syncthreads();
    { const int rt = wave >> 1, r = lane & 31, lh = lane >> 5, hh = rt >> 1, h = 2 * g + hh;
#pragma unroll
      for (int q = 0; q < 2; ++q) { const int ct = (wave & 1) * 2 + q; f32x16 acc = {}; acc = mma_tile_sw<true, true>(XwT, rt * 32, BT, ct * 32, 128, acc, r, lh);
#pragma unroll
          for (int reg = 0; reg < 16; ++reg) { const int p = (rt & 1) * 32 + crow(reg, lh); ST[((size_t)((b * 16 + c) * 4 + h) * 64 + p) * 128 + ct * 32 + r] = f2b(acc[reg]); } } }
    if (tid < 2) CD[(b * 16 + c) * 4 + 2 * g + tid] = __expf(acs[127 * 2 + tid]);
    __syncthreads();
}
DI void ssd_pass2(KA a, int L, int b, int c, int g, LAS unsigned char* lds, int tid, int wave, int lane) {
    OPQ(lane); OPQ(tid);
    LAS bf16* Cm = (LAS bf16*)lds; LAS bf16* Bm = (LAS bf16*)(lds + 34816); LAS bf16* XT = (LAS bf16*)(lds + 69632); LAS bf16* PV = (LAS bf16*)(lds + 104448);
    LAS float* dtv = (LAS float*)(lds + SSD_DT); LAS float* acs = (LAS float*)(lds + SSD_ACS);
    const bf16* PROJ = (const bf16*)(a->ws + WS_PROJ); const bf16* ST = (const bf16*)(a->ws + WS_ST); const float* CD = (const float*)(a->ws + WS_CD); bf16* MIX = (bf16*)(a->ws + WS_MIX);
    const int tok0 = b * SEQ + c * 128, r = lane & 31, lh = lane >> 5;
    v4u rawx[7], rawb[7], rawc[7];
    { const int cg = tid & 15, t0 = (tid >> 4) * 4; const bf16* rowp = PROJ + (size_t)(tok0 + t0) * PP + g * 128 + cg * 8; conv_load(rowp + C_XS, c * 128 + t0, rawx); conv_load(rowp + C_B, c * 128 + t0, rawb); conv_load(rowp + C_C, c * 128 + t0, rawc); }
    ssd_dt(a, L, g, tok0, lds, tid, nullptr);
    { const int cg = tid & 15, t0 = (tid >> 4) * 4, tpos0 = c * 128 + t0, ch = cg * 8; const bf16* rowp = PROJ + (size_t)(tok0 + t0) * PP;
      const float* cwb = a->in[I_CONVW] + (size_t)L * 768 * 4; const float* cbb = a->in[I_CONVB] + L * 768;
      float o[4][8];
      conv_apply(rawx, cwb + (g * 128 + ch) * 4, cbb + g * 128 + ch, o);
#pragma unroll
      for (int i = 0; i < 8; ++i) { u32x2 w; w.x = pk2(o[0][i], o[1][i]); w.y = pk2(o[2][i], o[3][i]); *(LAS u32x2*)(XT + swz136(ch + i, t0)) = w; }
      conv_apply(rawb, cwb + (256 + g * 128 + ch) * 4, cbb + 256 + g * 128 + ch, o);
#pragma unroll
      for (int k = 0; k < 4; ++k) *(LAS v4u*)(Bm + (t0 + k) * 136 + ch) = pack8(o[k]);
      conv_apply(rawc, cwb + (512 + g * 128 + ch) * 4, cbb + 512 + g * 128 + ch, o);
#pragma unroll
      for (int k = 0; k < 4; ++k) *(LAS v4u*)(Cm + (t0 + k) * 136 + ch) = pack8(o[k]); }
    {
      float pv[4][8];
#pragma unroll
      for (int i = 0; i < 4; ++i)
#pragma unroll
          for (int e = 0; e < 8; ++e) pv[i][e] = 0.f;
      const v4u* sp = (const v4u*)(ST + (size_t)((b * 16) * 4 + 2 * g) * 64 * 128) + tid; constexpr size_t cstride = (size_t)4 * 64 * 128 / 8;
      float w0 = 1.f, w1 = 1.f;
      for (int jt = c - 1; jt >= 0; jt -= 8) {
          v4u ld[8][4];
#pragma unroll
          for (int u = 0; u < 8; ++u) { const int jc = (jt - u >= 0) ? jt - u : 0;
#pragma unroll
              for (int i = 0; i < 4; ++i) ld[u][i] = sp[(size_t)jc * cstride + i * 512]; }
#pragma unroll
          for (int u = 0; u < 8; ++u) { const int jj = jt - u; const bool ok = jj >= 0; const float ww0 = ok ? w0 : 0.f, ww1 = ok ? w1 : 0.f;
#pragma unroll
              for (int i = 0; i < 4; ++i) { float f[8]; unpack8(ld[u][i], f); const float ww = i < 2 ? ww0 : ww1;
#pragma unroll
                  for (int e = 0; e < 8; ++e) pv[i][e] += ww * f[e]; }
              if (ok) { w0 *= CD[(b * 16 + jj) * 4 + 2 * g]; w1 *= CD[(b * 16 + jj) * 4 + 2 * g + 1]; } } }
#pragma unroll
      for (int i = 0; i < 4; ++i) *(LAS v4u*)(PV + (i * 32 + (tid >> 4)) * 136 + (tid & 15) * 8) = pack8(pv[i]); }
    __syncthreads();
    const int lt = wave >> 1, pt = wave & 1;
    f32x16 cb[2];
#pragma unroll
    for (int q = 0; q < 2; ++q) { const int st = (wave & 1) * 2 + q; cb[q] = (f32x16){}; if (st <= lt) cb[q] = mma_tile(Cm + lt * 32 * 136, 136, Bm + st * 32 * 136, 136, 128, cb[q], r, lh); }
    f32x16 y[2];
#pragma unroll
    for (int hh = 0; hh < 2; ++hh) {
        __syncthreads();
#pragma unroll
        for (int q = 0; q < 2; ++q) { const int s = ((wave & 1) * 2 + q) * 32 + r; const float as = acs[s * 2 + hh], ds = dtv[s * 2 + hh];
#pragma unroll
            for (int reg = 0; reg < 16; ++reg) { const int l = lt * 32 + crow(reg, lh); const float val = (s <= l) ? cb[q][reg] * __expf(acs[l * 2 + hh] - as) * ds : 0.f; Bm[l * 136 + s] = f2b(val); } }
        __syncthreads();
        f32x16 a1 = {}, a2 = {};
        a1 = mma_tile_sw<false, true>(Bm, lt * 32, XT, hh * 64 + pt * 32, 32 * (lt + 1), a1, r, lh);
        a2 = mma_tile(Cm + lt * 32 * 136, 136, PV + (hh * 64 + pt * 32) * 136, 136, 128, a2, r, lh);
        const int ch = hh * 64 + pt * 32 + r; const float Dh = a->in[I_SSMD][L * 4 + 2 * g + hh];
#pragma unroll
        for (int reg = 0; reg < 16; ++reg) { const int l = lt * 32 + crow(reg, lh); const float xsv = bf2f(XT[swz136(ch, l)]); const float zz = bf2f(PROJ[(size_t)(tok0 + l) * PP + C_Z + g * 128 + ch]);
            const float yv = a1[reg] + __expf(acs[l * 2 + hh]) * a2[reg] + Dh * xsv; y[hh][reg] = yv * silu_f(zz); }
    }
    __syncthreads();
    LAS float* ybuf = (LAS float*)lds;
#pragma unroll
    for (int hh = 0; hh < 2; ++hh)
#pragma unroll
        for (int reg = 0; reg < 16; ++reg) { const int l = lt * 32 + crow(reg, lh); ybuf[l * 129 + hh * 64 + pt * 32 + r] = y[hh][reg]; }
    __syncthreads();
    { const int t = tid >> 2, ch0 = (tid & 3) * 32; float v[32]; float ss = 0.f;
#pragma unroll
      for (int i = 0; i < 32; ++i) { v[i] = ybuf[t * 129 + ch0 + i]; ss += v[i] * v[i]; }
      ss += __shfl_xor(ss, 1); ss += __shfl_xor(ss, 2);
      const float rstd = 1.0f / sqrtf(ss * (1.0f / 128.0f) + EPS); const float* nw = a->in[I_SSMNW] + L * 256 + g * 128 + ch0;
#pragma unroll
      for (int i = 0; i < 32; ++i) v[i] = v[i] * rstd * nw[i];
      bf16* op = MIX + (size_t)(tok0 + t) * DM + 256 + g * 128 + ch0;
#pragma unroll
      for (int i = 0; i < 4; ++i) *(v4u*)(op + 8 * i) = pack8(v + 8 * i); }
    __syncthreads();
}
typedef float f32x2_t __attribute__((ext_vector_type(2))); typedef __bf16 bf16x2_t __attribute__((ext_vector_type(2)));
DI unsigned cvtpk(float lo, float hi) { f32x2_t v = {lo, hi}; bf16x2_t b = __builtin_convertvector(v, bf16x2_t); return __builtin_bit_cast(unsigned, b); }
DI float xhalf_sum(float v) { auto rr = __builtin_amdgcn_permlane32_swap(__float_as_uint(v), __float_as_uint(v), false, false); return __uint_as_float(rr[0]) + __uint_as_float(rr[1]); }
DI float xhalf_max(float v) { auto rr = __builtin_amdgcn_permlane32_swap(__float_as_uint(v), __float_as_uint(v), false, false); return fmaxf(__uint_as_float(rr[0]), __uint_as_float(rr[1])); }
constexpr int ATT_TPS = 4;
constexpr int ATT_KP = 144, ATT_VP = 64 * ATT_TPS + 8, ATT_VOFF = 32 * ATT_TPS * ATT_KP, ATT_BUF = ATT_VOFF + 64 * ATT_VP;
DI void attn_block(KA a, int L, int b, int h, int s8, LAS unsigned char* lds, int tid, int wave, int lane) {
    OPQ(lane); OPQ(tid);
    const bf16* PROJ = (const bf16*)(a->ws + WS_PROJ); const bf16* VT = (const bf16*)(a->ws + WS_VT); bf16* MIX = (bf16*)(a->ws + WS_MIX);
    const int r = lane & 31, lh = lane >> 5; const size_t tokb = (size_t)b * SEQ;
    const int cw = wave >> 2, jS = s8 * 4 + (wave & 3), jL = 63 - jS, st0 = (63 - s8 * 4) / ATT_TPS;
    float p1 = 0.f, p2 = 0.f;
#pragma unroll 8
    for (int i = 0; i < 32; ++i) { p1 += a->in[I_LQ1][L * 32 + i] * a->in[I_LK1][L * 32 + i]; p2 += a->in[I_LQ2][L * 32 + i] * a->in[I_LK2][L * 32 + i]; }
    const float lam_init = (L == 0) ? 0.2f : 0.35550906f;
    const float lam = __expf(p1) - __expf(p2) + lam_init;
    const float slope2 = exp2f(-2.0f * (float)(h + 1)) * LOG2E, tstep = 32.f * slope2;
    const bf16* gk = PROJ + (tokb + (tid >> 3)) * PP + C_K + h * 64 + (tid & 7) * 8;
    const bf16* gv = VT + (size_t)(h * 64 + (tid >> 4)) * M + tokb + (tid & 15) * 8;
    const int lk = (tid >> 3) * ATT_KP + (tid & 7) * 16, lv = ATT_VOFF + (tid >> 4) * ATT_VP + (tid & 15) * 16;
    v4u sk[ATT_TPS / 2], sv[ATT_TPS / 2];
#define ATT_GLOAD(st_) do { _Pragma("unroll") for (int i_ = 0; i_ < ATT_TPS / 2; ++i_) { sk[i_] = *(const v4u*)(gk + ((size_t)(st_) * 32 * ATT_TPS + 64 * i_) * PP); sv[i_] = *(const v4u*)(gv + (size_t)32 * i_ * M + (st_) * 32 * ATT_TPS); } } while (0)
#define ATT_STORE(buf_) do { LAS unsigned char* d_ = lds + (buf_) * ATT_BUF; _Pragma("unroll") for (int i_ = 0; i_ < ATT_TPS / 2; ++i_) { *(LAS v4u*)(d_ + lk + 64 * i_ * ATT_KP) = sk[i_]; \
        *(LAS u32x2*)(d_ + lv + 32 * i_ * ATT_VP) = (u32x2){sv[i_].x, sv[i_].y}; *(LAS u32x2*)(d_ + lv + 32 * i_ * ATT_VP + 8) = (u32x2){sv[i_].z, sv[i_].w}; } } while (0)
    bf16x8 qf[2][2];
#pragma unroll
    for (int jb = 0; jb < 2; ++jb) { const bf16* qp = PROJ + (tokb + (jb == 0 ? jL : jS) * 32 + r) * PP + C_Q + h * 64 + cw * 32 + 8 * lh;
#pragma unroll
        for (int s = 0; s < 2; ++s) qf[jb][s] = *(const bf16x8*)(qp + s * 16); }
    f32x16 cinit;
#pragma unroll
    for (int reg = 0; reg < 16; ++reg) cinit[reg] = slope2 * (float)crow(reg, lh);
    f32x16 o[2][2];
#pragma unroll
    for (int jb = 0; jb < 2; ++jb)
#pragma unroll
        for (int d = 0; d < 2; ++d) o[jb][d] = (f32x16){};
    float kwmax = 0.f;
#pragma unroll 8
    for (int i = 0; i < 32; ++i) kwmax = fmaxf(kwmax, fabsf(a->in[I_KNW][L * 32 + i]));
    const float knorm = 5.65685425f * 1.01f * kwmax;
    float mref[2], lrun[2] = {0.f, 0.f};
#pragma unroll
    for (int jb = 0; jb < 2; ++jb) { float qs = 0.f;
#pragma unroll
        for (int s2 = 0; s2 < 2; ++s2)
#pragma unroll
            for (int e = 0; e < 8; ++e) { const float qv = bf2f((bf16)qf[jb][s2][e]); qs += qv * qv; }
        qs = xhalf_sum(qs); mref[jb] = sqrtf(qs) * knorm + 31.f * slope2; }
    ATT_GLOAD(st0);
    ATT_STORE(0);
    __syncthreads();
    int cur = 0;
    const int koff = r * ATT_KP + 16 * lh + cw * 64, voff = ATT_VOFF + r * ATT_VP + 8 * lh;
    for (int st = st0; st >= 0; --st) {
        if (st > 0) ATT_GLOAD(st - 1);
#pragma unroll 1
        for (int tl = ATT_TPS - 1; tl >= 0; --tl) {
            const int kt = st * ATT_TPS + tl;
            int act = (kt <= jL) ? 1 : 0; asm volatile("" : "+v"(act)); act = __builtin_amdgcn_readfirstlane(act);
            if (act) {
                const LAS unsigned char* kb = lds + cur * ATT_BUF + koff + tl * 32 * ATT_KP; const LAS unsigned char* vb = lds + cur * ATT_BUF + voff + tl * 64;
                const bf16x8 k0 = *(const LAS bf16x8*)kb, k1 = *(const LAS bf16x8*)(kb + 32);
                u32x2 vlo[2][2], vhi[2][2];
#pragma unroll
                for (int d = 0; d < 2; ++d)
#pragma unroll
                    for (int s = 0; s < 2; ++s) { vlo[d][s] = *(const LAS u32x2*)(vb + d * 32 * ATT_VP + 32 * s); vhi[d][s] = *(const LAS u32x2*)(vb + d * 32 * ATT_VP + 32 * s + 16); }
#pragma unroll
                for (int jb = 0; jb < 2; ++jb) {
                    const int jq = (jb == 0) ? jL : jS;
                    int on = (kt <= jq) ? 1 : 0; asm volatile("" : "+v"(on)); on = __builtin_amdgcn_readfirstlane(on);
                    if (on) {
                        int isdiag = (kt == jq) ? 1 : 0; asm volatile("" : "+v"(isdiag)); isdiag = __builtin_amdgcn_readfirstlane(isdiag);
                        f32x16 S = MFMA32(k0, qf[jb][0], cinit); S = MFMA32(k1, qf[jb][1], S);
                        if (isdiag) {
#pragma unroll
                            for (int reg = 0; reg < 16; ++reg) S[reg] = crow(reg, lh) > r ? -INFINITY : S[reg];
                        }
                        const float sh = tstep * (float)(kt - jq) - mref[jb];
                        float rs4[4] = {0.f, 0.f, 0.f, 0.f};
#pragma unroll
                        for (int reg = 0; reg < 16; ++reg) { S[reg] = __builtin_amdgcn_exp2f(S[reg] + sh); rs4[reg & 3] += S[reg]; }
                        lrun[jb] += (rs4[0] + rs4[1]) + (rs4[2] + rs4[3]);
                        u32x4 w0, w1;
                        w0.x = cvtpk(S[0], S[1]); w0.y = cvtpk(S[2], S[3]); w0.z = cvtpk(S[4], S[5]); w0.w = cvtpk(S[6], S[7]);
                        w1.x = cvtpk(S[8], S[9]); w1.y = cvtpk(S[10], S[11]); w1.z = cvtpk(S[12], S[13]); w1.w = cvtpk(S[14], S[15]);
                        const bf16x8 pb0 = __builtin_bit_cast(bf16x8, w0), pb1 = __builtin_bit_cast(bf16x8, w1);
#pragma unroll
                        for (int d = 0; d < 2; ++d) {
                            const u32x4 v0 = (u32x4){vlo[d][0].x, vlo[d][0].y, vhi[d][0].x, vhi[d][0].y}, v1 = (u32x4){vlo[d][1].x, vlo[d][1].y, vhi[d][1].x, vhi[d][1].y};
                            o[jb][d] = MFMA32(__builtin_bit_cast(bf16x8, v0), pb0, o[jb][d]);
                            o[jb][d] = MFMA32(__builtin_bit_cast(bf16x8, v1), pb1, o[jb][d]);
                        }
                    }
                }
            }
        }
        if (st > 0) ATT_STORE(cur ^ 1);
        __syncthreads();
        cur ^= 1;
    }
#undef ATT_GLOAD
#undef ATT_STORE
    lrun[0] = xhalf_sum(lrun[0]); lrun[1] = xhalf_sum(lrun[1]);
    const int give = (cw == 0) ? 1 : 0, keep = 1 - give;
    LAS float* xw = (LAS float*)lds + (size_t)wave * 2048;
    LAS const float* xr = (LAS const float*)lds + (size_t)(wave ^ 4) * 2048;
    { const float sc = (cw == 0 ? 1.0f : lam) / (give == 0 ? lrun[0] : lrun[1]);
#pragma unroll
      for (int d = 0; d < 2; ++d)
#pragma unroll
          for (int reg = 0; reg < 16; ++reg) xw[(d * 16 + reg) * 64 + lane] = (give == 0 ? o[0][d][reg] : o[1][d][reg]) * sc; }
    __syncthreads();
    { const float sck = (cw == 0 ? 1.0f : lam) / (keep == 0 ? lrun[0] : lrun[1]); const float sgn = (cw == 0) ? 1.0f : -1.0f;
      f32x16 v[2]; float ss = 0.f;
#pragma unroll
      for (int d = 0; d < 2; ++d)
#pragma unroll
          for (int reg = 0; reg < 16; ++reg) { const float mine = (keep == 0 ? o[0][d][reg] : o[1][d][reg]) * sck, other = xr[(d * 16 + reg) * 64 + lane]; const float val = sgn * (mine - other); v[d][reg] = val; ss += val * val; }
      ss = xhalf_sum(ss);
      const float rstd = (1.0f - lam_init) / sqrtf(ss * (1.0f / 64.0f) + EPS);
      const int jq = (keep == 0) ? jL : jS;
      bf16* op = MIX + (tokb + jq * 32 + r) * DM + 768 + h * 64;
#pragma unroll
      for (int d = 0; d < 2; ++d)
#pragma unroll
          for (int g4 = 0; g4 < 4; ++g4) { const int d0 = d * 32 + 8 * g4 + 4 * lh; const f32x4 w4 = *(const f32x4*)(a->in[I_SUBLN] + L * 64 + d0);
              u32x2 pk; pk.x = cvtpk(v[d][4 * g4] * rstd * w4.x, v[d][4 * g4 + 1] * rstd * w4.y); pk.y = cvtpk(v[d][4 * g4 + 2] * rstd * w4.z, v[d][4 * g4 + 3] * rstd * w4.w);
              *(u32x2*)(op + d0) = pk; } }
    __syncthreads();
}

#ifndef DIS_SSD1
#define DIS_SSD1 0
#endif
#ifndef DIS_SSD2
#define DIS_SSD2 0
#endif
#ifndef DIS_GMLP
#define DIS_GMLP 0
#endif
#ifndef DIS_POOL
#define DIS_POOL 0
#endif
#ifndef DIS_ATTN
#define DIS_ATTN 0
#endif
#ifndef DIS_GEMM
#define DIS_GEMM 0
#endif
#ifndef REP_P0
#define REP_P0 1
#endif
#ifndef REP_M1
#define REP_M1 1
#endif
#ifndef REP_SSD2
#define REP_SSD2 1
#endif
#ifndef REP_ATTN
#define REP_ATTN 1
#endif
#ifndef REP_N2
#define REP_N2 1
#endif
#ifndef REP_BAR
#define REP_BAR 1
#endif
#ifndef REP_G1
#define REP_G1 1
#endif
#ifndef REP_G3
#define REP_G3 1
#endif
#ifndef MK_SPLIT
#define MK_SPLIT 0
#endif
constexpr int N_PHASES = 13;
__global__ void __launch_bounds__(NWAVES * 64, 2) hybrid_fwd(Args args) {
    extern __shared__ __attribute__((aligned(16))) unsigned char lds_raw[];
    LAS unsigned char* lds = (LAS unsigned char*)lds_raw;
    const int tid = threadIdx.x, lane = tid & 63, wave = __builtin_amdgcn_readfirstlane(tid >> 6);
    const int G = gridDim.x; const int bx = blockIdx.x; const int vcu = (G % 8 == 0) ? (bx % 8) * (G / 8) + bx / 8 : bx;
    for (int u = tid; u < (LDS_BYTES - LDSCTL_OFF) / 4; u += NWAVES * 64) ((LAS unsigned*)(lds + LDSCTL_OFF))[u] = 0u;
    __syncthreads();
    int lo, hi;
    XcdBarrier bar;
    { KA ka = kargs(); lo = ka->ph_lo; hi = ka->ph_hi; gu32* ctl = (gu32*)(ka->ws + WS_CTL);
      bar.bar = (unsigned*)(ctl + CW_BAR); bar.x = 0; bar.st = nullptr;
      if (!MK_SPLIT) bar = xcd_barrier_post((unsigned*)(ctl + CW_BAR), (volatile LAS unsigned*)(lds + MISC_OFF) + 8); }
#define IN(k) (lo <= (k) && (k) < hi)
#define SEAM(k) do { if (IN(k) && IN((k) + 1)) for (int rb_ = 0; rb_ < REP_BAR; ++rb_) xcd_barrier(bar); } while (0)
    if (IN(0)) { KA ka = kargs(); for (int rep = 0; rep < REP_P0; ++rep) { weights_phase(ka, lds, 0, 0, WI_INP, vcu * NWAVES + wave, G * NWAVES, wave, lane); __syncthreads(); }
        prep_phase(ka->in[I_X], (bf16*)(ka->ws + WS_XN), (float*)(ka->ws + WS_RS), vcu, G, wave, lane); }
    SEAM(0);
#pragma unroll 1
    for (int L = 0; L < DEPTH; ++L) {
        const int pb = 1 + 6 * L;
        if (IN(pb)) { KA ka = kargs(); unsigned char* ws = ka->ws; const bf16* wb = (const bf16*)(ws + WS_W + (size_t)L * W_LAYER + W_IN); const bf16* XB = (const bf16*)(ws + WS_XN);
            const float* rs = (const float*)(ws + WS_RS) + (size_t)(2 * L) * RS_STRIDE;
            for (int rep = 0; rep < REP_G1; ++rep) {
            { pg8::Gemm g{XB, wb, M, PP, DM}; pg8::StaticOrder S; S.init(M, PP, G, bx);
              pg8::EpiInProj E{(bf16*)(ws + WS_PROJ), ka->in[I_QNW] + L * 32, ka->in[I_KNW] + L * 32, rs};
              pg8::gemm_phase<pg8::EpiInProj, pg8::StaticOrder, true, true>(lds, g, S, E); }
            { pg8::Gemm g{wb + (size_t)PP * DM, XB, 256, M, DM}; pg8::StaticOrder S; S.init(256, M, G, (bx + 192) % G);
              pg8::EpiVT E{(bf16*)(ws + WS_VT), rs};
              pg8::gemm_phase<pg8::EpiVT, pg8::StaticOrder, true, true>(lds, g, S, E); }
            }
            { const int nidle = G - G / 2; if (bx >= G / 2) weights_phase(ka, lds, L, WI_INP, WI_INP + WI_OUT + 2 * WI_G, (bx - G / 2) * NWAVES + wave, nidle * NWAVES, wave, lane); __syncthreads(); }
        }
        SEAM(pb);
        if (IN(pb + 1)) { KA ka = kargs();
            __syncthreads();
            for (int rep = 0; rep < REP_M1; ++rep) {
            if (!DIS_SSD1) for (int it = vcu; it < 256; it += G) ssd_pass1(ka, L, it >> 5, (it >> 1) & 15, it & 1, lds, tid, wave, lane);
            if (!DIS_GMLP) for (int it = vcu; it < 512; it += 2 * G) { if (it + G < 512) gmlp_pair(ka, L, it, it + G, lds, tid, wave, lane); else gmlp_item(ka, L, it >> 6, (it >> 2) & 15, it & 3, lds, tid, wave, lane); }
            if (!DIS_POOL) for (int it = vcu; it < 512; it += 2 * G) { if (it + G < 512) pool_pair(ka, L, it, it + G, lds, tid, wave, lane); else pool_item(ka, L, it >> 6, (it >> 2) & 15, it & 3, lds, tid, wave, lane); }
            }
        }
        SEAM(pb + 1);
        if (IN(pb + 2)) { KA ka = kargs();
            __syncthreads();
            for (int rep = 0; rep < REP_SSD2; ++rep)
            if (!DIS_SSD2) for (int it = vcu; it < 256; it += G) ssd_pass2(ka, L, it >> 5, (it >> 1) & 15, it & 1, lds, tid, wave, lane);
            for (int rep = 0; rep < REP_ATTN; ++rep)
            if (!DIS_ATTN) for (int it = vcu; it < 256; it += G) attn_block(ka, L, it >> 5, (it >> 3) & 3, it & 7, lds, tid, wave, lane);
        }
        SEAM(pb + 2);
        if (IN(pb + 3)) { KA ka = kargs(); unsigned char* ws = ka->ws;
            pg8::Gemm g{(const bf16*)(ws + WS_MIX), (const bf16*)(ws + WS_W + (size_t)L * W_LAYER + W_OUT), M, DM, DM}; pg8::StaticOrder S; S.init(M, DM, G, bx);
            pg8::EpiResid E{(const float*)nullptr, (const bf16*)(ws + WS_XN), (float*)nullptr, (bf16*)(ws + WS_XN), (float*)(ws + WS_RS) + (size_t)(2 * L + 1) * RS_STRIDE};
            pg8::gemm_phase<pg8::EpiResid, pg8::StaticOrder, false, true>(lds, g, S, E); }
        SEAM(pb + 3);
        if (IN(pb + 4)) for (int rep = 0; rep < REP_G3; ++rep) { KA ka = kargs(); unsigned char* ws = ka->ws;
            pg8::Gemm g{(const bf16*)(ws + WS_XN), (const bf16*)(ws + WS_W + (size_t)L * W_LAYER + W_GU), M, NGU, DM}; pg8::StaticOrder S; S.init(M, NGU, G, bx);
            pg8::EpiSwiGLU E{(bf16*)(ws + WS_H), (const float*)(ws + WS_RS) + (size_t)(2 * L + 1) * RS_STRIDE};
            pg8::gemm_phase<pg8::EpiSwiGLU, pg8::StaticOrder, true, true>(lds, g, S, E);
            { const int nidle = G - G / 2; if (bx >= G / 2) { weights_phase(ka, lds, L, WI_PER_L - WI_D, WI_PER_L, (bx - G / 2) * NWAVES + wave, nidle * NWAVES, wave, lane);
                if (L + 1 < DEPTH) weights_phase(ka, lds, L + 1, 0, WI_INP, (bx - G / 2) * NWAVES + wave, nidle * NWAVES, wave, lane); } __syncthreads(); } }
        SEAM(pb + 4);
        if (IN(pb + 5)) { KA ka = kargs(); unsigned char* ws = ka->ws; const bool more = (L + 1 < DEPTH);
            pg8::Gemm g{(const bf16*)(ws + WS_H), (const bf16*)(ws + WS_W + (size_t)L * W_LAYER + W_DN), M, DM, DFF}; pg8::StaticOrder S; S.init(M, DM, G, bx);
            pg8::EpiResid E{(const float*)nullptr, (const bf16*)(ws + WS_XN), more ? (float*)nullptr : ka->out, more ? (bf16*)(ws + WS_XN) : (bf16*)nullptr, more ? (float*)(ws + WS_RS) + (size_t)(2 * L + 2) * RS_STRIDE : (float*)nullptr};
            pg8::gemm_phase<pg8::EpiResid, pg8::StaticOrder, false, true>(lds, g, S, E); }
        if (L + 1 < DEPTH) SEAM(pb + 5);
    }
#undef IN
#undef SEAM
}

extern "C" void kernel_launch(void* const* d_in, const int* in_sizes, int n_in, void* d_out, int out_size, void* d_ws, size_t ws_size, hipStream_t stream) {
    static int grid = 0;
    if (grid == 0) {
        if (n_in != N_IN || in_sizes[0] != M * DM || out_size != M * DM || ws_size < WS_END) { fprintf(stderr, "kernel_launch: unexpected problem shape (n_in %d, in0 %d, out %d, ws %zu); nothing launched\n", n_in, n_in > 0 ? in_sizes[0] : -1, out_size, ws_size); grid = -1; return; }
        int dev = 0, cus = 0;
        if (hipGetDevice(&dev) != hipSuccess || hipDeviceGetAttribute(&cus, hipDeviceAttributeMultiprocessorCount, dev) != hipSuccess) { grid = -1; return; }
        if (hipFuncSetAttribute((const void*)hybrid_fwd, hipFuncAttributeMaxDynamicSharedMemorySize, LDS_BYTES) != hipSuccess) { fprintf(stderr, "kernel_launch: hipFuncSetAttribute failed\n"); grid = -1; return; }
        int per_cu = 0;
        if (hipOccupancyMaxActiveBlocksPerMultiprocessor(&per_cu, (const void*)hybrid_fwd, NWAVES * 64, LDS_BYTES) != hipSuccess || per_cu < 1) fprintf(stderr, "kernel_launch: occupancy query reports %d\n", per_cu);
        (void)hipGetLastError();
        grid = cus;
    }
    if (grid < 0) return;
    (void)hipMemsetAsync((char*)d_ws + WS_CTL, 0, CTL_ZERO_BYTES, stream);
    Args a{};
    for (int i = 0; i < N_IN; ++i) a.in[i] = (const float*)d_in[i];
    a.out = (float*)d_out; a.ws = (unsigned char*)d_ws;
#if MK_SPLIT
    for (int p = 0; p < N_PHASES; ++p) { a.ph_lo = p; a.ph_hi = p + 1; hipLaunchKernelGGL(hybrid_fwd, dim3(grid), dim3(NWAVES * 64), LDS_BYTES, stream, a); }
#else
    a.ph_lo = 0; a.ph_hi = N_PHASES;
    hipLaunchKernelGGL(hybrid_fwd, dim3(grid), dim3(NWAVES * 64), LDS_BYTES, stream, a);
#endif
}
```

```cpp
#include <hip/hip_runtime.h>
#include <cstdio>
#include <cstdint>
#include <cmath>
namespace pg8 {
#define PG8_LAS __attribute__((address_space(3)))
typedef unsigned short bf16_t;
typedef short bf16x8 __attribute__((ext_vector_type(8)));
typedef float f32x4 __attribute__((ext_vector_type(4)));
typedef unsigned u32x4 __attribute__((ext_vector_type(4)));
constexpr int BM = 256, BK = 64, HALF = 128, HTB = HALF * BK * 2  , STAGE_BYTES = 8 * HTB, NXCD = 8, WGM = 8;

__host__ __device__ __forceinline__ int lds_byte(int r, int c) { const int st = (r >> 4) * 2 + (c >> 5), rr = r & 15, cc = c & 31, ob = rr * 64 + cc * 2; return st * 1024 + (ob ^ (((ob >> 9) & 1) << 5)); }
__host__ __device__ __forceinline__ void stage_rc(int b, int& R, int& C) { const int st = b / 1024, sb = b % 1024, swz = sb ^ (((sb >> 9) & 1) << 5); R = (st >> 1) * 16 + swz / 64; C = (st & 1) * 32 + (swz % 64) / 2; }
__host__ __device__ __forceinline__ int perm32(int rho) { const int n = rho >> 4, i = rho & 15; return 8 * (i >> 2) + 4 * n + (i & 3); }

struct Unit { int pm, pn; };
struct Gemm { const bf16_t* A; const bf16_t* Bt; int M, N, K; };

struct StaticOrder {
    int nM, nN, nwg, G, c;
    __host__ __device__ void init(int M, int N, int G_, int c_) { nM = M / BM; nN = N / BM; nwg = nM * nN; G = G_; c = c_; }
    __host__ __device__ bool next(int i, Unit& u) const {
        const long L = (long)i * G + c; if (L >= nwg) return false;
        int wgid = (int)L; { const int q = nwg / NXCD, r = nwg % NXCD, xcd = wgid % NXCD, off = wgid / NXCD; wgid = (xcd < r ? xcd * (q + 1) : r * (q + 1) + (xcd - r) * q) + off; }
        const int nig = WGM * nN, gid = wgid / nig, fm = gid * WGM, gsz = (nM - fm) < WGM ? (nM - fm) : WGM;
        u.pm = fm + ((wgid % nig) % gsz); u.pn = (wgid % nig) / gsz; return true;
    }
    __device__ __forceinline__ void a_ready(const Unit&) const {}
    __device__ __forceinline__ void done(const Unit&) const {}
};

__device__ __forceinline__ unsigned cvt_pk_bf16(float lo, float hi) { unsigned r; asm volatile("v_cvt_pk_bf16_f32 %0, %1, %2" : "=v"(r) : "v"(lo), "v"(hi)); return r; }
typedef float f32x2 __attribute__((ext_vector_type(2)));
__device__ __forceinline__ f32x2 gelu_pk(f32x2 v) {
    const f32x2 av = __builtin_elementwise_abs(v), d = av * 0.2316418882f + 1.0f;
    f32x2 t; t.x = __builtin_amdgcn_rcpf(d.x); t.y = __builtin_amdgcn_rcpf(d.y);
    f32x2 q = t * 0.5307027145f + (-0.7265760135f); q = q * t + 0.7107068705f; q = q * t + (-0.142248368f); q = q * t + 0.127414796f; q = q * t;
    const f32x2 s = (v * v) * (-0.72134752044f);
    f32x2 e; e.x = __builtin_amdgcn_exp2f(s.x); e.y = __builtin_amdgcn_exp2f(s.y);
    const f32x2 m = v * (q * e), r = v - m;
    f32x2 o; o.x = v.x < 0.f ? m.x : r.x; o.y = v.y < 0.f ? m.y : r.y; return o;
}

template <int ACT  > struct EpiBf16 {
    static constexpr bool PERM = true, AFTER_DRAIN = false; static_assert(ACT == 0 || ACT == 1, "EpiBf16: ACT is 0 (none) or 1 (gelu_pk)");
    bf16_t* O; int ldc; const float* bias; int split_cols; size_t split_stride; float scale0;
    __device__ __forceinline__ void operator()(const f32x4 (&acc)[2][2][4][2], const Unit& u, int wr, int wc, int fr, int fq) const {
        const int row0 = u.pm * BM + wr * 64 + fr; int colt = u.pn * BM; bf16_t* base = O;
        float sc = 1.f; if (split_cols) { const int t = colt / split_cols; base += (size_t)t * split_stride; colt -= t * split_cols; if (t == 0) sc = scale0; }
        const int col0 = colt + wc * 32 + 8 * fq, bcol0 = u.pn * BM + wc * 32 + 8 * fq;
        f32x4 bv[2][2];
#pragma unroll
        for (int bj = 0; bj < 2; ++bj)
#pragma unroll
            for (int n = 0; n < 2; ++n) bv[bj][n] = bias ? *(const f32x4*)(bias + bcol0 + bj * HALF + 4 * n) : (f32x4){0.f, 0.f, 0.f, 0.f};
#pragma unroll
        for (int ai = 0; ai < 2; ++ai)
#pragma unroll
            for (int m = 0; m < 4; ++m) { bf16_t* rowp = base + (size_t)(row0 + ai * HALF + m * 16) * ldc + col0;
#pragma unroll
                for (int bj = 0; bj < 2; ++bj) { f32x4 v0 = acc[ai][bj][m][0] + bv[bj][0], v1 = acc[ai][bj][m][1] + bv[bj][1];
                    if (ACT == 1) { f32x2 a = gelu_pk((f32x2){v0[0], v0[1]}), b = gelu_pk((f32x2){v0[2], v0[3]}), c = gelu_pk((f32x2){v1[0], v1[1]}), d = gelu_pk((f32x2){v1[2], v1[3]});
                        v0 = (f32x4){a.x, a.y, b.x, b.y}; v1 = (f32x4){c.x, c.y, d.x, d.y}; }
                    v0 = v0 * sc; v1 = v1 * sc; u32x4 w; w.x = cvt_pk_bf16(v0[0], v0[1]); w.y = cvt_pk_bf16(v0[2], v0[3]); w.z = cvt_pk_bf16(v1[0], v1[1]); w.w = cvt_pk_bf16(v1[2], v1[3]);
                    *(u32x4*)(rowp + bj * HALF) = w; } }
    }
};
template <class Epi, class Sched, bool ALIGN_EPI = false, bool SP2 = false>
__device__ __forceinline__ void gemm_phase(PG8_LAS unsigned char* lds, const Gemm g, const Sched& S, const Epi& E) {
    int tid_ = threadIdx.x; asm volatile("" : "+v"(tid_));
    const int tid = tid_, wid = __builtin_amdgcn_readfirstlane(tid >> 6), lane = tid & 63, wr = wid >> 2, wc = wid & 3, fr = lane & 15, fq = lane >> 4;
    const int K = g.K, nt = K / BK;
    unsigned voffA[2], voffB[2];
#pragma unroll
    for (int i = 0; i < 2; ++i) { int R, C; stage_rc(tid * 16 + i * 8192, R, C); const int Rb = Epi::PERM ? ((R & ~31) + perm32(R & 31)) : R;
        voffA[i] = (unsigned)(R * K + C) * 2u; voffB[i] = (unsigned)(Rb * K + C) * 2u; }
    const size_t kstep = (size_t)(BK * 2);
    const size_t hstep = (size_t)HALF * K * 2;
    const size_t tstep = 2 * hstep;
    const unsigned ldsw = (unsigned)wid * 1024u;
    const int aoff = lds_byte(wr * 64 + fr, fq * 8), boff = lds_byte(wc * 32 + fr, fq * 8);
#define PG8_SA(b, h) (((b) * 2 + (h)) * HTB)
#define PG8_SB(b, h) ((4 + (b) * 2 + (h)) * HTB)
#define PG8_STAGE(bufoff, gbase, voff) do { _Pragma("unroll") for (int _i = 0; _i < 2; ++_i) \
        __builtin_amdgcn_global_load_lds((const unsigned*)((const char*)(gbase) + (voff)[_i]), (PG8_LAS unsigned*)(lds + (bufoff) + ldsw + _i * 8192), 16, 0, 0); } while (0)
#define PG8_LDA(dst, b, h) do { _Pragma("unroll") for (int m = 0; m < 4; ++m) _Pragma("unroll") for (int k = 0; k < 2; ++k) dst[m][k] = *(const PG8_LAS bf16x8*)(lds + PG8_SA(b, h) + aoff + m * 2048 + k * 1024); } while (0)
#define PG8_LDB(dst, b, h) do { _Pragma("unroll") for (int n = 0; n < 2; ++n) _Pragma("unroll") for (int k = 0; k < 2; ++k) dst[n][k] = *(const PG8_LAS bf16x8*)(lds + PG8_SB(b, h) + boff + n * 2048 + k * 1024); } while (0)
#define PG8_MMA(ai, bj, At, Bt) do { __builtin_amdgcn_s_setprio(1); _Pragma("unroll") for (int m = 0; m < 4; ++m) _Pragma("unroll") for (int n = 0; n < 2; ++n) _Pragma("unroll") for (int k = 0; k < 2; ++k) \
        acc[ai][bj][m][n] = __builtin_amdgcn_mfma_f32_16x16x32_bf16(Bt[n][k], At[m][k], acc[ai][bj][m][n], 0, 0, 0); __builtin_amdgcn_s_setprio(0); } while (0)
#define PG8_WAIT_V(n) asm volatile("s_waitcnt vmcnt(" #n ")" ::: "memory")
#define PG8_WAIT_L(n) asm volatile("s_waitcnt lgkmcnt(" #n ")" ::: "memory")
#define PG8_BAR __builtin_amdgcn_s_barrier()
#define PG8_SCHED __builtin_amdgcn_sched_barrier(0)
    Unit cur, nxt; int ui = 0;
    if (!S.next(0, cur)) return;
    f32x4 acc[2][2][4][2];
#pragma unroll
    for (int a = 0; a < 2; ++a)
#pragma unroll
        for (int b = 0; b < 2; ++b)
#pragma unroll
            for (int m = 0; m < 4; ++m)
#pragma unroll
                for (int n = 0; n < 2; ++n) acc[a][b][m][n] = (f32x4){0.f, 0.f, 0.f, 0.f};
    bf16x8 At[4][2], B0[2][2], B1[2][2];
    const char* cA = (const char*)g.A + (size_t)cur.pm * tstep; const char* cB = (const char*)g.Bt + (size_t)cur.pn * tstep;
    S.a_ready(cur);
    if constexpr (SP2) {
        PG8_STAGE(PG8_SB(0, 0), cB, voffB); PG8_STAGE(PG8_SB(0, 1), cB + hstep, voffB); PG8_STAGE(PG8_SA(0, 0), cA, voffA); PG8_STAGE(PG8_SA(0, 1), cA + hstep, voffA);
        if (wr == 1) PG8_BAR;
        PG8_WAIT_V(2); PG8_BAR;
        PG8_STAGE(PG8_SB(1, 0), cB + kstep, voffB); PG8_STAGE(PG8_SA(1, 0), cA + kstep, voffA); PG8_STAGE(PG8_SB(1, 1), cB + hstep + kstep, voffB);
        PG8_WAIT_V(6); PG8_BAR;
    } else {
        PG8_STAGE(PG8_SB(0, 0), cB, voffB); PG8_STAGE(PG8_SA(0, 0), cA, voffA); PG8_STAGE(PG8_SB(0, 1), cB + hstep, voffB); PG8_STAGE(PG8_SA(0, 1), cA + hstep, voffA);
        if (wr == 1) PG8_BAR;
        PG8_WAIT_V(4); PG8_BAR;
        PG8_STAGE(PG8_SB(1, 0), cB + kstep, voffB); PG8_STAGE(PG8_SA(1, 0), cA + kstep, voffA); PG8_STAGE(PG8_SB(1, 1), cB + hstep + kstep, voffB);
        PG8_WAIT_V(6); PG8_BAR;
    }
    for (;;) {
        const bool has_next = S.next(ui + 1, nxt);
        const char* nA = has_next ? (const char*)g.A + (size_t)nxt.pm * tstep : cA; const char* nB = has_next ? (const char*)g.Bt + (size_t)nxt.pn * tstep : cB;
        for (int t = 0; t < nt; t += 2) {
            const bool last = (t == nt - 2);
            const char* a1 = cA + (size_t)(t + 1) * kstep;
            const char* a2 = last ? nA : cA + (size_t)(t + 2) * kstep; const char* b2 = last ? nB : cB + (size_t)(t + 2) * kstep;
            const char* a3 = a2 + kstep; const char* b3 = b2 + kstep;
            if (last && has_next) S.a_ready(nxt);
            if constexpr (SP2) {
            PG8_LDB(B0, 0, 0); PG8_LDB(B1, 0, 1); PG8_SCHED; PG8_LDA(At, 0, 0); PG8_STAGE(PG8_SA(1, 1), a1 + hstep, voffA);
            PG8_WAIT_V(8); PG8_WAIT_L(0); PG8_BAR; PG8_MMA(0, 0, At, B0); PG8_MMA(0, 1, At, B1); PG8_BAR; PG8_SCHED;
            PG8_LDA(At, 0, 1); PG8_STAGE(PG8_SB(0, 0), b2, voffB); PG8_STAGE(PG8_SB(0, 1), b2 + hstep, voffB); PG8_STAGE(PG8_SA(0, 0), a2, voffA);
            PG8_WAIT_V(8); PG8_WAIT_L(0); PG8_BAR; PG8_MMA(1, 0, At, B0); PG8_MMA(1, 1, At, B1); PG8_BAR; PG8_SCHED;
            PG8_LDB(B0, 1, 0); PG8_LDB(B1, 1, 1); PG8_SCHED; PG8_LDA(At, 1, 0); PG8_STAGE(PG8_SA(0, 1), a2 + hstep, voffA);
            PG8_WAIT_V(8); PG8_WAIT_L(0); PG8_BAR; PG8_MMA(0, 0, At, B0); PG8_MMA(0, 1, At, B1); PG8_BAR; PG8_SCHED;
            PG8_LDA(At, 1, 1); PG8_STAGE(PG8_SB(1, 0), b3, voffB); PG8_STAGE(PG8_SB(1, 1), b3 + hstep, voffB); PG8_STAGE(PG8_SA(1, 0), a3, voffA);
            PG8_WAIT_V(8); PG8_WAIT_L(0); PG8_BAR; PG8_MMA(1, 0, At, B0); PG8_MMA(1, 1, At, B1); PG8_BAR; PG8_SCHED;
            } else {
            PG8_LDB(B0, 0, 0); PG8_SCHED; PG8_LDA(At, 0, 0); PG8_STAGE(PG8_SA(1, 1), a1 + hstep, voffA);
            PG8_WAIT_L(8); PG8_BAR; PG8_WAIT_L(0); PG8_MMA(0, 0, At, B0); PG8_BAR; PG8_SCHED;
            PG8_LDB(B1, 0, 1); PG8_STAGE(PG8_SB(0, 0), b2, voffB);
            PG8_BAR; PG8_WAIT_L(0); PG8_MMA(0, 1, At, B1); PG8_BAR;
            PG8_LDA(At, 0, 1); PG8_STAGE(PG8_SA(0, 0), a2, voffA);
            PG8_BAR; PG8_WAIT_L(0); PG8_MMA(1, 0, At, B0); PG8_BAR; PG8_SCHED;
            PG8_STAGE(PG8_SB(0, 1), b2 + hstep, voffB);
            PG8_WAIT_V(6); PG8_BAR; PG8_MMA(1, 1, At, B1); PG8_BAR;
            PG8_LDB(B0, 1, 0); PG8_SCHED; PG8_LDA(At, 1, 0); PG8_STAGE(PG8_SA(0, 1), a2 + hstep, voffA);
            PG8_WAIT_L(8); PG8_BAR; PG8_WAIT_L(0); PG8_MMA(0, 0, At, B0); PG8_BAR; PG8_SCHED;
            PG8_LDB(B1, 1, 1); PG8_STAGE(PG8_SB(1, 0), b3, voffB);
            PG8_BAR; PG8_WAIT_L(0); PG8_MMA(0, 1, At, B1); PG8_BAR;
            PG8_LDA(At, 1, 1); PG8_STAGE(PG8_SA(1, 0), a3, voffA);
            PG8_BAR; PG8_WAIT_L(0); PG8_MMA(1, 0, At, B0); PG8_BAR; PG8_SCHED;
            PG8_STAGE(PG8_SB(1, 1), b3 + hstep, voffB);
            PG8_WAIT_V(6); PG8_BAR; PG8_MMA(1, 1, At, B1); PG8_BAR;
            }
        }
        if constexpr (ALIGN_EPI) { if (wr == 0) PG8_BAR; }
        if constexpr (!Epi::AFTER_DRAIN) { E(acc, cur, wr, wc, fr, fq); S.done(cur); }
        if (!has_next) break;
#pragma unroll
        for (int a = 0; a < 2; ++a)
#pragma unroll
            for (int b = 0; b < 2; ++b)
#pragma unroll
                for (int m = 0; m < 4; ++m)
#pragma unroll
                    for (int n = 0; n < 2; ++n) acc[a][b][m][n] = (f32x4){0.f, 0.f, 0.f, 0.f};
        cur = nxt; cA = nA; cB = nB; ++ui;
        if constexpr (ALIGN_EPI) { if (wr == 1) PG8_BAR; }
    }
    PG8_WAIT_V(0);
    if constexpr (!ALIGN_EPI) { if (wr == 0) PG8_BAR; }
    PG8_BAR;
    if constexpr (Epi::AFTER_DRAIN) { E.fused(acc, cur, wr, wc, fr, fq, lds, wid, lane); S.done(cur); }
#undef PG8_SA
#undef PG8_SB
#undef PG8_STAGE
#undef PG8_LDA
#undef PG8_LDB
#undef PG8_MMA
#undef PG8_WAIT_V
#undef PG8_WAIT_L
#undef PG8_BAR
#undef PG8_SCHED
}
}
#define GAS __attribute__((address_space(1)))
#define LAS __attribute__((address_space(3)))
typedef unsigned short bf16;
typedef unsigned v4u __attribute__((ext_vector_type(4)));
typedef float f32x4 __attribute__((ext_vector_type(4)));
typedef short bf16x8 __attribute__((ext_vector_type(8)));
typedef GAS unsigned gu32;
typedef GAS unsigned long long gu64;
#define RLX_AGENT __ATOMIC_RELAXED, __HIP_MEMORY_SCOPE_AGENT
#define LDS_WAIT() asm volatile("s_waitcnt lgkmcnt(0)" ::: "memory")
#define VM_WAIT() asm volatile("s_waitcnt vmcnt(0)" ::: "memory")
__device__ __forceinline__ unsigned long long rt() { return __builtin_amdgcn_s_memrealtime(); }
__device__ __forceinline__ unsigned f2bf(float f) { unsigned u = __builtin_bit_cast(unsigned, f); return (u + 0x7fffu + ((u >> 16) & 1u)) >> 16; }
__device__ __forceinline__ unsigned pk2(float lo, float hi) { return f2bf(lo) | (f2bf(hi) << 16); }

#define XB_TMO      128
#define XB_XCNT(j)  (256  + 64 * (j))
#define XB_XSUB(j)  (1280 + 64 * (j))
#define XB_XGEN(j)  (2304 + 64 * (j))
#define XB_TOP      3328
#define XB_TOPGEN   3392
#define XCD_BAR_WORDS 3456
#define XB_SPIN_CAP (1u << 18)

__device__ __forceinline__ unsigned xb_ld(unsigned* p)              { return __hip_atomic_load(p, __ATOMIC_RELAXED, __HIP_MEMORY_SCOPE_AGENT); }
__device__ __forceinline__ unsigned xb_add(unsigned* p, unsigned v) { return __hip_atomic_fetch_add(p, v, __ATOMIC_RELAXED, __HIP_MEMORY_SCOPE_AGENT); }
__device__ __forceinline__ unsigned xb_xcc_id() { return (unsigned)__builtin_amdgcn_s_getreg((3 << 11) | 20) & 0xFu; }
#define XB_SPIN(cond, bar) do { unsigned _sp = 0; while (cond) { __builtin_amdgcn_s_sleep(1); \
    if ((++_sp & 255u) == 0u) { if (xb_ld(&(bar)[XB_TMO])) break; if (_sp > XB_SPIN_CAP) { atomicAdd(&(bar)[XB_TMO], 1u); break; } } } } while (0)

struct XcdBarrier {
    unsigned* bar; unsigned x;
    volatile LAS unsigned* st;
};

__device__ __forceinline__ XcdBarrier xcd_barrier_post(unsigned* bar, volatile LAS unsigned* st) {
    XcdBarrier b; b.bar = bar; b.x = xb_xcc_id(); b.st = st;
    if (threadIdx.x == 0) (void)xb_add(&bar[XB_XCNT(b.x)], 1u);
    return b;
}
__device__ __forceinline__ void xcd_barrier_complete(unsigned* bar, unsigned x, unsigned& nloc, unsigned& nx) {
    const unsigned G = gridDim.x * gridDim.y * gridDim.z;
    unsigned sum, cnt, mine, sp = 0u;
    for (;;) {
        sum = 0u; cnt = 0u; mine = 0u;
#pragma unroll
        for (unsigned j = 0; j < 16; ++j) { const unsigned c = xb_ld(&bar[XB_XCNT(j)]); sum += c; cnt += (c > 0u) ? 1u : 0u; mine = (j == x) ? c : mine; }
        if (sum == G) break;
        __builtin_amdgcn_s_sleep(1);
        if ((++sp & 255u) == 0u) { if (xb_ld(&bar[XB_TMO])) break; if (sp > XB_SPIN_CAP) { atomicAdd(&bar[XB_TMO], 1u); break; } }
    }
    nloc = mine > 0u ? mine : 1u; nx = cnt > 0u ? cnt : 1u;
}

__device__ __forceinline__ void xcd_barrier(const XcdBarrier& b) {
    asm volatile("s_waitcnt vmcnt(0)" ::: "memory");
    __syncthreads();
    if (threadIdx.x == 0) {
        unsigned* bar = b.bar;
        __builtin_amdgcn_s_waitcnt(0);
        unsigned nloc = b.st[0], nx = b.st[1];
        if (nloc == 0u) { xcd_barrier_complete(bar, b.x, nloc, nx); b.st[0] = nloc; b.st[1] = nx; }
        const unsigned old = xb_add(&bar[XB_XSUB(b.x)], 1u);
        const unsigned gen = old / nloc;
        if (old + 1u == (gen + 1u) * nloc) {
            __builtin_amdgcn_fence(__ATOMIC_RELEASE, "agent");
            asm volatile("s_waitcnt vmcnt(0)" ::: "memory");
            const unsigned og = xb_add(&bar[XB_TOP], 1u);
            const unsigned tg = og / nx;
            if (og + 1u == (tg + 1u) * nx) xb_add(&bar[XB_TOPGEN], 1u);
            else XB_SPIN(xb_ld(&bar[XB_TOPGEN]) == tg, bar);
            __builtin_amdgcn_fence(__ATOMIC_ACQUIRE, "agent");
            xb_add(&bar[XB_XGEN(b.x)], 1u);
            asm volatile("s_waitcnt vmcnt(0)" ::: "memory");
        } else {
            XB_SPIN(xb_ld(&bar[XB_TOPGEN]) == gen, bar);
            __builtin_amdgcn_fence(__ATOMIC_ACQUIRE, "agent");
            asm volatile("s_waitcnt vmcnt(0)" ::: "memory");
        }
    }
    __syncthreads();
}
typedef unsigned u32x4 __attribute__((ext_vector_type(4)));

constexpr int NWAVES = 8;
constexpr int BATCH = 8, SEQ = 2048, DM = 1024, M = BATCH * SEQ, DEPTH = 2;
constexpr int DIN = 2564, PP = 2304, NPROJ = 2560, DFF = 2816, NGU = 2 * DFF;
constexpr float EPS = 1e-6f;
constexpr float LOG2E = 1.4426950408889634f;
constexpr int C_U = 0, C_V = 256, C_Z = 512, C_XS = 768, C_B = 1024, C_C = 1280, C_POOL = 1536, C_Q = 1792, C_K = 2048;
enum { I_X = 0, I_N1W, I_WIN, I_GMNW, I_GMWS, I_GMBS, I_CONVW, I_CONVB, I_DTB, I_ALOG, I_SSMD, I_SSMNW, I_POOLW, I_POOLS,
       I_QNW, I_KNW, I_LQ1, I_LK1, I_LQ2, I_LK2, I_SUBLN, I_WOUT, I_N2W, I_WG, I_WU, I_WD, N_IN };

constexpr size_t MiB = 1u << 20;
constexpr size_t WS_CTL = 0, WS_RS = 64 * 1024, RS_STRIDE = (size_t)16384 * 4, CTL_ZERO_BYTES = 64 * 1024 + 4 * 262144;
constexpr size_t WS_W = 2 * MiB, W_LAYER = 24 * MiB, W_IN = 0, W_OUT = 5 * MiB, W_GU = 7 * MiB, W_DN = 18 * MiB;
constexpr size_t WS_XN = 50 * MiB, WS_DT = 82 * MiB, WS_CD = 82 * MiB + 512 * 1024, WS_ST = 83 * MiB, WS_VT = 99 * MiB;
constexpr size_t WS_PROJ = 107 * MiB, WS_MIX = 179 * MiB, WS_H = 107 * MiB, WS_END = 211 * MiB;
constexpr int CW_BAR = 4096;

constexpr int SCR_BYTES = 147456;
constexpr int LDSCTL_OFF = SCR_BYTES, MISC_OFF = LDSCTL_OFF + 320;
constexpr int LDS_BYTES = SCR_BYTES + 1024;

typedef float f32x16 __attribute__((ext_vector_type(16)));
typedef unsigned u32x2 __attribute__((ext_vector_type(2)));
#define DI __device__ __forceinline__
#define OPQ(x) asm volatile("" : "+v"(x))
#define MFMA32(a, b, c) __builtin_amdgcn_mfma_f32_32x32x16_bf16((a), (b), (c), 0, 0, 0)

DI float bf2f(bf16 u) { return __uint_as_float((unsigned)u << 16); }
DI float bflo(unsigned w) { return __uint_as_float(w << 16); }
DI float bfhi(unsigned w) { return __uint_as_float(w & 0xffff0000u); }
DI bf16 f2b(float f) { return (bf16)f2bf(f); }
DI int crow(int reg, int h) { return (reg & 3) + 8 * (reg >> 2) + 4 * h; }
DI float wave_sum(float v) {
#pragma unroll
    for (int o = 1; o < 64; o <<= 1) v += __shfl_xor(v, o);
    return v;
}
DI void unpack8(v4u w, float* f) { f[0] = bflo(w.x); f[1] = bfhi(w.x); f[2] = bflo(w.y); f[3] = bfhi(w.y); f[4] = bflo(w.z); f[5] = bfhi(w.z); f[6] = bflo(w.w); f[7] = bfhi(w.w); }
DI v4u pack8(const float* f) { v4u o; o.x = pk2(f[0], f[1]); o.y = pk2(f[2], f[3]); o.z = pk2(f[4], f[5]); o.w = pk2(f[6], f[7]); return o; }
DI float silu_f(float x) { return x * __builtin_amdgcn_rcpf(1.f + __builtin_amdgcn_exp2f(-x * LOG2E)); }
DI float gelu_tanh_f(float x) { const float y = 0.7978845608f * (x + 0.044715f * x * x * x); return x * __builtin_amdgcn_rcpf(1.f + __builtin_amdgcn_exp2f(-2.f * LOG2E * y)); }

DI f32x16 mma_tile(const LAS bf16* A, int pa, const LAS bf16* Bt, int pb, int K, f32x16 acc, int r, int lh) {
    const LAS bf16* ap = A + r * pa + 8 * lh; const LAS bf16* bp = Bt + r * pb + 8 * lh;
    for (int k = 0; k < K; k += 16) { const bf16x8 a = *(const LAS bf16x8*)(ap + k); const bf16x8 b = *(const LAS bf16x8*)(bp + k); acc = MFMA32(a, b, acc); }
    return acc;
}

DI int swz136(int row, int t) { return row * 136 + ((((t >> 3) ^ (row >> 3)) & 15) << 3) + (t & 7); }
template <bool SWA, bool SWB>
DI f32x16 mma_tile_sw(const LAS bf16* Abuf, int rowA0, const LAS bf16* Bbuf, int rowB0, int K, f32x16 acc, int r, int lh) {
    const int ra = rowA0 + r, rb = rowB0 + r; const int xa = SWA ? ((ra >> 3) & 15) : 0, xb = SWB ? ((rb >> 3) & 15) : 0;
    const LAS bf16* ap = Abuf + ra * 136; const LAS bf16* bp = Bbuf + rb * 136;
    for (int k = 0; k < K; k += 16) { const int kb = (k >> 3) + lh; const bf16x8 a = *(const LAS bf16x8*)(ap + ((kb ^ xa) << 3)); const bf16x8 b = *(const LAS bf16x8*)(bp + ((kb ^ xb) << 3)); acc = MFMA32(a, b, acc); }
    return acc;
}

struct Args { const float* in[N_IN]; float* out; unsigned char* ws; int ph_lo, ph_hi; };
typedef const Args __attribute__((address_space(4)))* KA;
DI KA kargs() { KA p = (KA)__builtin_amdgcn_kernarg_segment_ptr(); asm volatile("" : "+s"(p)); return p; }

namespace pg8 {
struct EpiInProj {
    static constexpr bool PERM = true, AFTER_DRAIN = false;
    bf16_t* O; const float* qw; const float* kw; const float* rs;
    __device__ __forceinline__ void operator()(const f32x4 (&acc)[2][2][4][2], const Unit& u, int wr, int wc, int fr, int fq) const {
        const int row0 = u.pm * BM + wr * 64 + fr, col0 = u.pn * BM + wc * 32 + 8 * fq;
        const int mode = (u.pn < 2) ? 1 : (u.pn == 7 ? 2 : (u.pn == 8 ? 3 : 0));
        f32x4 w0 = (f32x4){1.f, 1.f, 1.f, 1.f}, w1 = w0;
        if (mode >= 2) { const float* wp = (mode == 2 ? qw : kw) + 8 * fq; w0 = *(const f32x4*)wp; w1 = *(const f32x4*)(wp + 4);
            if (mode == 2) { const float sc = 0.17677669529663687f * 1.4426950408889634f; w0 = w0 * sc; w1 = w1 * sc; } }
        float rstv[2][4];
#pragma unroll
        for (int ai = 0; ai < 2; ++ai)
#pragma unroll
            for (int m = 0; m < 4; ++m) { const f32x4 q4 = *(const f32x4*)(rs + (size_t)(row0 + ai * HALF + m * 16) * 4); rstv[ai][m] = 1.0f / sqrtf(((q4[0] + q4[1]) + (q4[2] + q4[3])) * (1.0f / DM) + EPS); }
#pragma unroll
        for (int ai = 0; ai < 2; ++ai)
#pragma unroll
            for (int m = 0; m < 4; ++m) { bf16_t* rowp = O + (size_t)(row0 + ai * HALF + m * 16) * PP + col0;
                const float rst = rstv[ai][m];
#pragma unroll
                for (int bj = 0; bj < 2; ++bj) { f32x4 v0 = acc[ai][bj][m][0] * rst, v1 = acc[ai][bj][m][1] * rst;
                    if (mode == 1) {
#pragma unroll
                        for (int j = 0; j < 4; ++j) { v0[j] = gelu_tanh_f(v0[j]); v1[j] = gelu_tanh_f(v1[j]); }
                    } else if (mode >= 2) {
                        float ss = (v0[0] * v0[0] + v0[1] * v0[1]) + (v0[2] * v0[2] + v0[3] * v0[3]) + (v1[0] * v1[0] + v1[1] * v1[1]) + (v1[2] * v1[2] + v1[3] * v1[3]);
                        ss += __shfl_xor(ss, 16); ss += __shfl_xor(ss, 32);
                        const float rstd = 1.0f / sqrtf(ss * (1.0f / 32.0f) + EPS);
                        v0 = v0 * rstd * w0; v1 = v1 * rstd * w1;
                    }
                    u32x4 w; w.x = cvt_pk_bf16(v0[0], v0[1]); w.y = cvt_pk_bf16(v0[2], v0[3]); w.z = cvt_pk_bf16(v1[0], v1[1]); w.w = cvt_pk_bf16(v1[2], v1[3]);
                    *(u32x4*)(rowp + bj * HALF) = w; } }
    }
};
struct EpiResid {
    static constexpr bool PERM = false, AFTER_DRAIN = false;
    const float* base32; const bf16_t* base16; float* out32; bf16_t* xb; float* rs;
    __device__ __forceinline__ void operator()(const f32x4 (&acc)[2][2][4][2], const Unit& u, int wr, int wc, int fr, int fq) const {
        typedef unsigned u32x2v __attribute__((ext_vector_type(2)));
        const int row0 = u.pm * BM + wr * 64 + fr, col0 = u.pn * BM + wc * 32 + 4 * fq;
#pragma unroll
        for (int ai = 0; ai < 2; ++ai) {
            f32x4 pre[4][2][2];
            if (base32) {
#pragma unroll
                for (int m = 0; m < 4; ++m) { const size_t off = (size_t)(row0 + ai * HALF + m * 16) * DM + col0;
#pragma unroll
                    for (int bj = 0; bj < 2; ++bj)
#pragma unroll
                        for (int n = 0; n < 2; ++n) pre[m][bj][n] = *(const f32x4*)(base32 + off + bj * HALF + n * 16); }
            } else {
                u32x2v raw[4][2][2];
#pragma unroll
                for (int m = 0; m < 4; ++m) { const size_t off = (size_t)(row0 + ai * HALF + m * 16) * DM + col0;
#pragma unroll
                    for (int bj = 0; bj < 2; ++bj)
#pragma unroll
                        for (int n = 0; n < 2; ++n) raw[m][bj][n] = *(const u32x2v*)(base16 + off + bj * HALF + n * 16); }
#pragma unroll
                for (int m = 0; m < 4; ++m)
#pragma unroll
                    for (int bj = 0; bj < 2; ++bj)
#pragma unroll
                        for (int n = 0; n < 2; ++n) { const u32x2v w = raw[m][bj][n]; pre[m][bj][n] = (f32x4){__uint_as_float(w.x << 16), __uint_as_float(w.x & 0xffff0000u), __uint_as_float(w.y << 16), __uint_as_float(w.y & 0xffff0000u)}; }
            }
            asm volatile("" ::: "memory");
#pragma unroll
            for (int m = 0; m < 4; ++m) { const int row = row0 + ai * HALF + m * 16; const size_t off = (size_t)row * DM + col0; float ss = 0.f;
#pragma unroll
                for (int bj = 0; bj < 2; ++bj)
#pragma unroll
                    for (int n = 0; n < 2; ++n) { const size_t o = off + bj * HALF + n * 16; const f32x4 v = pre[m][bj][n] + acc[ai][bj][m][n];
                        if (out32) *(f32x4*)(out32 + o) = v;
                        if (xb) { ss += (v[0] * v[0] + v[1] * v[1]) + (v[2] * v[2] + v[3] * v[3]); unsigned long long w = (unsigned long long)cvt_pk_bf16(v[0], v[1]) | ((unsigned long long)cvt_pk_bf16(v[2], v[3]) << 32); *(unsigned long long*)(xb + o) = w; } }
                if (xb) { ss += __shfl_xor(ss, 16); ss += __shfl_xor(ss, 32); if (fq == 0) __hip_atomic_fetch_add(rs + (size_t)row * 4 + u.pn, ss, __ATOMIC_RELAXED, __HIP_MEMORY_SCOPE_WORKGROUP); }     }
            asm volatile("" ::: "memory");
        }
    }
};
struct EpiSwiGLU {
    static constexpr bool PERM = true, AFTER_DRAIN = false;
    bf16_t* O; const float* rs;
    __device__ __forceinline__ void operator()(const f32x4 (&acc)[2][2][4][2], const Unit& u, int wr, int wc, int fr, int fq) const {
        const int row0 = u.pm * BM + wr * 64 + fr, col0 = u.pn * HALF + wc * 32 + 8 * fq;
        float rstv[2][4];
#pragma unroll
        for (int ai = 0; ai < 2; ++ai)
#pragma unroll
            for (int m = 0; m < 4; ++m) { const f32x4 q4 = *(const f32x4*)(rs + (size_t)(row0 + ai * HALF + m * 16) * 4); rstv[ai][m] = 1.0f / sqrtf(((q4[0] + q4[1]) + (q4[2] + q4[3])) * (1.0f / DM) + EPS); }
#pragma unroll
        for (int ai = 0; ai < 2; ++ai)
#pragma unroll
            for (int m = 0; m < 4; ++m) { bf16_t* rowp = O + (size_t)(row0 + ai * HALF + m * 16) * DFF + col0;
                f32x4 h0, h1; const float rst = rstv[ai][m];
#pragma unroll
                for (int j = 0; j < 4; ++j) { h0[j] = silu_f(acc[ai][0][m][0][j] * rst) * (acc[ai][1][m][0][j] * rst); h1[j] = silu_f(acc[ai][0][m][1][j] * rst) * (acc[ai][1][m][1][j] * rst); }
                u32x4 w; w.x = cvt_pk_bf16(h0[0], h0[1]); w.y = cvt_pk_bf16(h0[2], h0[3]); w.z = cvt_pk_bf16(h1[0], h1[1]); w.w = cvt_pk_bf16(h1[2], h1[3]);
                *(u32x4*)rowp = w; }
    }
};
struct EpiVT {
    static constexpr bool PERM = true, AFTER_DRAIN = false;
    bf16_t* O; const float* rs;
    __device__ __forceinline__ void operator()(const f32x4 (&acc)[2][2][4][2], const Unit& u, int wr, int wc, int fr, int fq) const {
        const int row0 = u.pm * BM + wr * 64 + fr, col0 = u.pn * BM + wc * 32 + 8 * fq;
        f32x4 sc[2][2];
#pragma unroll
        for (int bj = 0; bj < 2; ++bj)
#pragma unroll
            for (int n = 0; n < 2; ++n) {
#pragma unroll
                for (int j = 0; j < 4; ++j) { const f32x4 q4 = *(const f32x4*)(rs + (size_t)(col0 + bj * HALF + 4 * n + j) * 4); sc[bj][n][j] = 1.0f / sqrtf(((q4[0] + q4[1]) + (q4[2] + q4[3])) * (1.0f / DM) + EPS); } }
#pragma unroll
        for (int ai = 0; ai < 2; ++ai)
#pragma unroll
            for (int m = 0; m < 4; ++m) { bf16_t* rowp = O + (size_t)(row0 + ai * HALF + m * 16) * M + col0;
#pragma unroll
                for (int bj = 0; bj < 2; ++bj) { const f32x4 v0 = acc[ai][bj][m][0] * sc[bj][0], v1 = acc[ai][bj][m][1] * sc[bj][1];
                    u32x4 w; w.x = cvt_pk_bf16(v0[0], v0[1]); w.y = cvt_pk_bf16(v0[2], v0[3]); w.z = cvt_pk_bf16(v1[0], v1[1]); w.w = cvt_pk_bf16(v1[2], v1[3]);
                    *(u32x4*)(rowp + bj * HALF) = w; } }
    }
};
}

DI void tr_item(const float* src, int pitch, int k0, int c0, bf16* dst, int drow0, int Kd, LAS float* scr, int lane, const float* ksc) {
#pragma unroll 8
    for (int i = 0; i < 32; ++i) { const int kk = 2 * i + (lane >> 5); scr[kk * 33 + (lane & 31)] = src[(size_t)(k0 + kk) * pitch + c0 + (lane & 31)]; }
    LDS_WAIT(); asm volatile("" ::: "memory");
    const int c = lane & 7;
    f32x4 k0v = (f32x4){1.f, 1.f, 1.f, 1.f}, k1v = k0v; if (ksc) { k0v = *(const f32x4*)(ksc + k0 + 8 * c); k1v = *(const f32x4*)(ksc + k0 + 8 * c + 4); }
#pragma unroll
    for (int j = 0; j < 4; ++j) { const int n = (lane >> 3) + 8 * j; const LAS float* s = scr + (8 * c) * 33 + n;
        v4u o; o.x = pk2(s[0 * 33] * k0v[0], s[1 * 33] * k0v[1]); o.y = pk2(s[2 * 33] * k0v[2], s[3 * 33] * k0v[3]); o.z = pk2(s[4 * 33] * k1v[0], s[5 * 33] * k1v[1]); o.w = pk2(s[6 * 33] * k1v[2], s[7 * 33] * k1v[3]);
        *(v4u*)(dst + (size_t)(drow0 + n) * Kd + k0 + 8 * c) = o; }
    LDS_WAIT(); asm volatile("" ::: "memory");
}
constexpr int WI_INP = 16 * 80, WI_OUT = 16 * 32, WI_G = 16 * 88, WI_D = 44 * 32, WI_PER_L = WI_INP + WI_OUT + 2 * WI_G + WI_D;
DI void weights_phase(KA a, LAS unsigned char* lds, int L, int lo, int hi, int rank, int nranks, int wave, int lane) {
    OPQ(lane);
    LAS float* scr = (LAS float*)(lds + wave * 16384);
    unsigned char* wb = a->ws + WS_W + (size_t)L * W_LAYER;
    for (int it = lo + rank; it < hi; it += nranks) {
        int r = it;
        if (r < WI_INP) { const int kb = r / 80, nb = r % 80, d0 = nb * 32; tr_item(a->in[I_WIN] + (size_t)L * DM * DIN, DIN, kb * 64, d0 < 1536 ? d0 : d0 + 4, (bf16*)(wb + W_IN), d0, DM, scr, lane, a->in[I_N1W] + L * DM); continue; } r -= WI_INP;
        if (r < WI_OUT) { const int kb = r / 32, nb = r % 32; tr_item(a->in[I_WOUT] + (size_t)L * DM * DM, DM, kb * 64, nb * 32, (bf16*)(wb + W_OUT), nb * 32, DM, scr, lane, nullptr); continue; } r -= WI_OUT;
        if (r < WI_G) { const int kb = r / 88, nb = r % 88, c0 = nb * 32; tr_item(a->in[I_WG] + (size_t)L * DM * DFF, DFF, kb * 64, c0, (bf16*)(wb + W_GU), (c0 >> 7) * 256 + (c0 & 127), DM, scr, lane, a->in[I_N2W] + L * DM); continue; } r -= WI_G;
        if (r < WI_G) { const int kb = r / 88, nb = r % 88, c0 = nb * 32; tr_item(a->in[I_WU] + (size_t)L * DM * DFF, DFF, kb * 64, c0, (bf16*)(wb + W_GU), (c0 >> 7) * 256 + 128 + (c0 & 127), DM, scr, lane, a->in[I_N2W] + L * DM); continue; } r -= WI_G;
        { const int kb = r / 32, nb = r % 32; tr_item(a->in[I_WD] + (size_t)L * DFF * DM, DM, kb * 64, nb * 32, (bf16*)(wb + W_DN), nb * 32, DFF, scr, lane, nullptr); }
    }
}
DI void prep_phase(const float* xsrc, bf16* XB, float* rs, int vcu, int G, int wave, int lane) {
    OPQ(lane);
    for (int m = vcu * NWAVES + wave; m < M; m += G * NWAVES) {
        const f32x4* xr = (const f32x4*)(xsrc + (size_t)m * DM) + lane;
        f32x4 v[4]; float s = 0.f;
#pragma unroll
        for (int j = 0; j < 4; ++j) { v[j] = xr[64 * j]; s += (v[j].x * v[j].x + v[j].y * v[j].y) + (v[j].z * v[j].z + v[j].w * v[j].w); }
        s = wave_sum(s);
        unsigned long long* o8 = (unsigned long long*)(XB + (size_t)m * DM) + lane;
#pragma unroll
        for (int j = 0; j < 4; ++j) o8[64 * j] = (unsigned long long)pk2(v[j].x, v[j].y) | ((unsigned long long)pk2(v[j].z, v[j].w) << 32);
        if (lane == 0) rs[(size_t)m * 4] = s;
    }
}

DI void gmlp_item(KA a, int L, int b, int c, int h, LAS unsigned char* lds, int tid, int wave, int lane) {
    OPQ(lane); OPQ(tid);
    LAS bf16* Wm = (LAS bf16*)lds; LAS bf16* vT = (LAS bf16*)(lds + 34816);
    const bf16* PROJ = (const bf16*)(a->ws + WS_PROJ); bf16* MIX = (bf16*)(a->ws + WS_MIX);
    const int tok0 = b * SEQ + c * 128;
    const float* ws = a->in[I_GMWS] + (size_t)(L * 4 + h) * 16384;
#pragma unroll
    for (int i = 0; i < 8; ++i) { const int idx = tid + 512 * i, t = idx >> 5, s4 = (idx & 31) * 4; const f32x4 w = *(const f32x4*)(ws + t * 128 + s4);
        u32x2 p; p.x = pk2(s4 <= t ? w.x : 0.f, s4 + 1 <= t ? w.y : 0.f); p.y = pk2(s4 + 2 <= t ? w.z : 0.f, s4 + 3 <= t ? w.w : 0.f);
        *(LAS u32x2*)(Wm + t * 136 + s4) = p; }
    { const int t = tid >> 2, qd = tid & 3; const bf16* vp = PROJ + (size_t)(tok0 + t) * PP + C_V + h * 64 + qd * 16;
      float f[16]; unpack8(*(const v4u*)vp, f); unpack8(*(const v4u*)(vp + 8), f + 8);
      float ss = 0.f;
#pragma unroll
      for (int i = 0; i < 16; ++i) ss += f[i] * f[i];
      ss += __shfl_xor(ss, 1); ss += __shfl_xor(ss, 2);
      const float rstd = 1.0f / sqrtf(ss * (1.0f / 64.0f) + EPS); const float* gw = a->in[I_GMNW] + L * 256 + h * 64 + qd * 16;
#pragma unroll
      for (int i = 0; i < 16; ++i) vT[(qd * 16 + i) * 136 + t] = f2b(f[i] * rstd * gw[i]); }
    __syncthreads();
    { const int tt = wave >> 1, dtl = wave & 1, r = lane & 31, lh = lane >> 5;
      f32x16 acc = {}; acc = mma_tile(Wm + tt * 32 * 136, 136, vT + dtl * 32 * 136, 136, 32 * (tt + 1), acc, r, lh);
      const float* bs = a->in[I_GMBS] + (L * 4 + h) * 128; const int d = dtl * 32 + r;
#pragma unroll
      for (int reg = 0; reg < 16; ++reg) { const int t = tt * 32 + crow(reg, lh); const float u = bf2f(PROJ[(size_t)(tok0 + t) * PP + C_U + h * 64 + d]);
          MIX[(size_t)(tok0 + t) * DM + h * 64 + d] = f2b(u * (acc[reg] + bs[t])); } }
    __syncthreads();
}
template <int WIN> DI void pool_win(const bf16* hp, int tpos, float* s) {
    float cur[16];
#pragma unroll
    for (int i = 0; i < 16; ++i) s[i] = 0.f;
#pragma unroll
    for (int j = 0; j < WIN; ++j) { const bool ok = tpos - j >= 0; const bf16* pp = ok ? hp - (size_t)j * PP : hp; float f[16]; unpack8(*(const v4u*)pp, f); unpack8(*(const v4u*)(pp + 8), f + 8);
#pragma unroll
        for (int i = 0; i < 16; ++i) { if (j == 0) cur[i] = f[i]; s[i] += ok ? f[i] : 0.f; } }
    const int cnt = (tpos + 1 < WIN) ? tpos + 1 : WIN; const float inv = 1.0f / (float)cnt;
#pragma unroll
    for (int i = 0; i < 16; ++i) s[i] = s[i] * inv - cur[i];
}
DI void pool_item(KA a, int L, int b, int c, int g, LAS unsigned char* lds, int tid, int wave, int lane) {
    OPQ(lane); OPQ(tid);
    LAS bf16* P = (LAS bf16*)lds; LAS bf16* WT = (LAS bf16*)(lds + 18432);
    const bf16* PROJ = (const bf16*)(a->ws + WS_PROJ); bf16* MIX = (bf16*)(a->ws + WS_MIX);
    const int tok0 = b * SEQ + c * 128;
    { const int t = tid >> 2, qd = tid & 3, tpos = c * 128 + t;
      const bf16* hp = PROJ + (size_t)(b * SEQ + tpos) * PP + C_POOL + g * 64 + qd * 16;
      float s[16];
      switch (g) { case 0: pool_win<2>(hp, tpos, s); break; case 1: pool_win<4>(hp, tpos, s); break; case 2: pool_win<8>(hp, tpos, s); break; default: pool_win<16>(hp, tpos, s); break; }
      *(LAS v4u*)(P + t * 72 + qd * 16) = pack8(s); *(LAS v4u*)(P + t * 72 + qd * 16 + 8) = pack8(s + 8); }
    { const float* pw = a->in[I_POOLW] + (size_t)(L * 4 + g) * 4096;
#pragma unroll
      for (int i = 0; i < 8; ++i) { const int idx = tid + 512 * i, d = idx >> 6, e = idx & 63; WT[e * 72 + d] = f2b(pw[d * 64 + e]); } }
    __syncthreads();
    { const int tt = wave >> 1, et = wave & 1, r = lane & 31, lh = lane >> 5;
      f32x16 acc = {}; acc = mma_tile(P + tt * 32 * 72, 72, WT + et * 32 * 72, 72, 64, acc, r, lh);
      const int e = et * 32 + r; const float sc = a->in[I_POOLS][L * 256 + g * 64 + e];
#pragma unroll
      for (int reg = 0; reg < 16; ++reg) { const int t = tt * 32 + crow(reg, lh); MIX[(size_t)(tok0 + t) * DM + 512 + g * 64 + e] = f2b(acc[reg] * sc); } }
    __syncthreads();
}
DI void gmlp_pair(KA a, int L, int itA, int itB, LAS unsigned char* lds, int tid, int wave, int lane) {
    OPQ(lane); OPQ(tid);
    const bf16* PROJ = (const bf16*)(a->ws + WS_PROJ); bf16* MIX = (bf16*)(a->ws + WS_MIX);
    constexpr int REG = 52224;
    int tok0[2], hq[2]; const int its[2] = {itA, itB};
#pragma unroll
    for (int q = 0; q < 2; ++q) { tok0[q] = (its[q] >> 6) * SEQ + ((its[q] >> 2) & 15) * 128; hq[q] = its[q] & 3; }
    f32x4 wv[2][8]; v4u vv[2][2];
    const int vt = tid >> 2, vqd = tid & 3;
#pragma unroll
    for (int q = 0; q < 2; ++q) { const float* ws = a->in[I_GMWS] + (size_t)(L * 4 + hq[q]) * 16384;
#pragma unroll
        for (int i = 0; i < 8; ++i) { const int idx = tid + 512 * i; wv[q][i] = *(const f32x4*)(ws + (idx >> 5) * 128 + (idx & 31) * 4); }
        const bf16* vp = PROJ + (size_t)(tok0[q] + vt) * PP + C_V + hq[q] * 64 + vqd * 16; vv[q][0] = *(const v4u*)vp; vv[q][1] = *(const v4u*)(vp + 8); }
#pragma unroll
    for (int q = 0; q < 2; ++q) { LAS bf16* Wm = (LAS bf16*)(lds + q * REG); LAS bf16* vT = (LAS bf16*)(lds + q * REG + 34816);
#pragma unroll
        for (int i = 0; i < 8; ++i) { const int idx = tid + 512 * i, t = idx >> 5, s4 = (idx & 31) * 4; const f32x4 w = wv[q][i];
            u32x2 p; p.x = pk2(s4 <= t ? w.x : 0.f, s4 + 1 <= t ? w.y : 0.f); p.y = pk2(s4 + 2 <= t ? w.z : 0.f, s4 + 3 <= t ? w.w : 0.f);
            *(LAS u32x2*)(Wm + t * 136 + s4) = p; }
        float f[16]; unpack8(vv[q][0], f); unpack8(vv[q][1], f + 8);
        float ss = 0.f;
#pragma unroll
        for (int i = 0; i < 16; ++i) ss += f[i] * f[i];
        ss += __shfl_xor(ss, 1); ss += __shfl_xor(ss, 2);
        const float rstd = 1.0f / sqrtf(ss * (1.0f / 64.0f) + EPS); const float* gw = a->in[I_GMNW] + L * 256 + hq[q] * 64 + vqd * 16;
#pragma unroll
        for (int i = 0; i < 16; ++i) vT[(vqd * 16 + i) * 136 + vt] = f2b(f[i] * rstd * gw[i]); }
    __syncthreads();
    { const int tt = wave >> 1, dtl = wave & 1, r = lane & 31, lh = lane >> 5, d = dtl * 32 + r;
      float uu[2][16];
#pragma unroll
      for (int q = 0; q < 2; ++q)
#pragma unroll
          for (int reg = 0; reg < 16; ++reg) uu[q][reg] = bf2f(PROJ[(size_t)(tok0[q] + tt * 32 + crow(reg, lh)) * PP + C_U + hq[q] * 64 + d]);
      f32x16 acc[2];
#pragma unroll
      for (int q = 0; q < 2; ++q) { acc[q] = (f32x16){}; acc[q] = mma_tile((LAS bf16*)(lds + q * REG) + tt * 32 * 136, 136, (LAS bf16*)(lds + q * REG + 34816) + dtl * 32 * 136, 136, 32 * (tt + 1), acc[q], r, lh); }
#pragma unroll
      for (int q = 0; q < 2; ++q) { const float* bs = a->in[I_GMBS] + (L * 4 + hq[q]) * 128;
#pragma unroll
          for (int reg = 0; reg < 16; ++reg) { const int t = tt * 32 + crow(reg, lh); MIX[(size_t)(tok0[q] + t) * DM + hq[q] * 64 + d] = f2b(uu[q][reg] * (acc[q][reg] + bs[t])); } } }
    __syncthreads();
}
DI void pool_pair(KA a, int L, int itA, int itB, LAS unsigned char* lds, int tid, int wave, int lane) {
    OPQ(lane); OPQ(tid);
    const bf16* PROJ = (const bf16*)(a->ws + WS_PROJ); bf16* MIX = (bf16*)(a->ws + WS_MIX);
    constexpr int R_OFF = 0, P_OFF = 144 * 72 * 2, W_OFF = P_OFF + 128 * 72 * 2, REG = W_OFF + 64 * 72 * 2;
    const int its[2] = {itA, itB};
    v4u rv[2][3]; float wq[2][8];
#pragma unroll
    for (int q = 0; q < 2; ++q) { const int b = its[q] >> 6, c = (its[q] >> 2) & 15, g = its[q] & 3;
#pragma unroll
        for (int i = 0; i < 3; ++i) { const int idx = tid + 512 * i, row = idx >> 3, ch = idx & 7, tp = c * 128 - 16 + row; const bool ok = (idx < 144 * 8) && tp >= 0;
            rv[q][i] = *(const v4u*)(PROJ + (size_t)(b * SEQ + (ok ? tp : c * 128)) * PP + C_POOL + g * 64 + ch * 8); if (!ok) rv[q][i] = (v4u){0u, 0u, 0u, 0u}; }
        const float* pw = a->in[I_POOLW] + (size_t)(L * 4 + g) * 4096;
#pragma unroll
        for (int i = 0; i < 8; ++i) wq[q][i] = pw[tid + 512 * i]; }
#pragma unroll
    for (int q = 0; q < 2; ++q) { LAS bf16* R = (LAS bf16*)(lds + q * REG + R_OFF); LAS bf16* WT = (LAS bf16*)(lds + q * REG + W_OFF);
#pragma unroll
        for (int i = 0; i < 3; ++i) { const int idx = tid + 512 * i; if (idx < 144 * 8) *(LAS v4u*)(R + (idx >> 3) * 72 + (idx & 7) * 8) = rv[q][i]; }
#pragma unroll
        for (int i = 0; i < 8; ++i) { const int idx = tid + 512 * i, d = idx >> 6, e = idx & 63; WT[e * 72 + d] = f2b(wq[q][i]); } }
    __syncthreads();
    { const int t = tid >> 2, qd = tid & 3;
#pragma unroll
      for (int q = 0; q < 2; ++q) { const int c = (its[q] >> 2) & 15, g = its[q] & 3, win = 2 << g, tpos = c * 128 + t, cnt = (tpos + 1 < win) ? tpos + 1 : win;
          const LAS bf16* R = (const LAS bf16*)(lds + q * REG + R_OFF) + (t + 16) * 72 + qd * 16; LAS bf16* P = (LAS bf16*)(lds + q * REG + P_OFF);
          float sacc[16], cur[16];
          unpack8(*(const LAS v4u*)R, cur); unpack8(*(const LAS v4u*)(R + 8), cur + 8);
#pragma unroll
          for (int i = 0; i < 16; ++i) sacc[i] = cur[i];
          for (int jw = 1; jw < win; ++jw) { float f[16]; unpack8(*(const LAS v4u*)(R - jw * 72), f); unpack8(*(const LAS v4u*)(R - jw * 72 + 8), f + 8);
#pragma unroll
              for (int i = 0; i < 16; ++i) sacc[i] += f[i]; }
          const float inv = 1.0f / (float)cnt;
#pragma unroll
          for (int i = 0; i < 16; ++i) sacc[i] = sacc[i] * inv - cur[i];
          *(LAS v4u*)(P + t * 72 + qd * 16) = pack8(sacc); *(LAS v4u*)(P + t * 72 + qd * 16 + 8) = pack8(sacc + 8); } }
    __syncthreads();
    { const int tt = wave >> 1, et = wave & 1, r = lane & 31, lh = lane >> 5, e = et * 32 + r;
#pragma unroll
      for (int q = 0; q < 2; ++q) { const int b = its[q] >> 6, c = (its[q] >> 2) & 15, g = its[q] & 3, tok0 = b * SEQ + c * 128;
          f32x16 acc = {}; acc = mma_tile((LAS bf16*)(lds + q * REG + P_OFF) + tt * 32 * 72, 72, (LAS bf16*)(lds + q * REG + W_OFF) + et * 32 * 72, 72, 64, acc, r, lh);
          const float sc = a->in[I_POOLS][L * 256 + g * 64 + e];
#pragma unroll
          for (int reg = 0; reg < 16; ++reg) { const int tr = tt * 32 + crow(reg, lh); MIX[(size_t)(tok0 + tr) * DM + 512 + g * 64 + e] = f2b(acc[reg] * sc); } } }
    __syncthreads();
}
constexpr int SSD_DT = 139264, SSD_AR = SSD_DT + 1024, SSD_ACS = SSD_AR + 1024;
DI void ssd_dt(KA a, int L, int g, int tok0, LAS unsigned char* lds, int tid, const LAS float* dtraw) {
    LAS float* dtv = (LAS float*)(lds + SSD_DT); LAS float* wtot = (LAS float*)(lds + SSD_AR); LAS float* acs = (LAS float*)(lds + SSD_ACS);
    const float* DT = (const float*)(a->ws + WS_DT);
    const int hh = (tid >> 7) & 1, t = tid & 127, h = 2 * g + hh, ln = tid & 63, wv = tid >> 6;
    if (tid < 256) { const float x = (dtraw ? dtraw[t * 2 + hh] : DT[(size_t)(tok0 + t) * 4 + h]) + a->in[I_DTB][L * 4 + h]; const float ey = __expf(x); const float sp = x > 20.f ? x : (ey < 0.01f ? ey * (1.f - ey * (0.5f - ey * (1.f / 3.f))) : __logf(1.f + ey));
        float s = -sp * __expf(a->in[I_ALOG][L * 4 + h]);
#pragma unroll
        for (int o = 1; o < 64; o <<= 1) { const float n = __shfl_up(s, o); if (ln >= o) s += n; }
        dtv[t * 2 + hh] = sp; acs[t * 2 + hh] = s; if (ln == 63) wtot[wv] = s; }
    __syncthreads();
    if (tid < 256 && (wv & 1)) acs[t * 2 + hh] += wtot[wv - 1];
    __syncthreads();
}
DI void conv_load(const bf16* p, int tpos0, v4u (&raw)[7]) {
#pragma unroll
    for (int rr = 0; rr < 7; ++rr) { const bool ok = tpos0 - 3 + rr >= 0; raw[rr] = *(const v4u*)(ok ? p + (ptrdiff_t)(rr - 3) * PP : p); if (!ok) raw[rr] = (v4u){0u, 0u, 0u, 0u}; }
}
DI void conv_apply(const v4u (&raw)[7], const float* cw, const float* cb, float (&out)[4][8]) {
    f32x4 w[8];
#pragma unroll
    for (int i = 0; i < 8; ++i) w[i] = *(const f32x4*)(cw + 4 * i);
    const f32x4 b0 = *(const f32x4*)cb, b1 = *(const f32x4*)(cb + 4);
    const float bias[8] = {b0.x, b0.y, b0.z, b0.w, b1.x, b1.y, b1.z, b1.w};
    float x[7][8];
#pragma unroll
    for (int rr = 0; rr < 7; ++rr) unpack8(raw[rr], x[rr]);
#pragma unroll
    for (int k = 0; k < 4; ++k)
#pragma unroll
        for (int i = 0; i < 8; ++i) { float acc = bias[i];
#pragma unroll
            for (int jj = 0; jj < 4; ++jj) acc += x[k + jj][i] * w[i][jj];
            out[k][i] = silu_f(acc); }
}
DI void ssd_pass1(KA a, int L, int b, int c, int g, LAS unsigned char* lds, int tid, int wave, int lane) {
    OPQ(lane); OPQ(tid);
    LAS bf16* XwT = (LAS bf16*)lds; LAS bf16* BT = (LAS bf16*)(lds + 34816);
    LAS float* dtv = (LAS float*)(lds + SSD_DT); LAS float* acs = (LAS float*)(lds + SSD_ACS);
    const bf16* PROJ = (const bf16*)(a->ws + WS_PROJ); bf16* ST = (bf16*)(a->ws + WS_ST); float* CD = (float*)(a->ws + WS_CD);
    const int tok0 = b * SEQ + c * 128;
    v4u rawx[7], rawb[7];
    { const int cg = tid & 15, t0 = (tid >> 4) * 4; const bf16* rowp = PROJ + (size_t)(tok0 + t0) * PP + g * 128 + cg * 8; conv_load(rowp + C_XS, c * 128 + t0, rawx); conv_load(rowp + C_B, c * 128 + t0, rawb); }
    {
      LAS float* Wd = (LAS float*)(lds + 69632); LAS float* dtraw = (LAS float*)(lds + SSD_DT + 3072);
      const float* win = a->in[I_WIN] + (size_t)L * DM * DIN + 1536 + 2 * g; const float* nw = a->in[I_N1W] + L * DM;
      for (int k = tid; k < DM; k += NWAVES * 64) { const float w = nw[k]; Wd[2 * k] = w * win[(size_t)k * DIN]; Wd[2 * k + 1] = w * win[(size_t)k * DIN + 1]; }
      __syncthreads();
      const bf16* XB = (const bf16*)(a->ws + WS_XN); const float* rs = (const float*)(a->ws + WS_RS) + (size_t)(2 * L) * RS_STRIDE; float* DTg = (float*)(a->ws + WS_DT);
      const int t4 = tid >> 4, l16 = tid & 15; const bf16* xr = XB + (size_t)(tok0 + t4) * DM + l16 * 8;
      float a0[4] = {0.f, 0.f, 0.f, 0.f}, a1[4] = {0.f, 0.f, 0.f, 0.f};
#pragma unroll 4
      for (int mm = 0; mm < 8; ++mm) { const int k = mm * 128 + l16 * 8; f32x4 w[4];
#pragma unroll
          for (int e = 0; e < 4; ++e) w[e] = *(const LAS f32x4*)(Wd + 2 * k + 4 * e);
#pragma unroll
          for (int i = 0; i < 4; ++i) { float f[8]; unpack8(*(const v4u*)(xr + (size_t)i * 32 * DM + mm * 128), f);
#pragma unroll
              for (int e = 0; e < 4; ++e) { a0[i] += f[2 * e] * w[e][0] + f[2 * e + 1] * w[e][2]; a1[i] += f[2 * e] * w[e][1] + f[2 * e + 1] * w[e][3]; } } }
#pragma unroll
      for (int i = 0; i < 4; ++i) {
#pragma unroll
          for (int o = 1; o < 16; o <<= 1) { a0[i] += __shfl_xor(a0[i], o); a1[i] += __shfl_xor(a1[i], o); }
          if (l16 == 0) { const int t = t4 + 32 * i; const f32x4 q4 = *(const f32x4*)(rs + (size_t)(tok0 + t) * 4); const float rst = 1.0f / sqrtf(((q4[0] + q4[1]) + (q4[2] + q4[3])) * (1.0f / DM) + EPS);
              const float d0 = a0[i] * rst, d1 = a1[i] * rst; dtraw[t * 2] = d0; dtraw[t * 2 + 1] = d1; DTg[(size_t)(tok0 + t) * 4 + 2 * g] = d0; DTg[(size_t)(tok0 + t) * 4 + 2 * g + 1] = d1; } }
      __syncthreads();
      ssd_dt(a, L, g, tok0, lds, tid, dtraw); }
    { const int cg = tid & 15, t0 = (tid >> 4) * 4, tpos0 = c * 128 + t0, ch = cg * 8, hh = cg >> 3; const bf16* rowp = PROJ + (size_t)(tok0 + t0) * PP;
      const float* cwb = a->in[I_CONVW] + (size_t)L * 768 * 4; const float* cbb = a->in[I_CONVB] + L * 768;
      float o[4][8];
      conv_apply(rawx, cwb + (g * 128 + ch) * 4, cbb + g * 128 + ch, o);
      float wg[4]; const float aend = acs[127 * 2 + hh];
#pragma unroll
      for (int k = 0; k < 4; ++k) wg[k] = dtv[(t0 + k) * 2 + hh] * __expf(aend - acs[(t0 + k) * 2 + hh]);
#pragma unroll
      for (int i = 0; i < 8; ++i) { u32x2 w; w.x = pk2(o[0][i] * wg[0], o[1][i] * wg[1]); w.y = pk2(o[2][i] * wg[2], o[3][i] * wg[3]); *(LAS u32x2*)(XwT + swz136(ch + i, t0)) = w; }
      conv_apply(rawb, cwb + (256 + g * 128 + ch) * 4, cbb + 256 + g * 128 + ch, o);
#pragma unroll
      for (int i = 0; i < 8; ++i) { u32x2 w; w.x = pk2(o[0][i], o[1][i]); w.y = pk2(o[2][i], o[3][i]); *(LAS u32x2*)(BT + swz136(ch + i, t0)) = w; } }
    __syncthreads();
    { const int rt = wave >> 1, r = lane & 31, lh = lane >> 5, hh = rt >> 1, h = 2 * g + hh;
#pragma unroll
      for (int q = 0; q < 2; ++q) { const int ct = (wave & 1) * 2 + q; f32x16 acc = {}; acc = mma_tile_sw<true, true>(XwT, rt * 32, BT, ct * 32, 128, acc, r, lh);
#pragma unroll
          for (int reg = 0; reg < 16; ++reg) { const int p = (rt & 1) * 32 + crow(reg, lh); ST[((size_t)((b * 16 + c) * 4 + h) * 64 + p) * 128 + ct * 32 + r] = f2b(acc[reg]); } } }
    if (tid < 2) CD[(b * 16 + c) * 4 + 2 * g + tid] = __expf(acs[127 * 2 + tid]);
    __syncthreads();
}
DI void ssd_pass2(KA a, int L, int b, int c, int g, LAS unsigned char* lds, int tid, int wave, int lane) {
    OPQ(lane); OPQ(tid);
    LAS bf16* Cm = (LAS bf16*)lds; LAS bf16* Bm = (LAS bf16*)(lds + 34816); LAS bf16* XT = (LAS bf16*)(lds + 69632); LAS bf16* PV = (LAS bf16*)(lds + 104448);
    LAS float* dtv = (LAS float*)(lds + SSD_DT); LAS float* acs = (LAS float*)(lds + SSD_ACS);
    const bf16* PROJ = (const bf16*)(a->ws + WS_PROJ); const bf16* ST = (const bf16*)(a->ws + WS_ST); const float* CD = (const float*)(a->ws + WS_CD); bf16* MIX = (bf16*)(a->ws + WS_MIX);
    const int tok0 = b * SEQ + c * 128, r = lane & 31, lh = lane >> 5;
    v4u rawx[7], rawb[7], rawc[7];
    { const int cg = tid & 15, t0 = (tid >> 4) * 4; const bf16* rowp = PROJ + (size_t)(tok0 + t0) * PP + g * 128 + cg * 8; conv_load(rowp + C_XS, c * 128 + t0, rawx); conv_load(rowp + C_B, c * 128 + t0, rawb); conv_load(rowp + C_C, c * 128 + t0, rawc); }
    ssd_dt(a, L, g, tok0, lds, tid, nullptr);
    { const int cg = tid & 15, t0 = (tid >> 4) * 4, tpos0 = c * 128 + t0, ch = cg * 8; const bf16* rowp = PROJ + (size_t)(tok0 + t0) * PP;
      const float* cwb = a->in[I_CONVW] + (size_t)L * 768 * 4; const float* cbb = a->in[I_CONVB] + L * 768;
      float o[4][8];
      conv_apply(rawx, cwb + (g * 128 + ch) * 4, cbb + g * 128 + ch, o);
#pragma unroll
      for (int i = 0; i < 8; ++i) { u32x2 w; w.x = pk2(o[0][i], o[1][i]); w.y = pk2(o[2][i], o[3][i]); *(LAS u32x2*)(XT + swz136(ch + i, t0)) = w; }
      conv_apply(rawb, cwb + (256 + g * 128 + ch) * 4, cbb + 256 + g * 128 + ch, o);
#pragma unroll
      for (int k = 0; k < 4; ++k) *(LAS v4u*)(Bm + (t0 + k) * 136 + ch) = pack8(o[k]);
      conv_apply(rawc, cwb + (512 + g * 128 + ch) * 4, cbb + 512 + g * 128 + ch, o);
#pragma unroll
      for (int k = 0; k < 4; ++k) *(LAS v4u*)(Cm + (t0 + k) * 136 + ch) = pack8(o[k]); }
    {
      float pv[4][8];
#pragma unroll
      for (int i = 0; i < 4; ++i)
#pragma unroll
          for (int e = 0; e < 8; ++e) pv[i][e] = 0.f;
      const v4u* sp = (const v4u*)(ST + (size_t)((b * 16) * 4 + 2 * g) * 64 * 128) + tid; constexpr size_t cstride = (size_t)4 * 64 * 128 / 8;
      float w0 = 1.f, w1 = 1.f;
      for (int jt = c - 1; jt >= 0; jt -= 8) {
          v4u ld[8][4];
#pragma unroll
          for (int u = 0; u < 8; ++u) { const int jc = (jt - u >= 0) ? jt - u : 0;
#pragma unroll
              for (int i = 0; i < 4; ++i) ld[u][i] = sp[(size_t)jc * cstride + i * 512]; }
#pragma unroll
          for (int u = 0; u < 8; ++u) { const int jj = jt - u; const bool ok = jj >= 0; const float ww0 = ok ? w0 : 0.f, ww1 = ok ? w1 : 0.f;
#pragma unroll
              for (int i = 0; i < 4; ++i) { float f[8]; unpack8(ld[u][i], f); const float ww = i < 2 ? ww0 : ww1;
#pragma unroll
                  for (int e = 0; e < 8; ++e) pv[i][e] += ww * f[e]; }
              if (ok) { w0 *= CD[(b * 16 + jj) * 4 + 2 * g]; w1 *= CD[(b * 16 + jj) * 4 + 2 * g + 1]; } } }
#pragma unroll
      for (int i = 0; i < 4; ++i) *(LAS v4u*)(PV + (i * 32 + (tid >> 4)) * 136 + (tid & 15) * 8) = pack8(pv[i]); }
    __syncthreads();
    const int lt = wave >> 1, pt = wave & 1;
    f32x16 cb[2];
#pragma unroll
    for (int q = 0; q < 2; ++q) { const int st = (wave & 1) * 2 + q; cb[q] = (f32x16){}; if (st <= lt) cb[q] = mma_tile(Cm + lt * 32 * 136, 136, Bm + st * 32 * 136, 136, 128, cb[q], r, lh); }
    f32x16 y[2];
#pragma unroll
    for (int hh = 0; hh < 2; ++hh) {
        __syncthreads();
#pragma unroll
        for (int q = 0; q < 2; ++q) { const int s = ((wave & 1) * 2 + q) * 32 + r; const float as = acs[s * 2 + hh], ds = dtv[s * 2 + hh];
#pragma unroll
            for (int reg = 0; reg < 16; ++reg) { const int l = lt * 32 + crow(reg, lh); const float val = (s <= l) ? cb[q][reg] * __expf(acs[l * 2 + hh] - as) * ds : 0.f; Bm[l * 136 + s] = f2b(val); } }
        __syncthreads();
        f32x16 a1 = {}, a2 = {};
        a1 = mma_tile_sw<false, true>(Bm, lt * 32, XT, hh * 64 + pt * 32, 32 * (lt + 1), a1, r, lh);
        a2 = mma_tile(Cm + lt * 32 * 136, 136, PV + (hh * 64 + pt * 32) * 136, 136, 128, a2, r, lh);
        const int ch = hh * 64 + pt * 32 + r; const float Dh = a->in[I_SSMD][L * 4 + 2 * g + hh];
#pragma unroll
        for (int reg = 0; reg < 16; ++reg) { const int l = lt * 32 + crow(reg, lh); const float xsv = bf2f(XT[swz136(ch, l)]); const float zz = bf2f(PROJ[(size_t)(tok0 + l) * PP + C_Z + g * 128 + ch]);
            const float yv = a1[reg] + __expf(acs[l * 2 + hh]) * a2[reg] + Dh * xsv; y[hh][reg] = yv * silu_f(zz); }
    }
    __syncthreads();
    LAS float* ybuf = (LAS float*)lds;
#pragma unroll
    for (int hh = 0; hh < 2; ++hh)
#pragma unroll
        for (int reg = 0; reg < 16; ++reg) { const int l = lt * 32 + crow(reg, lh); ybuf[l * 129 + hh * 64 + pt * 32 + r] = y[hh][reg]; }
    __syncthreads();
    { const int t = tid >> 2, ch0 = (tid & 3) * 32; float v[32]; float ss = 0.f;
#pragma unroll
      for (int i = 0; i < 32; ++i) { v[i] = ybuf[t * 129 + ch0 + i]; ss += v[i] * v[i]; }
      ss += __shfl_xor(ss, 1); ss += __shfl_xor(ss, 2);
      const float rstd = 1.0f / sqrtf(ss * (1.0f / 128.0f) + EPS); const float* nw = a->in[I_SSMNW] + L * 256 + g * 128 + ch0;
#pragma unroll
      for (int i = 0; i < 32; ++i) v[i] = v[i] * rstd * nw[i];
      bf16* op = MIX + (size_t)(tok0 + t) * DM + 256 + g * 128 + ch0;
#pragma unroll
      for (int i = 0; i < 4; ++i) *(v4u*)(op + 8 * i) = pack8(v + 8 * i); }
    __syncthreads();
}
typedef float f32x2_t __attribute__((ext_vector_type(2))); typedef __bf16 bf16x2_t __attribute__((ext_vector_type(2)));
DI unsigned cvtpk(float lo, float hi) { f32x2_t v = {lo, hi}; bf16x2_t b = __builtin_convertvector(v, bf16x2_t); return __builtin_bit_cast(unsigned, b); }
DI float xhalf_sum(float v) { auto rr = __builtin_amdgcn_permlane32_swap(__float_as_uint(v), __float_as_uint(v), false, false); return __uint_as_float(rr[0]) + __uint_as_float(rr[1]); }
DI float xhalf_max(float v) { auto rr = __builtin_amdgcn_permlane32_swap(__float_as_uint(v), __float_as_uint(v), false, false); return fmaxf(__uint_as_float(rr[0]), __uint_as_float(rr[1])); }
constexpr int ATT_TPS = 4;
constexpr int ATT_KP = 144, ATT_VP = 64 * ATT_TPS + 8, ATT_VOFF = 32 * ATT_TPS * ATT_KP, ATT_BUF = ATT_VOFF + 64 * ATT_VP;
DI void attn_block(KA a, int L, int b, int h, int s8, LAS unsigned char* lds, int tid, int wave, int lane) {
    OPQ(lane); OPQ(tid);
    const bf16* PROJ = (const bf16*)(a->ws + WS_PROJ); const bf16* VT = (const bf16*)(a->ws + WS_VT); bf16* MIX = (bf16*)(a->ws + WS_MIX);
    const int r = lane & 31, lh = lane >> 5; const size_t tokb = (size_t)b * SEQ;
    const int cw = wave >> 2, jS = s8 * 4 + (wave & 3), jL = 63 - jS, st0 = (63 - s8 * 4) / ATT_TPS;
    float p1 = 0.f, p2 = 0.f;
#pragma unroll 8
    for (int i = 0; i < 32; ++i) { p1 += a->in[I_LQ1][L * 32 + i] * a->in[I_LK1][L * 32 + i]; p2 += a->in[I_LQ2][L * 32 + i] * a->in[I_LK2][L * 32 + i]; }
    const float lam_init = (L == 0) ? 0.2f : 0.35550906f;
    const float lam = __expf(p1) - __expf(p2) + lam_init;
    const float slope2 = exp2f(-2.0f * (float)(h + 1)) * LOG2E, tstep = 32.f * slope2;
    const bf16* gk = PROJ + (tokb + (tid >> 3)) * PP + C_K + h * 64 + (tid & 7) * 8;
    const bf16* gv = VT + (size_t)(h * 64 + (tid >> 4)) * M + tokb + (tid & 15) * 8;
    const int lk = (tid >> 3) * ATT_KP + (tid & 7) * 16, lv = ATT_VOFF + (tid >> 4) * ATT_VP + (tid & 15) * 16;
    v4u sk[ATT_TPS / 2], sv[ATT_TPS / 2];
#define ATT_GLOAD(st_) do { _Pragma("unroll") for (int i_ = 0; i_ < ATT_TPS / 2; ++i_) { sk[i_] = *(const v4u*)(gk + ((size_t)(st_) * 32 * ATT_TPS + 64 * i_) * PP); sv[i_] = *(const v4u*)(gv + (size_t)32 * i_ * M + (st_) * 32 * ATT_TPS); } } while (0)
#define ATT_STORE(buf_) do { LAS unsigned char* d_ = lds + (buf_) * ATT_BUF; _Pragma("unroll") for (int i_ = 0; i_ < ATT_TPS / 2; ++i_) { *(LAS v4u*)(d_ + lk + 64 * i_ * ATT_KP) = sk[i_]; \
        *(LAS u32x2*)(d_ + lv + 32 * i_ * ATT_VP) = (u32x2){sv[i_].x, sv[i_].y}; *(LAS u32x2*)(d_ + lv + 32 * i_ * ATT_VP + 8) = (u32x2){sv[i_].z, sv[i_].w}; } } while (0)
    bf16x8 qf[2][2];
#pragma unroll
    for (int jb = 0; jb < 2; ++jb) { const bf16* qp = PROJ + (tokb + (jb == 0 ? jL : jS) * 32 + r) * PP + C_Q + h * 64 + cw * 32 + 8 * lh;
#pragma unroll
        for (int s = 0; s < 2; ++s) qf[jb][s] = *(const bf16x8*)(qp + s * 16); }
    f32x16 cinit;
#pragma unroll
    for (int reg = 0; reg < 16; ++reg) cinit[reg] = slope2 * (float)crow(reg, lh);
    f32x16 o[2][2];
#pragma unroll
    for (int jb = 0; jb < 2; ++jb)
#pragma unroll
        for (int d = 0; d < 2; ++d) o[jb][d] = (f32x16){};
    float kwmax = 0.f;
#pragma unroll 8
    for (int i = 0; i < 32; ++i) kwmax = fmaxf(kwmax, fabsf(a->in[I_KNW][L * 32 + i]));
    const float knorm = 5.65685425f * 1.01f * kwmax;
    float mref[2], lrun[2] = {0.f, 0.f};
#pragma unroll
    for (int jb = 0; jb < 2; ++jb) { float qs = 0.f;
#pragma unroll
        for (int s2 = 0; s2 < 2; ++s2)
#pragma unroll
            for (int e = 0; e < 8; ++e) { const float qv = bf2f((bf16)qf[jb][s2][e]); qs += qv * qv; }
        qs = xhalf_sum(qs); mref[jb] = sqrtf(qs) * knorm + 31.f * slope2; }
    ATT_GLOAD(st0);
    ATT_STORE(0);
    __syncthreads();
    int cur = 0;
    const int koff = r * ATT_KP + 16 * lh + cw * 64, voff = ATT_VOFF + r * ATT_VP + 8 * lh;
    for (int st = st0; st >= 0; --st) {
        if (st > 0) ATT_GLOAD(st - 1);
#pragma unroll 1
        for (int tl = ATT_TPS - 1; tl >= 0; --tl) {
            const int kt = st * ATT_TPS + tl;
            int act = (kt <= jL) ? 1 : 0; asm volatile("" : "+v"(act)); act = __builtin_amdgcn_readfirstlane(act);
            if (act) {
                const LAS unsigned char* kb = lds + cur * ATT_BUF + koff + tl * 32 * ATT_KP; const LAS unsigned char* vb = lds + cur * ATT_BUF + voff + tl * 64;
                const bf16x8 k0 = *(const LAS bf16x8*)kb, k1 = *(const LAS bf16x8*)(kb + 32);
                u32x2 vlo[2][2], vhi[2][2];
#pragma unroll
                for (int d = 0; d < 2; ++d)
#pragma unroll
                    for (int s = 0; s < 2; ++s) { vlo[d][s] = *(const LAS u32x2*)(vb + d * 32 * ATT_VP + 32 * s); vhi[d][s] = *(const LAS u32x2*)(vb + d * 32 * ATT_VP + 32 * s + 16); }
#pragma unroll
                for (int jb = 0; jb < 2; ++jb) {
                    const int jq = (jb == 0) ? jL : jS;
                    int on = (kt <= jq) ? 1 : 0; asm volatile("" : "+v"(on)); on = __builtin_amdgcn_readfirstlane(on);
                    if (on) {
                        int isdiag = (kt == jq) ? 1 : 0; asm volatile("" : "+v"(isdiag)); isdiag = __builtin_amdgcn_readfirstlane(isdiag);
                        f32x16 S = MFMA32(k0, qf[jb][0], cinit); S = MFMA32(k1, qf[jb][1], S);
                        if (isdiag) {
#pragma unroll
                            for (int reg = 0; reg < 16; ++reg) S[reg] = crow(reg, lh) > r ? -INFINITY : S[reg];
                        }
                        const float sh = tstep * (float)(kt - jq) - mref[jb];
                        float rs4[4] = {0.f, 0.f, 0.f, 0.f};
#pragma unroll
                        for (int reg = 0; reg < 16; ++reg) { S[reg] = __builtin_amdgcn_exp2f(S[reg] + sh); rs4[reg & 3] += S[reg]; }
                        lrun[jb] += (rs4[0] + rs4[1]) + (rs4[2] + rs4[3]);
                        u32x4 w0, w1;
                        w0.x = cvtpk(S[0], S[1]); w0.y = cvtpk(S[2], S[3]); w0.z = cvtpk(S[4], S[5]); w0.w = cvtpk(S[6], S[7]);
                        w1.x = cvtpk(S[8], S[9]); w1.y = cvtpk(S[10], S[11]); w1.z = cvtpk(S[12], S[13]); w1.w = cvtpk(S[14], S[15]);
                        const bf16x8 pb0 = __builtin_bit_cast(bf16x8, w0), pb1 = __builtin_bit_cast(bf16x8, w1);
#pragma unroll
                        for (int d = 0; d < 2; ++d) {
                            const u32x4 v0 = (u32x4){vlo[d][0].x, vlo[d][0].y, vhi[d][0].x, vhi[d][0].y}, v1 = (u32x4){vlo[d][1].x, vlo[d][1].y, vhi[d][1].x, vhi[d][1].y};
                            o[jb][d] = MFMA32(__builtin_bit_cast(bf16x8, v0), pb0, o[jb][d]);
                            o[jb][d] = MFMA32(__builtin_bit_cast(bf16x8, v1), pb1, o[jb][d]);
                        }
                    }
                }
            }
        }
        if (st > 0) ATT_STORE(cur ^ 1);
        __syncthreads();
        cur ^= 1;
    }
#undef ATT_GLOAD
#undef ATT_STORE
    lrun[0] = xhalf_sum(lrun[0]); lrun[1] = xhalf_sum(lrun[1]);
    const int give = (cw == 0) ? 1 : 0, keep = 1 - give;
    LAS float* xw = (LAS float*)lds + (size_t)wave * 2048;
    LAS const float* xr = (LAS const float*)lds + (size_t)(wave ^ 4) * 2048;
    { const float sc = (cw == 0 ? 1.0f : lam) / (give == 0 ? lrun[0] : lrun[1]);
#pragma unroll
      for (int d = 0; d < 2; ++d)
#pragma unroll
          for (int reg = 0; reg < 16; ++reg) xw[(d * 16 + reg) * 64 + lane] = (give == 0 ? o[0][d][reg] : o[1][d][reg]) * sc; }
    __syncthreads();
    { const float sck = (cw == 0 ? 1.0f : lam) / (keep == 0 ? lrun[0] : lrun[1]); const float sgn = (cw == 0) ? 1.0f : -1.0f;
      f32x16 v[2]; float ss = 0.f;
#pragma unroll
      for (int d = 0; d < 2; ++d)
#pragma unroll
          for (int reg = 0; reg < 16; ++reg) { const float mine = (keep == 0 ? o[0][d][reg] : o[1][d][reg]) * sck, other = xr[(d * 16 + reg) * 64 + lane]; const float val = sgn * (mine - other); v[d][reg] = val; ss += val * val; }
      ss = xhalf_sum(ss);
      const float rstd = (1.0f - lam_init) / sqrtf(ss * (1.0f / 64.0f) + EPS);
      const int jq = (keep == 0) ? jL : jS;
      bf16* op = MIX + (tokb + jq * 32 + r) * DM + 768 + h * 64;
#pragma unroll
      for (int d = 0; d < 2; ++d)
#pragma unroll
          for (int g4 = 0; g4 < 4; ++g4) { const int d0 = d * 32 + 8 * g4 + 4 * lh; const f32x4 w4 = *(const f32x4*)(a->in[I_SUBLN] + L * 64 + d0);
              u32x2 pk; pk.x = cvtpk(v[d][4 * g4] * rstd * w4.x, v[d][4 * g4 + 1] * rstd * w4.y); pk.y = cvtpk(v[d][4 * g4 + 2] * rstd * w4.z, v[d][4 * g4 + 3] * rstd * w4.w);
              *(u32x2*)(op + d0) = pk; } }
    __syncthreads();
}

#ifndef DIS_SSD1
#define DIS_SSD1 0
#endif
#ifndef DIS_SSD2
#define DIS_SSD2 0
#endif
#ifndef DIS_GMLP
#define DIS_GMLP 0
#endif
#ifndef DIS_POOL
#define DIS_POOL 0
#endif
#ifndef DIS_ATTN
#define DIS_ATTN 0
#endif
#ifndef DIS_GEMM
#define DIS_GEMM 0
#endif
#ifndef REP_P0
#define REP_P0 1
#endif
#ifndef REP_M1
#define REP_M1 1
#endif
#ifndef REP_SSD2
#define REP_SSD2 1
#endif
#ifndef REP_ATTN
#define REP_ATTN 1
#endif
#ifndef REP_N2
#define REP_N2 1
#endif
#ifndef REP_BAR
#define REP_BAR 1
#endif
#ifndef REP_G1
#define REP_G1 1
#endif
#ifndef REP_G3
#define REP_G3 1
#endif
#ifndef MK_SPLIT
#define MK_SPLIT 0
#endif
constexpr int N_PHASES = 13;
__global__ void __launch_bounds__(NWAVES * 64, 2) hybrid_fwd(Args args) {
    extern __shared__ __attribute__((aligned(16))) unsigned char lds_raw[];
    LAS unsigned char* lds = (LAS unsigned char*)lds_raw;
    const int tid = threadIdx.x, lane = tid & 63, wave = __builtin_amdgcn_readfirstlane(tid >> 6);
    const int G = gridDim.x; const int bx = blockIdx.x; const int vcu = (G % 8 == 0) ? (bx % 8) * (G / 8) + bx / 8 : bx;
    for (int u = tid; u < (LDS_BYTES - LDSCTL_OFF) / 4; u += NWAVES * 64) ((LAS unsigned*)(lds + LDSCTL_OFF))[u] = 0u;
    __syncthreads();
    int lo, hi;
    XcdBarrier bar;
    { KA ka = kargs(); lo = ka->ph_lo; hi = ka->ph_hi; gu32* ctl = (gu32*)(ka->ws + WS_CTL);
      bar.bar = (unsigned*)(ctl + CW_BAR); bar.x = 0; bar.st = nullptr;
      if (!MK_SPLIT) bar = xcd_barrier_post((unsigned*)(ctl + CW_BAR), (volatile LAS unsigned*)(lds + MISC_OFF) + 8); }
#define IN(k) (lo <= (k) && (k) < hi)
#define SEAM(k) do { if (IN(k) && IN((k) + 1)) for (int rb_ = 0; rb_ < REP_BAR; ++rb_) xcd_barrier(bar); } while (0)
    if (IN(0)) { KA ka = kargs(); for (int rep = 0; rep < REP_P0; ++rep) { weights_phase(ka, lds, 0, 0, WI_INP, vcu * NWAVES + wave, G * NWAVES, wave, lane); __syncthreads(); }
        prep_phase(ka->in[I_X], (bf16*)(ka->ws + WS_XN), (float*)(ka->ws + WS_RS), vcu, G, wave, lane); }
    SEAM(0);
#pragma unroll 1
    for (int L = 0; L < DEPTH; ++L) {
        const int pb = 1 + 6 * L;
        if (IN(pb)) { KA ka = kargs(); unsigned char* ws = ka->ws; const bf16* wb = (const bf16*)(ws + WS_W + (size_t)L * W_LAYER + W_IN); const bf16* XB = (const bf16*)(ws + WS_XN);
            const float* rs = (const float*)(ws + WS_RS) + (size_t)(2 * L) * RS_STRIDE;
            for (int rep = 0; rep < REP_G1; ++rep) {
            { pg8::Gemm g{XB, wb, M, PP, DM}; pg8::StaticOrder S; S.init(M, PP, G, bx);
              pg8::EpiInProj E{(bf16*)(ws + WS_PROJ), ka->in[I_QNW] + L * 32, ka->in[I_KNW] + L * 32, rs};
              pg8::gemm_phase<pg8::EpiInProj, pg8::StaticOrder, true, true>(lds, g, S, E); }
            { pg8::Gemm g{wb + (size_t)PP * DM, XB, 256, M, DM}; pg8::StaticOrder S; S.init(256, M, G, (bx + 192) % G);
              pg8::EpiVT E{(bf16*)(ws + WS_VT), rs};
              pg8::gemm_phase<pg8::EpiVT, pg8::StaticOrder, true, true>(lds, g, S, E); }
            }
            { const int nidle = G - G / 2; if (bx >= G / 2) weights_phase(ka, lds, L, WI_INP, WI_INP + WI_OUT + 2 * WI_G, (bx - G / 2) * NWAVES + wave, nidle * NWAVES, wave, lane); __syncthreads(); }
        }
        SEAM(pb);
        if (IN(pb + 1)) { KA ka = kargs();
            __syncthreads();
            for (int rep = 0; rep < REP_M1; ++rep) {
            if (!DIS_SSD1) for (int it = vcu; it < 256; it += G) ssd_pass1(ka, L, it >> 5, (it >> 1) & 15, it & 1, lds, tid, wave, lane);
            if (!DIS_GMLP) for (int it = vcu; it < 512; it += 2 * G) { if (it + G < 512) gmlp_pair(ka, L, it, it + G, lds, tid, wave, lane); else gmlp_item(ka, L, it >> 6, (it >> 2) & 15, it & 3, lds, tid, wave, lane); }
            if (!DIS_POOL) for (int it = vcu; it < 512; it += 2 * G) { if (it + G < 512) pool_pair(ka, L, it, it + G, lds, tid, wave, lane); else pool_item(ka, L, it >> 6, (it >> 2) & 15, it & 3, lds, tid, wave, lane); }
            }
        }
        SEAM(pb + 1);
        if (IN(pb + 2)) { KA ka = kargs();
            __syncthreads();
            for (int rep = 0; rep < REP_SSD2; ++rep)
            if (!DIS_SSD2) for (int it = vcu; it < 256; it += G) ssd_pass2(ka, L, it >> 5, (it >> 1) & 15, it & 1, lds, tid, wave, lane);
            for (int rep = 0; rep < REP_ATTN; ++rep)
            if (!DIS_ATTN) for (int it = vcu; it < 256; it += G) attn_block(ka, L, it >> 5, (it >> 3) & 3, it & 7, lds, tid, wave, lane);
        }
        SEAM(pb + 2);
        if (IN(pb + 3)) { KA ka = kargs(); unsigned char* ws = ka->ws;
            pg8::Gemm g{(const bf16*)(ws + WS_MIX), (const bf16*)(ws + WS_W + (size_t)L * W_LAYER + W_OUT), M, DM, DM}; pg8::StaticOrder S; S.init(M, DM, G, bx);
            pg8::EpiResid E{(const float*)nullptr, (const bf16*)(ws + WS_XN), (float*)nullptr, (bf16*)(ws + WS_XN), (float*)(ws + WS_RS) + (size_t)(2 * L + 1) * RS_STRIDE};
            pg8::gemm_phase<pg8::EpiResid, pg8::StaticOrder, true, true>(lds, g, S, E); }
        SEAM(pb + 3);
        if (IN(pb + 4)) for (int rep = 0; rep < REP_G3; ++rep) { KA ka = kargs(); unsigned char* ws = ka->ws;
            pg8::Gemm g{(const bf16*)(ws + WS_XN), (const bf16*)(ws + WS_W + (size_t)L * W_LAYER + W_GU), M, NGU, DM}; pg8::StaticOrder S; S.init(M, NGU, G, bx);
            pg8::EpiSwiGLU E{(bf16*)(ws + WS_H), (const float*)(ws + WS_RS) + (size_t)(2 * L + 1) * RS_STRIDE};
            pg8::gemm_phase<pg8::EpiSwiGLU, pg8::StaticOrder, true, true>(lds, g, S, E);
            { const int nidle = G - G / 2; if (bx >= G / 2) { weights_phase(ka, lds, L, WI_PER_L - WI_D, WI_PER_L, (bx - G / 2) * NWAVES + wave, nidle * NWAVES, wave, lane);
                if (L + 1 < DEPTH) weights_phase(ka, lds, L + 1, 0, WI_INP, (bx - G / 2) * NWAVES + wave, nidle * NWAVES, wave, lane); } __syncthreads(); } }
        SEAM(pb + 4);
        if (IN(pb + 5)) { KA ka = kargs(); unsigned char* ws = ka->ws; const bool more = (L + 1 < DEPTH);
            pg8::Gemm g{(const bf16*)(ws + WS_H), (const bf16*)(ws + WS_W + (size_t)L * W_LAYER + W_DN), M, DM, DFF}; pg8::StaticOrder S; S.init(M, DM, G, bx);
            pg8::EpiResid E{(const float*)nullptr, (const bf16*)(ws + WS_XN), more ? (float*)nullptr : ka->out, more ? (bf16*)(ws + WS_XN) : (bf16*)nullptr, more ? (float*)(ws + WS_RS) + (size_t)(2 * L + 2) * RS_STRIDE : (float*)nullptr};
            pg8::gemm_phase<pg8::EpiResid, pg8::StaticOrder, true, true>(lds, g, S, E); }
        if (L + 1 < DEPTH) SEAM(pb + 5);
    }
#undef IN
#undef SEAM
}

extern "C" void kernel_launch(void* const* d_in, const int* in_sizes, int n_in, void* d_out, int out_size, void* d_ws, size_t ws_size, hipStream_t stream) {
    static int grid = 0;
    if (grid == 0) {
        if (n_in != N_IN || in_sizes[0] != M * DM || out_size != M * DM || ws_size < WS_END) { fprintf(stderr, "kernel_launch: unexpected problem shape (n_in %d, in0 %d, out %d, ws %zu); nothing launched\n", n_in, n_in > 0 ? in_sizes[0] : -1, out_size, ws_size); grid = -1; return; }
        int dev = 0, cus = 0;
        if (hipGetDevice(&dev) != hipSuccess || hipDeviceGetAttribute(&cus, hipDeviceAttributeMultiprocessorCount, dev) != hipSuccess) { grid = -1; return; }
        if (hipFuncSetAttribute((const void*)hybrid_fwd, hipFuncAttributeMaxDynamicSharedMemorySize, LDS_BYTES) != hipSuccess) { fprintf(stderr, "kernel_launch: hipFuncSetAttribute failed\n"); grid = -1; return; }
        int per_cu = 0;
        if (hipOccupancyMaxActiveBlocksPerMultiprocessor(&per_cu, (const void*)hybrid_fwd, NWAVES * 64, LDS_BYTES) != hipSuccess || per_cu < 1) fprintf(stderr, "kernel_launch: occupancy query reports %d\n", per_cu);
        (void)hipGetLastError();
        grid = cus;
    }
    if (grid < 0) return;
    (void)hipMemsetAsync((char*)d_ws + WS_CTL, 0, CTL_ZERO_BYTES, stream);
    Args a{};
    for (int i = 0; i < N_IN; ++i) a.in[i] = (const float*)d_in[i];
    a.out = (float*)d_out; a.ws = (unsigned char*)d_ws;
#if MK_SPLIT
    for (int p = 0; p < N_PHASES; ++p) { a.ph_lo = p; a.ph_hi = p + 1; hipLaunchKernelGGL(hybrid_fwd, dim3(grid), dim3(NWAVES * 64), LDS_BYTES, stream, a); }
#else
    a.ph_lo = 0; a.ph_hi = N_PHASES;
    hipLaunchKernelGGL(hybrid_fwd, dim3(grid), dim3(NWAVES * 64), LDS_BYTES, stream, a);
#endif
}
```

```cpp
#include <hip/hip_runtime.h>
#include <cstdio>
#include <cstdint>
#include <cmath>
namespace pg8 {
#define PG8_LAS __attribute__((address_space(3)))
typedef unsigned short bf16_t;
typedef short bf16x8 __attribute__((ext_vector_type(8)));
typedef float f32x4 __attribute__((ext_vector_type(4)));
typedef unsigned u32x4 __attribute__((ext_vector_type(4)));
constexpr int BM = 256, BK = 64, HALF = 128, HTB = HALF * BK * 2  , STAGE_BYTES = 8 * HTB, NXCD = 8, WGM = 8;

__host__ __device__ __forceinline__ int lds_byte(int r, int c) { const int st = (r >> 4) * 2 + (c >> 5), rr = r & 15, cc = c & 31, ob = rr * 64 + cc * 2; return st * 1024 + (ob ^ (((ob >> 9) & 1) << 5)); }
__host__ __device__ __forceinline__ void stage_rc(int b, int& R, int& C) { const int st = b / 1024, sb = b % 1024, swz = sb ^ (((sb >> 9) & 1) << 5); R = (st >> 1) * 16 + swz / 64; C = (st & 1) * 32 + (swz % 64) / 2; }
__host__ __device__ __forceinline__ int perm32(int rho) { const int n = rho >> 4, i = rho & 15; return 8 * (i >> 2) + 4 * n + (i & 3); }

struct Unit { int pm, pn; };
struct Gemm { const bf16_t* A; const bf16_t* Bt; int M, N, K; };

struct StaticOrder {
    int nM, nN, nwg, G, c;
    __host__ __device__ void init(int M, int N, int G_, int c_) { nM = M / BM; nN = N / BM; nwg = nM * nN; G = G_; c = c_; }
    __host__ __device__ bool next(int i, Unit& u) const {
        const long L = (long)i * G + c; if (L >= nwg) return false;
        int wgid = (int)L; { const int q = nwg / NXCD, r = nwg % NXCD, xcd = wgid % NXCD, off = wgid / NXCD; wgid = (xcd < r ? xcd * (q + 1) : r * (q + 1) + (xcd - r) * q) + off; }
        const int nig = WGM * nN, gid = wgid / nig, fm = gid * WGM, gsz = (nM - fm) < WGM ? (nM - fm) : WGM;
        u.pm = fm + ((wgid % nig) % gsz); u.pn = (wgid % nig) / gsz; return true;
    }
    __device__ __forceinline__ void a_ready(const Unit&) const {}
    __device__ __forceinline__ void done(const Unit&) const {}
};

__device__ __forceinline__ unsigned cvt_pk_bf16(float lo, float hi) { unsigned r; asm volatile("v_cvt_pk_bf16_f32 %0, %1, %2" : "=v"(r) : "v"(lo), "v"(hi)); return r; }
typedef float f32x2 __attribute__((ext_vector_type(2)));
__device__ __forceinline__ f32x2 gelu_pk(f32x2 v) {
    const f32x2 av = __builtin_elementwise_abs(v), d = av * 0.2316418882f + 1.0f;
    f32x2 t; t.x = __builtin_amdgcn_rcpf(d.x); t.y = __builtin_amdgcn_rcpf(d.y);
    f32x2 q = t * 0.5307027145f + (-0.7265760135f); q = q * t + 0.7107068705f; q = q * t + (-0.142248368f); q = q * t + 0.127414796f; q = q * t;
    const f32x2 s = (v * v) * (-0.72134752044f);
    f32x2 e; e.x = __builtin_amdgcn_exp2f(s.x); e.y = __builtin_amdgcn_exp2f(s.y);
    const f32x2 m = v * (q * e), r = v - m;
    f32x2 o; o.x = v.x < 0.f ? m.x : r.x; o.y = v.y < 0.f ? m.y : r.y; return o;
}

template <int ACT  > struct EpiBf16 {
    static constexpr bool PERM = true, AFTER_DRAIN = false; static_assert(ACT == 0 || ACT == 1, "EpiBf16: ACT is 0 (none) or 1 (gelu_pk)");
    bf16_t* O; int ldc; const float* bias; int split_cols; size_t split_stride; float scale0;
    __device__ __forceinline__ void operator()(const f32x4 (&acc)[2][2][4][2], const Unit& u, int wr, int wc, int fr, int fq) const {
        const int row0 = u.pm * BM + wr * 64 + fr; int colt = u.pn * BM; bf16_t* base = O;
        float sc = 1.f; if (split_cols) { const int t = colt / split_cols; base += (size_t)t * split_stride; colt -= t * split_cols; if (t == 0) sc = scale0; }
        const int col0 = colt + wc * 32 + 8 * fq, bcol0 = u.pn * BM + wc * 32 + 8 * fq;
        f32x4 bv[2][2];
#pragma unroll
        for (int bj = 0; bj < 2; ++bj)
#pragma unroll
            for (int n = 0; n < 2; ++n) bv[bj][n] = bias ? *(const f32x4*)(bias + bcol0 + bj * HALF + 4 * n) : (f32x4){0.f, 0.f, 0.f, 0.f};
#pragma unroll
        for (int ai = 0; ai < 2; ++ai)
#pragma unroll
            for (int m = 0; m < 4; ++m) { bf16_t* rowp = base + (size_t)(row0 + ai * HALF + m * 16) * ldc + col0;
#pragma unroll
                for (int bj = 0; bj < 2; ++bj) { f32x4 v0 = acc[ai][bj][m][0] + bv[bj][0], v1 = acc[ai][bj][m][1] + bv[bj][1];
                    if (ACT == 1) { f32x2 a = gelu_pk((f32x2){v0[0], v0[1]}), b = gelu_pk((f32x2){v0[2], v0[3]}), c = gelu_pk((f32x2){v1[0], v1[1]}), d = gelu_pk((f32x2){v1[2], v1[3]});
                        v0 = (f32x4){a.x, a.y, b.x, b.y}; v1 = (f32x4){c.x, c.y, d.x, d.y}; }
                    v0 = v0 * sc; v1 = v1 * sc; u32x4 w; w.x = cvt_pk_bf16(v0[0], v0[1]); w.y = cvt_pk_bf16(v0[2], v0[3]); w.z = cvt_pk_bf16(v1[0], v1[1]); w.w = cvt_pk_bf16(v1[2], v1[3]);
                    *(u32x4*)(rowp + bj * HALF) = w; } }
    }
};
template <class Epi, class Sched, bool ALIGN_EPI = false, bool SP2 = false>
__device__ __forceinline__ void gemm_phase(PG8_LAS unsigned char* lds, const Gemm g, const Sched& S, const Epi& E) {
    int tid_ = threadIdx.x; asm volatile("" : "+v"(tid_));
    const int tid = tid_, wid = __builtin_amdgcn_readfirstlane(tid >> 6), lane = tid & 63, wr = wid >> 2, wc = wid & 3, fr = lane & 15, fq = lane >> 4;
    const int K = g.K, nt = K / BK;
    unsigned voffA[2], voffB[2];
#pragma unroll
    for (int i = 0; i < 2; ++i) { int R, C; stage_rc(tid * 16 + i * 8192, R, C); const int Rb = Epi::PERM ? ((R & ~31) + perm32(R & 31)) : R;
        voffA[i] = (unsigned)(R * K + C) * 2u; voffB[i] = (unsigned)(Rb * K + C) * 2u; }
    const size_t kstep = (size_t)(BK * 2);
    const size_t hstep = (size_t)HALF * K * 2;
    const size_t tstep = 2 * hstep;
    const unsigned ldsw = (unsigned)wid * 1024u;
    const int aoff = lds_byte(wr * 64 + fr, fq * 8), boff = lds_byte(wc * 32 + fr, fq * 8);
#define PG8_SA(b, h) (((b) * 2 + (h)) * HTB)
#define PG8_SB(b, h) ((4 + (b) * 2 + (h)) * HTB)
#define PG8_STAGE(bufoff, gbase, voff) do { _Pragma("unroll") for (int _i = 0; _i < 2; ++_i) \
        __builtin_amdgcn_global_load_lds((const unsigned*)((const char*)(gbase) + (voff)[_i]), (PG8_LAS unsigned*)(lds + (bufoff) + ldsw + _i * 8192), 16, 0, 0); } while (0)
#define PG8_LDA(dst, b, h) do { _Pragma("unroll") for (int m = 0; m < 4; ++m) _Pragma("unroll") for (int k = 0; k < 2; ++k) dst[m][k] = *(const PG8_LAS bf16x8*)(lds + PG8_SA(b, h) + aoff + m * 2048 + k * 1024); } while (0)
#define PG8_LDB(dst, b, h) do { _Pragma("unroll") for (int n = 0; n < 2; ++n) _Pragma("unroll") for (int k = 0; k < 2; ++k) dst[n][k] = *(const PG8_LAS bf16x8*)(lds + PG8_SB(b, h) + boff + n * 2048 + k * 1024); } while (0)
#define PG8_MMA(ai, bj, At, Bt) do { __builtin_amdgcn_s_setprio(1); _Pragma("unroll") for (int m = 0; m < 4; ++m) _Pragma("unroll") for (int n = 0; n < 2; ++n) _Pragma("unroll") for (int k = 0; k < 2; ++k) \
        acc[ai][bj][m][n] = __builtin_amdgcn_mfma_f32_16x16x32_bf16(Bt[n][k], At[m][k], acc[ai][bj][m][n], 0, 0, 0); __builtin_amdgcn_s_setprio(0); } while (0)
#define PG8_WAIT_V(n) asm volatile("s_waitcnt vmcnt(" #n ")" ::: "memory")
#define PG8_WAIT_L(n) asm volatile("s_waitcnt lgkmcnt(" #n ")" ::: "memory")
#define PG8_BAR __builtin_amdgcn_s_barrier()
#define PG8_SCHED __builtin_amdgcn_sched_barrier(0)
    Unit cur, nxt; int ui = 0;
    if (!S.next(0, cur)) return;
    f32x4 acc[2][2][4][2];
#pragma unroll
    for (int a = 0; a < 2; ++a)
#pragma unroll
        for (int b = 0; b < 2; ++b)
#pragma unroll
            for (int m = 0; m < 4; ++m)
#pragma unroll
                for (int n = 0; n < 2; ++n) acc[a][b][m][n] = (f32x4){0.f, 0.f, 0.f, 0.f};
    bf16x8 At[4][2], B0[2][2], B1[2][2];
    const char* cA = (const char*)g.A + (size_t)cur.pm * tstep; const char* cB = (const char*)g.Bt + (size_t)cur.pn * tstep;
    S.a_ready(cur);
    if constexpr (SP2) {
        PG8_STAGE(PG8_SB(0, 0), cB, voffB); PG8_STAGE(PG8_SB(0, 1), cB + hstep, voffB); PG8_STAGE(PG8_SA(0, 0), cA, voffA); PG8_STAGE(PG8_SA(0, 1), cA + hstep, voffA);
        if (wr == 1) PG8_BAR;
        PG8_WAIT_V(2); PG8_BAR;
        PG8_STAGE(PG8_SB(1, 0), cB + kstep, voffB); PG8_STAGE(PG8_SA(1, 0), cA + kstep, voffA); PG8_STAGE(PG8_SB(1, 1), cB + hstep + kstep, voffB);
        PG8_WAIT_V(6); PG8_BAR;
    } else {
        PG8_STAGE(PG8_SB(0, 0), cB, voffB); PG8_STAGE(PG8_SA(0, 0), cA, voffA); PG8_STAGE(PG8_SB(0, 1), cB + hstep, voffB); PG8_STAGE(PG8_SA(0, 1), cA + hstep, voffA);
        if (wr == 1) PG8_BAR;
        PG8_WAIT_V(4); PG8_BAR;
        PG8_STAGE(PG8_SB(1, 0), cB + kstep, voffB); PG8_STAGE(PG8_SA(1, 0), cA + kstep, voffA); PG8_STAGE(PG8_SB(1, 1), cB + hstep + kstep, voffB);
        PG8_WAIT_V(6); PG8_BAR;
    }
    for (;;) {
        const bool has_next = S.next(ui + 1, nxt);
        const char* nA = has_next ? (const char*)g.A + (size_t)nxt.pm * tstep : cA; const char* nB = has_next ? (const char*)g.Bt + (size_t)nxt.pn * tstep : cB;
        for (int t = 0; t < nt; t += 2) {
            const bool last = (t == nt - 2);
            const char* a1 = cA + (size_t)(t + 1) * kstep;
            const char* a2 = last ? nA : cA + (size_t)(t + 2) * kstep; const char* b2 = last ? nB : cB + (size_t)(t + 2) * kstep;
            const char* a3 = a2 + kstep; const char* b3 = b2 + kstep;
            if (last && has_next) S.a_ready(nxt);
            if constexpr (SP2) {
            PG8_LDB(B0, 0, 0); PG8_LDB(B1, 0, 1); PG8_SCHED; PG8_LDA(At, 0, 0); PG8_STAGE(PG8_SA(1, 1), a1 + hstep, voffA);
            PG8_WAIT_V(8); PG8_WAIT_L(0); PG8_BAR; PG8_MMA(0, 0, At, B0); PG8_MMA(0, 1, At, B1); PG8_BAR; PG8_SCHED;
            PG8_LDA(At, 0, 1); PG8_STAGE(PG8_SB(0, 0), b2, voffB); PG8_STAGE(PG8_SB(0, 1), b2 + hstep, voffB); PG8_STAGE(PG8_SA(0, 0), a2, voffA);
            PG8_WAIT_V(8); PG8_WAIT_L(0); PG8_BAR; PG8_MMA(1, 0, At, B0); PG8_MMA(1, 1, At, B1); PG8_BAR; PG8_SCHED;
            PG8_LDB(B0, 1, 0); PG8_LDB(B1, 1, 1); PG8_SCHED; PG8_LDA(At, 1, 0); PG8_STAGE(PG8_SA(0, 1), a2 + hstep, voffA);
            PG8_WAIT_V(8); PG8_WAIT_L(0); PG8_BAR; PG8_MMA(0, 0, At, B0); PG8_MMA(0, 1, At, B1); PG8_BAR; PG8_SCHED;
            PG8_LDA(At, 1, 1); PG8_STAGE(PG8_SB(1, 0), b3, voffB); PG8_STAGE(PG8_SB(1, 1), b3 + hstep, voffB); PG8_STAGE(PG8_SA(1, 0), a3, voffA);
            PG8_WAIT_V(8); PG8_WAIT_L(0); PG8_BAR; PG8_MMA(1, 0, At, B0); PG8_MMA(1, 1, At, B1); PG8_BAR; PG8_SCHED;
            } else {
            PG8_LDB(B0, 0, 0); PG8_SCHED; PG8_LDA(At, 0, 0); PG8_STAGE(PG8_SA(1, 1), a1 + hstep, voffA);
            PG8_WAIT_L(8); PG8_BAR; PG8_WAIT_L(0); PG8_MMA(0, 0, At, B0); PG8_BAR; PG8_SCHED;
            PG8_LDB(B1, 0, 1); PG8_STAGE(PG8_SB(0, 0), b2, voffB);
            PG8_BAR; PG8_WAIT_L(0); PG8_MMA(0, 1, At, B1); PG8_BAR;
            PG8_LDA(At, 0, 1); PG8_STAGE(PG8_SA(0, 0), a2, voffA);
            PG8_BAR; PG8_WAIT_L(0); PG8_MMA(1, 0, At, B0); PG8_BAR; PG8_SCHED;
            PG8_STAGE(PG8_SB(0, 1), b2 + hstep, voffB);
            PG8_WAIT_V(6); PG8_BAR; PG8_MMA(1, 1, At, B1); PG8_BAR;
            PG8_LDB(B0, 1, 0); PG8_SCHED; PG8_LDA(At, 1, 0); PG8_STAGE(PG8_SA(0, 1), a2 + hstep, voffA);
            PG8_WAIT_L(8); PG8_BAR; PG8_WAIT_L(0); PG8_MMA(0, 0, At, B0); PG8_BAR; PG8_SCHED;
            PG8_LDB(B1, 1, 1); PG8_STAGE(PG8_SB(1, 0), b3, voffB);
            PG8_BAR; PG8_WAIT_L(0); PG8_MMA(0, 1, At, B1); PG8_BAR;
            PG8_LDA(At, 1, 1); PG8_STAGE(PG8_SA(1, 0), a3, voffA);
            PG8_BAR; PG8_WAIT_L(0); PG8_MMA(1, 0, At, B0); PG8_BAR; PG8_SCHED;
            PG8_STAGE(PG8_SB(1, 1), b3 + hstep, voffB);
            PG8_WAIT_V(6); PG8_BAR; PG8_MMA(1, 1, At, B1); PG8_BAR;
            }
        }
        if constexpr (ALIGN_EPI) { if (wr == 0) PG8_BAR; }
        if constexpr (!Epi::AFTER_DRAIN) { E(acc, cur, wr, wc, fr, fq); S.done(cur); }
        if (!has_next) break;
#pragma unroll
        for (int a = 0; a < 2; ++a)
#pragma unroll
            for (int b = 0; b < 2; ++b)
#pragma unroll
                for (int m = 0; m < 4; ++m)
#pragma unroll
                    for (int n = 0; n < 2; ++n) acc[a][b][m][n] = (f32x4){0.f, 0.f, 0.f, 0.f};
        cur = nxt; cA = nA; cB = nB; ++ui;
        if constexpr (ALIGN_EPI) { if (wr == 1) PG8_BAR; }
    }
    PG8_WAIT_V(0);
    if constexpr (!ALIGN_EPI) { if (wr == 0) PG8_BAR; }
    PG8_BAR;
    if constexpr (Epi::AFTER_DRAIN) { E.fused(acc, cur, wr, wc, fr, fq, lds, wid, lane); S.done(cur); }
#undef PG8_SA
#undef PG8_SB
#undef PG8_STAGE
#undef PG8_LDA
#undef PG8_LDB
#undef PG8_MMA
#undef PG8_WAIT_V
#undef PG8_WAIT_L
#undef PG8_BAR
#undef PG8_SCHED
}
}
#define GAS __attribute__((address_space(1)))
#define LAS __attribute__((address_space(3)))
typedef unsigned short bf16;
typedef unsigned v4u __attribute__((ext_vector_type(4)));
typedef float f32x4 __attribute__((ext_vector_type(4)));
typedef short bf16x8 __attribute__((ext_vector_type(8)));
typedef GAS unsigned gu32;
typedef GAS unsigned long long gu64;
#define RLX_AGENT __ATOMIC_RELAXED, __HIP_MEMORY_SCOPE_AGENT
#define LDS_WAIT() asm volatile("s_waitcnt lgkmcnt(0)" ::: "memory")
#define VM_WAIT() asm volatile("s_waitcnt vmcnt(0)" ::: "memory")
__device__ __forceinline__ unsigned long long rt() { return __builtin_amdgcn_s_memrealtime(); }
__device__ __forceinline__ unsigned f2bf(float f) { unsigned u = __builtin_bit_cast(unsigned, f); return (u + 0x7fffu + ((u >> 16) & 1u)) >> 16; }
__device__ __forceinline__ unsigned pk2(float lo, float hi) { return f2bf(lo) | (f2bf(hi) << 16); }

#define XB_TMO      128
#define XB_XCNT(j)  (256  + 64 * (j))
#define XB_XSUB(j)  (1280 + 64 * (j))
#define XB_XGEN(j)  (2304 + 64 * (j))
#define XB_TOP      3328
#define XB_TOPGEN   3392
#define XCD_BAR_WORDS 3456
#define XB_SPIN_CAP (1u << 18)

__device__ __forceinline__ unsigned xb_ld(unsigned* p)              { return __hip_atomic_load(p, __ATOMIC_RELAXED, __HIP_MEMORY_SCOPE_AGENT); }
__device__ __forceinline__ unsigned xb_add(unsigned* p, unsigned v) { return __hip_atomic_fetch_add(p, v, __ATOMIC_RELAXED, __HIP_MEMORY_SCOPE_AGENT); }
__device__ __forceinline__ unsigned xb_xcc_id() { return (unsigned)__builtin_amdgcn_s_getreg((3 << 11) | 20) & 0xFu; }
#define XB_SPIN(cond, bar) do { unsigned _sp = 0; while (cond) { __builtin_amdgcn_s_sleep(1); \
    if ((++_sp & 255u) == 0u) { if (xb_ld(&(bar)[XB_TMO])) break; if (_sp > XB_SPIN_CAP) { atomicAdd(&(bar)[XB_TMO], 1u); break; } } } } while (0)

struct XcdBarrier {
    unsigned* bar; unsigned x;
    volatile LAS unsigned* st;
};

__device__ __forceinline__ XcdBarrier xcd_barrier_post(unsigned* bar, volatile LAS unsigned* st) {
    XcdBarrier b; b.bar = bar; b.x = xb_xcc_id(); b.st = st;
    if (threadIdx.x == 0) (void)xb_add(&bar[XB_XCNT(b.x)], 1u);
    return b;
}
__device__ __forceinline__ void xcd_barrier_complete(unsigned* bar, unsigned x, unsigned& nloc, unsigned& nx) {
    const unsigned G = gridDim.x * gridDim.y * gridDim.z;
    unsigned sum, cnt, mine, sp = 0u;
    for (;;) {
        sum = 0u; cnt = 0u; mine = 0u;
#pragma unroll
        for (unsigned j = 0; j < 16; ++j) { const unsigned c = xb_ld(&bar[XB_XCNT(j)]); sum += c; cnt += (c > 0u) ? 1u : 0u; mine = (j == x) ? c : mine; }
        if (sum == G) break;
        __builtin_amdgcn_s_sleep(1);
        if ((++sp & 255u) == 0u) { if (xb_ld(&bar[XB_TMO])) break; if (sp > XB_SPIN_CAP) { atomicAdd(&bar[XB_TMO], 1u); break; } }
    }
    nloc = mine > 0u ? mine : 1u; nx = cnt > 0u ? cnt : 1u;
}

__device__ __forceinline__ void xcd_barrier(const XcdBarrier& b) {
    asm volatile("s_waitcnt vmcnt(0)" ::: "memory");
    __syncthreads();
    if (threadIdx.x == 0) {
        unsigned* bar = b.bar;
        __builtin_amdgcn_s_waitcnt(0);
        unsigned nloc = b.st[0], nx = b.st[1];
        if (nloc == 0u) { xcd_barrier_complete(bar, b.x, nloc, nx); b.st[0] = nloc; b.st[1] = nx; }
        const unsigned old = xb_add(&bar[XB_XSUB(b.x)], 1u);
        const unsigned gen = old / nloc;
        if (old + 1u == (gen + 1u) * nloc) {
            __builtin_amdgcn_fence(__ATOMIC_RELEASE, "agent");
            asm volatile("s_waitcnt vmcnt(0)" ::: "memory");
            const unsigned og = xb_add(&bar[XB_TOP], 1u);
            const unsigned tg = og / nx;
            if (og + 1u == (tg + 1u) * nx) xb_add(&bar[XB_TOPGEN], 1u);
            else XB_SPIN(xb_ld(&bar[XB_TOPGEN]) == tg, bar);
            __builtin_amdgcn_fence(__ATOMIC_ACQUIRE, "agent");
            xb_add(&bar[XB_XGEN(b.x)], 1u);
            asm volatile("s_waitcnt vmcnt(0)" ::: "memory");
        } else {
            XB_SPIN(xb_ld(&bar[XB_TOPGEN]) == gen, bar);
            __builtin_amdgcn_fence(__ATOMIC_ACQUIRE, "agent");
            asm volatile("s_waitcnt vmcnt(0)" ::: "memory");
        }
    }
    __syncthreads();
}
typedef unsigned u32x4 __attribute__((ext_vector_type(4)));

constexpr int NWAVES = 8;
constexpr int BATCH = 8, SEQ = 2048, DM = 1024, M = BATCH * SEQ, DEPTH = 2;
constexpr int DIN = 2564, PP = 2304, NPROJ = 2560, DFF = 2816, NGU = 2 * DFF;
constexpr float EPS = 1e-6f;
constexpr float LOG2E = 1.4426950408889634f;
constexpr int C_U = 0, C_V = 256, C_Z = 512, C_XS = 768, C_B = 1024, C_C = 1280, C_POOL = 1536, C_Q = 1792, C_K = 2048;
enum { I_X = 0, I_N1W, I_WIN, I_GMNW, I_GMWS, I_GMBS, I_CONVW, I_CONVB, I_DTB, I_ALOG, I_SSMD, I_SSMNW, I_POOLW, I_POOLS,
       I_QNW, I_KNW, I_LQ1, I_LK1, I_LQ2, I_LK2, I_SUBLN, I_WOUT, I_N2W, I_WG, I_WU, I_WD, N_IN };

constexpr size_t MiB = 1u << 20;
constexpr size_t WS_CTL = 0, WS_RS = 64 * 1024, RS_STRIDE = (size_t)16384 * 4, CTL_ZERO_BYTES = 64 * 1024 + 4 * 262144;
constexpr size_t WS_W = 2 * MiB, W_LAYER = 24 * MiB, W_IN = 0, W_OUT = 5 * MiB, W_GU = 7 * MiB, W_DN = 18 * MiB;
constexpr size_t WS_XN = 50 * MiB, WS_DT = 82 * MiB, WS_CD = 82 * MiB + 512 * 1024, WS_ST = 83 * MiB, WS_VT = 99 * MiB;
constexpr size_t WS_PROJ = 107 * MiB, WS_MIX = 179 * MiB, WS_H = 107 * MiB, WS_END = 211 * MiB;
constexpr int CW_BAR = 4096;

constexpr int SCR_BYTES = 147456;
constexpr int LDSCTL_OFF = SCR_BYTES, MISC_OFF = LDSCTL_OFF + 320;
constexpr int LDS_BYTES = SCR_BYTES + 1024;

typedef float f32x16 __attribute__((ext_vector_type(16)));
typedef unsigned u32x2 __attribute__((ext_vector_type(2)));
#define DI __device__ __forceinline__
#define OPQ(x) asm volatile("" : "+v"(x))
#define MFMA32(a, b, c) __builtin_amdgcn_mfma_f32_32x32x16_bf16((a), (b), (c), 0, 0, 0)

DI float bf2f(bf16 u) { return __uint_as_float((unsigned)u << 16); }
DI float bflo(unsigned w) { return __uint_as_float(w << 16); }
DI float bfhi(unsigned w) { return __uint_as_float(w & 0xffff0000u); }
DI bf16 f2b(float f) { return (bf16)f2bf(f); }
DI int crow(int reg, int h) { return (reg & 3) + 8 * (reg >> 2) + 4 * h; }
DI float wave_sum(float v) {
#pragma unroll
    for (int o = 1; o < 64; o <<= 1) v += __shfl_xor(v, o);
    return v;
}
DI void unpack8(v4u w, float* f) { f[0] = bflo(w.x); f[1] = bfhi(w.x); f[2] = bflo(w.y); f[3] = bfhi(w.y); f[4] = bflo(w.z); f[5] = bfhi(w.z); f[6] = bflo(w.w); f[7] = bfhi(w.w); }
DI v4u pack8(const float* f) { v4u o; o.x = pk2(f[0], f[1]); o.y = pk2(f[2], f[3]); o.z = pk2(f[4], f[5]); o.w = pk2(f[6], f[7]); return o; }
DI float silu_f(float x) { return x * __builtin_amdgcn_rcpf(1.f + __builtin_amdgcn_exp2f(-x * LOG2E)); }
DI float gelu_tanh_f(float x) { const float y = 0.7978845608f * (x + 0.044715f * x * x * x); return x * __builtin_amdgcn_rcpf(1.f + __builtin_amdgcn_exp2f(-2.f * LOG2E * y)); }

DI f32x16 mma_tile(const LAS bf16* A, int pa, const LAS bf16* Bt, int pb, int K, f32x16 acc, int r, int lh) {
    const LAS bf16* ap = A + r * pa + 8 * lh; const LAS bf16* bp = Bt + r * pb + 8 * lh;
    for (int k = 0; k < K; k += 16) { const bf16x8 a = *(const LAS bf16x8*)(ap + k); const bf16x8 b = *(const LAS bf16x8*)(bp + k); acc = MFMA32(a, b, acc); }
    return acc;
}

DI int swz136(int row, int t) { return row * 136 + ((((t >> 3) ^ (row >> 3)) & 15) << 3) + (t & 7); }
template <bool SWA, bool SWB>
DI f32x16 mma_tile_sw(const LAS bf16* Abuf, int rowA0, const LAS bf16* Bbuf, int rowB0, int K, f32x16 acc, int r, int lh) {
    const int ra = rowA0 + r, rb = rowB0 + r; const int xa = SWA ? ((ra >> 3) & 15) : 0, xb = SWB ? ((rb >> 3) & 15) : 0;
    const LAS bf16* ap = Abuf + ra * 136; const LAS bf16* bp = Bbuf + rb * 136;
    for (int k = 0; k < K; k += 16) { const int kb = (k >> 3) + lh; const bf16x8 a = *(const LAS bf16x8*)(ap + ((kb ^ xa) << 3)); const bf16x8 b = *(const LAS bf16x8*)(bp + ((kb ^ xb) << 3)); acc = MFMA32(a, b, acc); }
    return acc;
}

struct Args { const float* in[N_IN]; float* out; unsigned char* ws; int ph_lo, ph_hi; };
typedef const Args __attribute__((address_space(4)))* KA;
DI KA kargs() { KA p = (KA)__builtin_amdgcn_kernarg_segment_ptr(); asm volatile("" : "+s"(p)); return p; }

namespace pg8 {
struct EpiInProj {
    static constexpr bool PERM = true, AFTER_DRAIN = false;
    bf16_t* O; const float* qw; const float* kw; const float* rs;
    __device__ __forceinline__ void operator()(const f32x4 (&acc)[2][2][4][2], const Unit& u, int wr, int wc, int fr, int fq) const {
        const int row0 = u.pm * BM + wr * 64 + fr, col0 = u.pn * BM + wc * 32 + 8 * fq;
        const int mode = (u.pn < 2) ? 1 : (u.pn == 7 ? 2 : (u.pn == 8 ? 3 : 0));
        f32x4 w0 = (f32x4){1.f, 1.f, 1.f, 1.f}, w1 = w0;
        if (mode >= 2) { const float* wp = (mode == 2 ? qw : kw) + 8 * fq; w0 = *(const f32x4*)wp; w1 = *(const f32x4*)(wp + 4);
            if (mode == 2) { const float sc = 0.17677669529663687f * 1.4426950408889634f; w0 = w0 * sc; w1 = w1 * sc; } }
        float rstv[2][4];
#pragma unroll
        for (int ai = 0; ai < 2; ++ai)
#pragma unroll
            for (int m = 0; m < 4; ++m) { const f32x4 q4 = *(const f32x4*)(rs + (size_t)(row0 + ai * HALF + m * 16) * 4); rstv[ai][m] = 1.0f / sqrtf(((q4[0] + q4[1]) + (q4[2] + q4[3])) * (1.0f / DM) + EPS); }
#pragma unroll
        for (int ai = 0; ai < 2; ++ai)
#pragma unroll
            for (int m = 0; m < 4; ++m) { bf16_t* rowp = O + (size_t)(row0 + ai * HALF + m * 16) * PP + col0;
                const float rst = rstv[ai][m];
#pragma unroll
                for (int bj = 0; bj < 2; ++bj) { f32x4 v0 = acc[ai][bj][m][0] * rst, v1 = acc[ai][bj][m][1] * rst;
                    if (mode == 1) {
#pragma unroll
                        for (int j = 0; j < 4; ++j) { v0[j] = gelu_tanh_f(v0[j]); v1[j] = gelu_tanh_f(v1[j]); }
                    } else if (mode >= 2) {
                        float ss = (v0[0] * v0[0] + v0[1] * v0[1]) + (v0[2] * v0[2] + v0[3] * v0[3]) + (v1[0] * v1[0] + v1[1] * v1[1]) + (v1[2] * v1[2] + v1[3] * v1[3]);
                        ss += __shfl_xor(ss, 16); ss += __shfl_xor(ss, 32);
                        const float rstd = 1.0f / sqrtf(ss * (1.0f / 32.0f) + EPS);
                        v0 = v0 * rstd * w0; v1 = v1 * rstd * w1;
                    }
                    u32x4 w; w.x = cvt_pk_bf16(v0[0], v0[1]); w.y = cvt_pk_bf16(v0[2], v0[3]); w.z = cvt_pk_bf16(v1[0], v1[1]); w.w = cvt_pk_bf16(v1[2], v1[3]);
                    *(u32x4*)(rowp + bj * HALF) = w; } }
    }
};
struct EpiResid {
    static constexpr bool PERM = true, AFTER_DRAIN = false;
    const float* base32; const bf16_t* base16; float* out32; bf16_t* xb; float* rs;
    __device__ __forceinline__ void operator()(const f32x4 (&acc)[2][2][4][2], const Unit& u, int wr, int wc, int fr, int fq) const {
        const int row0 = u.pm * BM + wr * 64 + fr, col0 = u.pn * BM + wc * 32 + 8 * fq;
#pragma unroll
        for (int ai = 0; ai < 2; ++ai) {
            f32x4 pre[4][2][2];
            if (base32) {
#pragma unroll
                for (int m = 0; m < 4; ++m) { const size_t off = (size_t)(row0 + ai * HALF + m * 16) * DM + col0;
#pragma unroll
                    for (int bj = 0; bj < 2; ++bj)
#pragma unroll
                        for (int n = 0; n < 2; ++n) pre[m][bj][n] = *(const f32x4*)(base32 + off + bj * HALF + n * 4); }
            } else {
                u32x4 raw[4][2];
#pragma unroll
                for (int m = 0; m < 4; ++m) { const size_t off = (size_t)(row0 + ai * HALF + m * 16) * DM + col0;
#pragma unroll
                    for (int bj = 0; bj < 2; ++bj) raw[m][bj] = *(const u32x4*)(base16 + off + bj * HALF); }
#pragma unroll
                for (int m = 0; m < 4; ++m)
#pragma unroll
                    for (int bj = 0; bj < 2; ++bj) { const u32x4 w = raw[m][bj];
                        pre[m][bj][0] = (f32x4){__uint_as_float(w.x << 16), __uint_as_float(w.x & 0xffff0000u), __uint_as_float(w.y << 16), __uint_as_float(w.y & 0xffff0000u)};
                        pre[m][bj][1] = (f32x4){__uint_as_float(w.z << 16), __uint_as_float(w.z & 0xffff0000u), __uint_as_float(w.w << 16), __uint_as_float(w.w & 0xffff0000u)}; }
            }
            asm volatile("" ::: "memory");
#pragma unroll
            for (int m = 0; m < 4; ++m) { const int row = row0 + ai * HALF + m * 16; const size_t off = (size_t)row * DM + col0; float ss = 0.f;
#pragma unroll
                for (int bj = 0; bj < 2; ++bj) { const size_t o = off + bj * HALF; const f32x4 v0 = pre[m][bj][0] + acc[ai][bj][m][0], v1 = pre[m][bj][1] + acc[ai][bj][m][1];
                    if (out32) { *(f32x4*)(out32 + o) = v0; *(f32x4*)(out32 + o + 4) = v1; }
                    if (xb) { ss += ((v0[0] * v0[0] + v0[1] * v0[1]) + (v0[2] * v0[2] + v0[3] * v0[3])) + ((v1[0] * v1[0] + v1[1] * v1[1]) + (v1[2] * v1[2] + v1[3] * v1[3]));
                        u32x4 w; w.x = cvt_pk_bf16(v0[0], v0[1]); w.y = cvt_pk_bf16(v0[2], v0[3]); w.z = cvt_pk_bf16(v1[0], v1[1]); w.w = cvt_pk_bf16(v1[2], v1[3]); *(u32x4*)(xb + o) = w; } }
                if (xb) { ss += __shfl_xor(ss, 16); ss += __shfl_xor(ss, 32); if (fq == 0) __hip_atomic_fetch_add(rs + (size_t)row * 4 + u.pn, ss, __ATOMIC_RELAXED, __HIP_MEMORY_SCOPE_WORKGROUP); }     }
            asm volatile("" ::: "memory");
        }
    }
};
struct EpiSwiGLU {
    static constexpr bool PERM = true, AFTER_DRAIN = false;
    bf16_t* O; const float* rs;
    __device__ __forceinline__ void operator()(const f32x4 (&acc)[2][2][4][2], const Unit& u, int wr, int wc, int fr, int fq) const {
        const int row0 = u.pm * BM + wr * 64 + fr, col0 = u.pn * HALF + wc * 32 + 8 * fq;
        float rstv[2][4];
#pragma unroll
        for (int ai = 0; ai < 2; ++ai)
#pragma unroll
            for (int m = 0; m < 4; ++m) { const f32x4 q4 = *(const f32x4*)(rs + (size_t)(row0 + ai * HALF + m * 16) * 4); rstv[ai][m] = 1.0f / sqrtf(((q4[0] + q4[1]) + (q4[2] + q4[3])) * (1.0f / DM) + EPS); }
#pragma unroll
        for (int ai = 0; ai < 2; ++ai)
#pragma unroll
            for (int m = 0; m < 4; ++m) { bf16_t* rowp = O + (size_t)(row0 + ai * HALF + m * 16) * DFF + col0;
                f32x4 h0, h1; const float rst = rstv[ai][m];
#pragma unroll
                for (int j = 0; j < 4; ++j) { h0[j] = silu_f(acc[ai][0][m][0][j] * rst) * (acc[ai][1][m][0][j] * rst); h1[j] = silu_f(acc[ai][0][m][1][j] * rst) * (acc[ai][1][m][1][j] * rst); }
                u32x4 w; w.x = cvt_pk_bf16(h0[0], h0[1]); w.y = cvt_pk_bf16(h0[2], h0[3]); w.z = cvt_pk_bf16(h1[0], h1[1]); w.w = cvt_pk_bf16(h1[2], h1[3]);
                *(u32x4*)rowp = w; }
    }
};
struct EpiVT {
    static constexpr bool PERM = true, AFTER_DRAIN = false;
    bf16_t* O; const float* rs;
    __device__ __forceinline__ void operator()(const f32x4 (&acc)[2][2][4][2], const Unit& u, int wr, int wc, int fr, int fq) const {
        const int row0 = u.pm * BM + wr * 64 + fr, col0 = u.pn * BM + wc * 32 + 8 * fq;
        f32x4 sc[2][2];
#pragma unroll
        for (int bj = 0; bj < 2; ++bj)
#pragma unroll
            for (int n = 0; n < 2; ++n) {
#pragma unroll
                for (int j = 0; j < 4; ++j) { const f32x4 q4 = *(const f32x4*)(rs + (size_t)(col0 + bj * HALF + 4 * n + j) * 4); sc[bj][n][j] = 1.0f / sqrtf(((q4[0] + q4[1]) + (q4[2] + q4[3])) * (1.0f / DM) + EPS); } }
#pragma unroll
        for (int ai = 0; ai < 2; ++ai)
#pragma unroll
            for (int m = 0; m < 4; ++m) { bf16_t* rowp = O + (size_t)(row0 + ai * HALF + m * 16) * M + col0;
#pragma unroll
                for (int bj = 0; bj < 2; ++bj) { const f32x4 v0 = acc[ai][bj][m][0] * sc[bj][0], v1 = acc[ai][bj][m][1] * sc[bj][1];
                    u32x4 w; w.x = cvt_pk_bf16(v0[0], v0[1]); w.y = cvt_pk_bf16(v0[2], v0[3]); w.z = cvt_pk_bf16(v1[0], v1[1]); w.w = cvt_pk_bf16(v1[2], v1[3]);
                    *(u32x4*)(rowp + bj * HALF) = w; } }
    }
};
}

DI void tr_item(const float* src, int pitch, int k0, int c0, bf16* dst, int drow0, int Kd, LAS float* scr, int lane, const float* ksc) {
#pragma unroll 8
    for (int i = 0; i < 32; ++i) { const int kk = 2 * i + (lane >> 5); scr[kk * 33 + (lane & 31)] = src[(size_t)(k0 + kk) * pitch + c0 + (lane & 31)]; }
    LDS_WAIT(); asm volatile("" ::: "memory");
    const int c = lane & 7;
    f32x4 k0v = (f32x4){1.f, 1.f, 1.f, 1.f}, k1v = k0v; if (ksc) { k0v = *(const f32x4*)(ksc + k0 + 8 * c); k1v = *(const f32x4*)(ksc + k0 + 8 * c + 4); }
#pragma unroll
    for (int j = 0; j < 4; ++j) { const int n = (lane >> 3) + 8 * j; const LAS float* s = scr + (8 * c) * 33 + n;
        v4u o; o.x = pk2(s[0 * 33] * k0v[0], s[1 * 33] * k0v[1]); o.y = pk2(s[2 * 33] * k0v[2], s[3 * 33] * k0v[3]); o.z = pk2(s[4 * 33] * k1v[0], s[5 * 33] * k1v[1]); o.w = pk2(s[6 * 33] * k1v[2], s[7 * 33] * k1v[3]);
        *(v4u*)(dst + (size_t)(drow0 + n) * Kd + k0 + 8 * c) = o; }
    LDS_WAIT(); asm volatile("" ::: "memory");
}
constexpr int WI_INP = 16 * 80, WI_OUT = 16 * 32, WI_G = 16 * 88, WI_D = 44 * 32, WI_PER_L = WI_INP + WI_OUT + 2 * WI_G + WI_D;
DI void weights_phase(KA a, LAS unsigned char* lds, int L, int lo, int hi, int rank, int nranks, int wave, int lane) {
    OPQ(lane);
    LAS float* scr = (LAS float*)(lds + wave * 16384);
    unsigned char* wb = a->ws + WS_W + (size_t)L * W_LAYER;
    for (int it = lo + rank; it < hi; it += nranks) {
        int r = it;
        if (r < WI_INP) { const int kb = r / 80, nb = r % 80, d0 = nb * 32; tr_item(a->in[I_WIN] + (size_t)L * DM * DIN, DIN, kb * 64, d0 < 1536 ? d0 : d0 + 4, (bf16*)(wb + W_IN), d0, DM, scr, lane, a->in[I_N1W] + L * DM); continue; } r -= WI_INP;
        if (r < WI_OUT) { const int kb = r / 32, nb = r % 32; tr_item(a->in[I_WOUT] + (size_t)L * DM * DM, DM, kb * 64, nb * 32, (bf16*)(wb + W_OUT), nb * 32, DM, scr, lane, nullptr); continue; } r -= WI_OUT;
        if (r < WI_G) { const int kb = r / 88, nb = r % 88, c0 = nb * 32; tr_item(a->in[I_WG] + (size_t)L * DM * DFF, DFF, kb * 64, c0, (bf16*)(wb + W_GU), (c0 >> 7) * 256 + (c0 & 127), DM, scr, lane, a->in[I_N2W] + L * DM); continue; } r -= WI_G;
        if (r < WI_G) { const int kb = r / 88, nb = r % 88, c0 = nb * 32; tr_item(a->in[I_WU] + (size_t)L * DM * DFF, DFF, kb * 64, c0, (bf16*)(wb + W_GU), (c0 >> 7) * 256 + 128 + (c0 & 127), DM, scr, lane, a->in[I_N2W] + L * DM); continue; } r -= WI_G;
        { const int kb = r / 32, nb = r % 32; tr_item(a->in[I_WD] + (size_t)L * DFF * DM, DM, kb * 64, nb * 32, (bf16*)(wb + W_DN), nb * 32, DFF, scr, lane, nullptr); }
    }
}
DI void prep_phase(const float* xsrc, bf16* XB, float* rs, int vcu, int G, int wave, int lane) {
    OPQ(lane);
    for (int m = vcu * NWAVES + wave; m < M; m += G * NWAVES) {
        const f32x4* xr = (const f32x4*)(xsrc + (size_t)m * DM) + lane;
        f32x4 v[4]; float s = 0.f;
#pragma unroll
        for (int j = 0; j < 4; ++j) { v[j] = xr[64 * j]; s += (v[j].x * v[j].x + v[j].y * v[j].y) + (v[j].z * v[j].z + v[j].w * v[j].w); }
        s = wave_sum(s);
        unsigned long long* o8 = (unsigned long long*)(XB + (size_t)m * DM) + lane;
#pragma unroll
        for (int j = 0; j < 4; ++j) o8[64 * j] = (unsigned long long)pk2(v[j].x, v[j].y) | ((unsigned long long)pk2(v[j].z, v[j].w) << 32);
        if (lane == 0) rs[(size_t)m * 4] = s;
    }
}

DI void gmlp_item(KA a, int L, int b, int c, int h, LAS unsigned char* lds, int tid, int wave, int lane) {
    OPQ(lane); OPQ(tid);
    LAS bf16* Wm = (LAS bf16*)lds; LAS bf16* vT = (LAS bf16*)(lds + 34816);
    const bf16* PROJ = (const bf16*)(a->ws + WS_PROJ); bf16* MIX = (bf16*)(a->ws + WS_MIX);
    const int tok0 = b * SEQ + c * 128;
    const float* ws = a->in[I_GMWS] + (size_t)(L * 4 + h) * 16384;
#pragma unroll
    for (int i = 0; i < 8; ++i) { const int idx = tid + 512 * i, t = idx >> 5, s4 = (idx & 31) * 4; const f32x4 w = *(const f32x4*)(ws + t * 128 + s4);
        u32x2 p; p.x = pk2(s4 <= t ? w.x : 0.f, s4 + 1 <= t ? w.y : 0.f); p.y = pk2(s4 + 2 <= t ? w.z : 0.f, s4 + 3 <= t ? w.w : 0.f);
        *(LAS u32x2*)(Wm + t * 136 + s4) = p; }
    { const int t = tid >> 2, qd = tid & 3; const bf16* vp = PROJ + (size_t)(tok0 + t) * PP + C_V + h * 64 + qd * 16;
      float f[16]; unpack8(*(const v4u*)vp, f); unpack8(*(const v4u*)(vp + 8), f + 8);
      float ss = 0.f;
#pragma unroll
      for (int i = 0; i < 16; ++i) ss += f[i] * f[i];
      ss += __shfl_xor(ss, 1); ss += __shfl_xor(ss, 2);
      const float rstd = 1.0f / sqrtf(ss * (1.0f / 64.0f) + EPS); const float* gw = a->in[I_GMNW] + L * 256 + h * 64 + qd * 16;
#pragma unroll
      for (int i = 0; i < 16; ++i) vT[(qd * 16 + i) * 136 + t] = f2b(f[i] * rstd * gw[i]); }
    __syncthreads();
    { const int tt = wave >> 1, dtl = wave & 1, r = lane & 31, lh = lane >> 5;
      f32x16 acc = {}; acc = mma_tile(Wm + tt * 32 * 136, 136, vT + dtl * 32 * 136, 136, 32 * (tt + 1), acc, r, lh);
      const float* bs = a->in[I_GMBS] + (L * 4 + h) * 128; const int d = dtl * 32 + r;
#pragma unroll
      for (int reg = 0; reg < 16; ++reg) { const int t = tt * 32 + crow(reg, lh); const float u = bf2f(PROJ[(size_t)(tok0 + t) * PP + C_U + h * 64 + d]);
          MIX[(size_t)(tok0 + t) * DM + h * 64 + d] = f2b(u * (acc[reg] + bs[t])); } }
    __syncthreads();
}
template <int WIN> DI void pool_win(const bf16* hp, int tpos, float* s) {
    float cur[16];
#pragma unroll
    for (int i = 0; i < 16; ++i) s[i] = 0.f;
#pragma unroll
    for (int j = 0; j < WIN; ++j) { const bool ok = tpos - j >= 0; const bf16* pp = ok ? hp - (size_t)j * PP : hp; float f[16]; unpack8(*(const v4u*)pp, f); unpack8(*(const v4u*)(pp + 8), f + 8);
#pragma unroll
        for (int i = 0; i < 16; ++i) { if (j == 0) cur[i] = f[i]; s[i] += ok ? f[i] : 0.f; } }
    const int cnt = (tpos + 1 < WIN) ? tpos + 1 : WIN; const float inv = 1.0f / (float)cnt;
#pragma unroll
    for (int i = 0; i < 16; ++i) s[i] = s[i] * inv - cur[i];
}
DI void pool_item(KA a, int L, int b, int c, int g, LAS unsigned char* lds, int tid, int wave, int lane) {
    OPQ(lane); OPQ(tid);
    LAS bf16* P = (LAS bf16*)lds; LAS bf16* WT = (LAS bf16*)(lds + 18432);
    const bf16* PROJ = (const bf16*)(a->ws + WS_PROJ); bf16* MIX = (bf16*)(a->ws + WS_MIX);
    const int tok0 = b * SEQ + c * 128;
    { const int t = tid >> 2, qd = tid & 3, tpos = c * 128 + t;
      const bf16* hp = PROJ + (size_t)(b * SEQ + tpos) * PP + C_POOL + g * 64 + qd * 16;
      float s[16];
      switch (g) { case 0: pool_win<2>(hp, tpos, s); break; case 1: pool_win<4>(hp, tpos, s); break; case 2: pool_win<8>(hp, tpos, s); break; default: pool_win<16>(hp, tpos, s); break; }
      *(LAS v4u*)(P + t * 72 + qd * 16) = pack8(s); *(LAS v4u*)(P + t * 72 + qd * 16 + 8) = pack8(s + 8); }
    { const float* pw = a->in[I_POOLW] + (size_t)(L * 4 + g) * 4096;
#pragma unroll
      for (int i = 0; i < 8; ++i) { const int idx = tid + 512 * i, d = idx >> 6, e = idx & 63; WT[e * 72 + d] = f2b(pw[d * 64 + e]); } }
    __syncthreads();
    { const int tt = wave >> 1, et = wave & 1, r = lane & 31, lh = lane >> 5;
      f32x16 acc = {}; acc = mma_tile(P + tt * 32 * 72, 72, WT + et * 32 * 72, 72, 64, acc, r, lh);
      const int e = et * 32 + r; const float sc = a->in[I_POOLS][L * 256 + g * 64 + e];
#pragma unroll
      for (int reg = 0; reg < 16; ++reg) { const int t = tt * 32 + crow(reg, lh); MIX[(size_t)(tok0 + t) * DM + 512 + g * 64 + e] = f2b(acc[reg] * sc); } }
    __syncthreads();
}
DI void gmlp_pair(KA a, int L, int itA, int itB, LAS unsigned char* lds, int tid, int wave, int lane) {
    OPQ(lane); OPQ(tid);
    const bf16* PROJ = (const bf16*)(a->ws + WS_PROJ); bf16* MIX = (bf16*)(a->ws + WS_MIX);
    constexpr int REG = 52224;
    int tok0[2], hq[2]; const int its[2] = {itA, itB};
#pragma unroll
    for (int q = 0; q < 2; ++q) { tok0[q] = (its[q] >> 6) * SEQ + ((its[q] >> 2) & 15) * 128; hq[q] = its[q] & 3; }
    f32x4 wv[2][8]; v4u vv[2][2];
    const int vt = tid >> 2, vqd = tid & 3;
#pragma unroll
    for (int q = 0; q < 2; ++q) { const float* ws = a->in[I_GMWS] + (size_t)(L * 4 + hq[q]) * 16384;
#pragma unroll
        for (int i = 0; i < 8; ++i) { const int idx = tid + 512 * i; wv[q][i] = *(const f32x4*)(ws + (idx >> 5) * 128 + (idx & 31) * 4); }
        const bf16* vp = PROJ + (size_t)(tok0[q] + vt) * PP + C_V + hq[q] * 64 + vqd * 16; vv[q][0] = *(const v4u*)vp; vv[q][1] = *(const v4u*)(vp + 8); }
#pragma unroll
    for (int q = 0; q < 2; ++q) { LAS bf16* Wm = (LAS bf16*)(lds + q * REG); LAS bf16* vT = (LAS bf16*)(lds + q * REG + 34816);
#pragma unroll
        for (int i = 0; i < 8; ++i) { const int idx = tid + 512 * i, t = idx >> 5, s4 = (idx & 31) * 4; const f32x4 w = wv[q][i];
            u32x2 p; p.x = pk2(s4 <= t ? w.x : 0.f, s4 + 1 <= t ? w.y : 0.f); p.y = pk2(s4 + 2 <= t ? w.z : 0.f, s4 + 3 <= t ? w.w : 0.f);
            *(LAS u32x2*)(Wm + t * 136 + s4) = p; }
        float f[16]; unpack8(vv[q][0], f); unpack8(vv[q][1], f + 8);
        float ss = 0.f;
#pragma unroll
        for (int i = 0; i < 16; ++i) ss += f[i] * f[i];
        ss += __shfl_xor(ss, 1); ss += __shfl_xor(ss, 2);
        const float rstd = 1.0f / sqrtf(ss * (1.0f / 64.0f) + EPS); const float* gw = a->in[I_GMNW] + L * 256 + hq[q] * 64 + vqd * 16;
#pragma unroll
        for (int i = 0; i < 16; ++i) vT[(vqd * 16 + i) * 136 + vt] = f2b(f[i] * rstd * gw[i]); }
    __syncthreads();
    { const int tt = wave >> 1, dtl = wave & 1, r = lane & 31, lh = lane >> 5, d = dtl * 32 + r;
      float uu[2][16];
#pragma unroll
      for (int q = 0; q < 2; ++q)
#pragma unroll
          for (int reg = 0; reg < 16; ++reg) uu[q][reg] = bf2f(PROJ[(size_t)(tok0[q] + tt * 32 + crow(reg, lh)) * PP + C_U + hq[q] * 64 + d]);
      f32x16 acc[2];
#pragma unroll
      for (int q = 0; q < 2; ++q) { acc[q] = (f32x16){}; acc[q] = mma_tile((LAS bf16*)(lds + q * REG) + tt * 32 * 136, 136, (LAS bf16*)(lds + q * REG + 34816) + dtl * 32 * 136, 136, 32 * (tt + 1), acc[q], r, lh); }
#pragma unroll
      for (int q = 0; q < 2; ++q) { const float* bs = a->in[I_GMBS] + (L * 4 + hq[q]) * 128;
#pragma unroll
          for (int reg = 0; reg < 16; ++reg) { const int t = tt * 32 + crow(reg, lh); MIX[(size_t)(tok0[q] + t) * DM + hq[q] * 64 + d] = f2b(uu[q][reg] * (acc[q][reg] + bs[t])); } } }
    __syncthreads();
}
DI void pool_pair(KA a, int L, int itA, int itB, LAS unsigned char* lds, int tid, int wave, int lane) {
    OPQ(lane); OPQ(tid);
    const bf16* PROJ = (const bf16*)(a->ws + WS_PROJ); bf16* MIX = (bf16*)(a->ws + WS_MIX);
    constexpr int R_OFF = 0, P_OFF = 144 * 72 * 2, W_OFF = P_OFF + 128 * 72 * 2, REG = W_OFF + 64 * 72 * 2;
    const int its[2] = {itA, itB};
    v4u rv[2][3]; float wq[2][8];
#pragma unroll
    for (int q = 0; q < 2; ++q) { const int b = its[q] >> 6, c = (its[q] >> 2) & 15, g = its[q] & 3;
#pragma unroll
        for (int i = 0; i < 3; ++i) { const int idx = tid + 512 * i, row = idx >> 3, ch = idx & 7, tp = c * 128 - 16 + row; const bool ok = (idx < 144 * 8) && tp >= 0;
            rv[q][i] = *(const v4u*)(PROJ + (size_t)(b * SEQ + (ok ? tp : c * 128)) * PP + C_POOL + g * 64 + ch * 8); if (!ok) rv[q][i] = (v4u){0u, 0u, 0u, 0u}; }
        const float* pw = a->in[I_POOLW] + (size_t)(L * 4 + g) * 4096;
#pragma unroll
        for (int i = 0; i < 8; ++i) wq[q][i] = pw[tid + 512 * i]; }
#pragma unroll
    for (int q = 0; q < 2; ++q) { LAS bf16* R = (LAS bf16*)(lds + q * REG + R_OFF); LAS bf16* WT = (LAS bf16*)(lds + q * REG + W_OFF);
#pragma unroll
        for (int i = 0; i < 3; ++i) { const int idx = tid + 512 * i; if (idx < 144 * 8) *(LAS v4u*)(R + (idx >> 3) * 72 + (idx & 7) * 8) = rv[q][i]; }
#pragma unroll
        for (int i = 0; i < 8; ++i) { const int idx = tid + 512 * i, d = idx >> 6, e = idx & 63; WT[e * 72 + d] = f2b(wq[q][i]); } }
    __syncthreads();
    { const int t = tid >> 2, qd = tid & 3;
#pragma unroll
      for (int q = 0; q < 2; ++q) { const int c = (its[q] >> 2) & 15, g = its[q] & 3, win = 2 << g, tpos = c * 128 + t, cnt = (tpos + 1 < win) ? tpos + 1 : win;
          const LAS bf16* R = (const LAS bf16*)(lds + q * REG + R_OFF) + (t + 16) * 72 + qd * 16; LAS bf16* P = (LAS bf16*)(lds + q * REG + P_OFF);
          float sacc[16], cur[16];
          unpack8(*(const LAS v4u*)R, cur); unpack8(*(const LAS v4u*)(R + 8), cur + 8);
#pragma unroll
          for (int i = 0; i < 16; ++i) sacc[i] = cur[i];
          for (int jw = 1; jw < win; ++jw) { float f[16]; unpack8(*(const LAS v4u*)(R - jw * 72), f); unpack8(*(const LAS v4u*)(R - jw * 72 + 8), f + 8);
#pragma unroll
              for (int i = 0; i < 16; ++i) sacc[i] += f[i]; }
          const float inv = 1.0f / (float)cnt;
#pragma unroll
          for (int i = 0; i < 16; ++i) sacc[i] = sacc[i] * inv - cur[i];
          *(LAS v4u*)(P + t * 72 + qd * 16) = pack8(sacc); *(LAS v4u*)(P + t * 72 + qd * 16 + 8) = pack8(sacc + 8); } }
    __syncthreads();
    { const int tt = wave >> 1, et = wave & 1, r = lane & 31, lh = lane >> 5, e = et * 32 + r;
#pragma unroll
      for (int q = 0; q < 2; ++q) { const int b = its[q] >> 6, c = (its[q] >> 2) & 15, g = its[q] & 3, tok0 = b * SEQ + c * 128;
          f32x16 acc = {}; acc = mma_tile((LAS bf16*)(lds + q * REG + P_OFF) + tt * 32 * 72, 72, (LAS bf16*)(lds + q * REG + W_OFF) + et * 32 * 72, 72, 64, acc, r, lh);
          const float sc = a->in[I_POOLS][L * 256 + g * 64 + e];
#pragma unroll
          for (int reg = 0; reg < 16; ++reg) { const int tr = tt * 32 + crow(reg, lh); MIX[(size_t)(tok0 + tr) * DM + 512 + g * 64 + e] = f2b(acc[reg] * sc); } } }
    __syncthreads();
}
constexpr int SSD_DT = 139264, SSD_AR = SSD_DT + 1024, SSD_ACS = SSD_AR + 1024;
DI void ssd_dt(KA a, int L, int g, int tok0, LAS unsigned char* lds, int tid, const LAS float* dtraw) {
    LAS float* dtv = (LAS float*)(lds + SSD_DT); LAS float* wtot = (LAS float*)(lds + SSD_AR); LAS float* acs = (LAS float*)(lds + SSD_ACS);
    const float* DT = (const float*)(a->ws + WS_DT);
    const int hh = (tid >> 7) & 1, t = tid & 127, h = 2 * g + hh, ln = tid & 63, wv = tid >> 6;
    if (tid < 256) { const float x = (dtraw ? dtraw[t * 2 + hh] : DT[(size_t)(tok0 + t) * 4 + h]) + a->in[I_DTB][L * 4 + h]; const float ey = __expf(x); const float sp = x > 20.f ? x : (ey < 0.01f ? ey * (1.f - ey * (0.5f - ey * (1.f / 3.f))) : __logf(1.f + ey));
        float s = -sp * __expf(a->in[I_ALOG][L * 4 + h]);
#pragma unroll
        for (int o = 1; o < 64; o <<= 1) { const float n = __shfl_up(s, o); if (ln >= o) s += n; }
        dtv[t * 2 + hh] = sp; acs[t * 2 + hh] = s; if (ln == 63) wtot[wv] = s; }
    __syncthreads();
    if (tid < 256 && (wv & 1)) acs[t * 2 + hh] += wtot[wv - 1];
    __syncthreads();
}
DI void conv_load(const bf16* p, int tpos0, v4u (&raw)[7]) {
#pragma unroll
    for (int rr = 0; rr < 7; ++rr) { const bool ok = tpos0 - 3 + rr >= 0; raw[rr] = *(const v4u*)(ok ? p + (ptrdiff_t)(rr - 3) * PP : p); if (!ok) raw[rr] = (v4u){0u, 0u, 0u, 0u}; }
}
DI void conv_apply(const v4u (&raw)[7], const float* cw, const float* cb, float (&out)[4][8]) {
    f32x4 w[8];
#pragma unroll
    for (int i = 0; i < 8; ++i) w[i] = *(const f32x4*)(cw + 4 * i);
    const f32x4 b0 = *(const f32x4*)cb, b1 = *(const f32x4*)(cb + 4);
    const float bias[8] = {b0.x, b0.y, b0.z, b0.w, b1.x, b1.y, b1.z, b1.w};
    float x[7][8];
#pragma unroll
    for (int rr = 0; rr < 7; ++rr) unpack8(raw[rr], x[rr]);
#pragma unroll
    for (int k = 0; k < 4; ++k)
#pragma unroll
        for (int i = 0; i < 8; ++i) { float acc = bias[i];
#pragma unroll
            for (int jj = 0; jj < 4; ++jj) acc += x[k + jj][i] * w[i][jj];
            out[k][i] = silu_f(acc); }
}
DI void ssd_pass1(KA a, int L, int b, int c, int g, LAS unsigned char* lds, int tid, int wave, int lane) {
    OPQ(lane); OPQ(tid);
    LAS bf16* XwT = (LAS bf16*)lds; LAS bf16* BT = (LAS bf16*)(lds + 34816);
    LAS float* dtv = (LAS float*)(lds + SSD_DT); LAS float* acs = (LAS float*)(lds + SSD_ACS);
    const bf16* PROJ = (const bf16*)(a->ws + WS_PROJ); bf16* ST = (bf16*)(a->ws + WS_ST); float* CD = (float*)(a->ws + WS_CD);
    const int tok0 = b * SEQ + c * 128;
    v4u rawx[7], rawb[7];
    { const int cg = tid & 15, t0 = (tid >> 4) * 4; const bf16* rowp = PROJ + (size_t)(tok0 + t0) * PP + g * 128 + cg * 8; conv_load(rowp + C_XS, c * 128 + t0, rawx); conv_load(rowp + C_B, c * 128 + t0, rawb); }
    {
      LAS float* Wd = (LAS float*)(lds + 69632); LAS float* dtraw = (LAS float*)(lds + SSD_DT + 3072);
      const float* win = a->in[I_WIN] + (size_t)L * DM * DIN + 1536 + 2 * g; const float* nw = a->in[I_N1W] + L * DM;
      for (int k = tid; k < DM; k += NWAVES * 64) { const float w = nw[k]; Wd[2 * k] = w * win[(size_t)k * DIN]; Wd[2 * k + 1] = w * win[(size_t)k * DIN + 1]; }
      __syncthreads();
      const bf16* XB = (const bf16*)(a->ws + WS_XN); const float* rs = (const float*)(a->ws + WS_RS) + (size_t)(2 * L) * RS_STRIDE; float* DTg = (float*)(a->ws + WS_DT);
      const int t4 = tid >> 4, l16 = tid & 15; const bf16* xr = XB + (size_t)(tok0 + t4) * DM + l16 * 8;
      float a0[4] = {0.f, 0.f, 0.f, 0.f}, a1[4] = {0.f, 0.f, 0.f, 0.f};
#pragma unroll 4
      for (int mm = 0; mm < 8; ++mm) { const int k = mm * 128 + l16 * 8; f32x4 w[4];
#pragma unroll
          for (int e = 0; e < 4; ++e) w[e] = *(const LAS f32x4*)(Wd + 2 * k + 4 * e);
#pragma unroll
          for (int i = 0; i < 4; ++i) { float f[8]; unpack8(*(const v4u*)(xr + (size_t)i * 32 * DM + mm * 128), f);
#pragma unroll
              for (int e = 0; e < 4; ++e) { a0[i] += f[2 * e] * w[e][0] + f[2 * e + 1] * w[e][2]; a1[i] += f[2 * e] * w[e][1] + f[2 * e + 1] * w[e][3]; } } }
#pragma unroll
      for (int i = 0; i < 4; ++i) {
#pragma unroll
          for (int o = 1; o < 16; o <<= 1) { a0[i] += __shfl_xor(a0[i], o); a1[i] += __shfl_xor(a1[i], o); }
          if (l16 == 0) { const int t = t4 + 32 * i; const f32x4 q4 = *(const f32x4*)(rs + (size_t)(tok0 + t) * 4); const float rst = 1.0f / sqrtf(((q4[0] + q4[1]) + (q4[2] + q4[3])) * (1.0f / DM) + EPS);
              const float d0 = a0[i] * rst, d1 = a1[i] * rst; dtraw[t * 2] = d0; dtraw[t * 2 + 1] = d1; DTg[(size_t)(tok0 + t) * 4 + 2 * g] = d0; DTg[(size_t)(tok0 + t) * 4 + 2 * g + 1] = d1; } }
      __syncthreads();
      ssd_dt(a, L, g, tok0, lds, tid, dtraw); }
    { const int cg = tid & 15, t0 = (tid >> 4) * 4, tpos0 = c * 128 + t0, ch = cg * 8, hh = cg >> 3; const bf16* rowp = PROJ + (size_t)(tok0 + t0) * PP;
      const float* cwb = a->in[I_CONVW] + (size_t)L * 768 * 4; const float* cbb = a->in[I_CONVB] + L * 768;
      float o[4][8];
      conv_apply(rawx, cwb + (g * 128 + ch) * 4, cbb + g * 128 + ch, o);
      float wg[4]; const float aend = acs[127 * 2 + hh];
#pragma unroll
      for (int k = 0; k < 4; ++k) wg[k] = dtv[(t0 + k) * 2 + hh] * __expf(aend - acs[(t0 + k) * 2 + hh]);
#pragma unroll
      for (int i = 0; i < 8; ++i) { u32x2 w; w.x = pk2(o[0][i] * wg[0], o[1][i] * wg[1]); w.y = pk2(o[2][i] * wg[2], o[3][i] * wg[3]); *(LAS u32x2*)(XwT + swz136(ch + i, t0)) = w; }
      conv_apply(rawb, cwb + (256 + g * 128 + ch) * 4, cbb + 256 + g * 128 + ch, o);
#pragma unroll
      for (int i = 0; i < 8; ++i) { u32x2 w; w.x = pk2(o[0][i], o[1][i]); w.y = pk2(o[2][i], o[3][i]); *(LAS u32x2*)(BT + swz136(ch + i, t0)) = w; } }
    __syncthreads();
    { const int rt = wave >> 1, r = lane & 31, lh = lane >> 5, hh = rt >> 1, h = 2 * g + hh;
#pragma unroll
      for (int q = 0; q < 2; ++q) { const int ct = (wave & 1) * 2 + q; f32x16 acc = {}; acc = mma_tile_sw<true, true>(XwT, rt * 32, BT, ct * 32, 128, acc, r, lh);
#pragma unroll
          for (int reg = 0; reg < 16; ++reg) { const int p = (rt & 1) * 32 + crow(reg, lh); ST[((size_t)((b * 16 + c) * 4 + h) * 64 + p) * 128 + ct * 32 + r] = f2b(acc[reg]); } } }
    if (tid < 2) CD[(b * 16 + c) * 4 + 2 * g + tid] = __expf(acs[127 * 2 + tid]);
    __syncthreads();
}
DI void ssd_pass2(KA a, int L, int b, int c, int g, LAS unsigned char* lds, int tid, int wave, int lane) {
    OPQ(lane); OPQ(tid);
    LAS bf16* Cm = (LAS bf16*)lds; LAS bf16* Bm = (LAS bf16*)(lds + 34816); LAS bf16* XT = (LAS bf16*)(lds + 69632); LAS bf16* PV = (LAS bf16*)(lds + 104448);
    LAS float* dtv = (LAS float*)(lds + SSD_DT); LAS float* acs = (LAS float*)(lds + SSD_ACS);
    const bf16* PROJ = (const bf16*)(a->ws + WS_PROJ); const bf16* ST = (const bf16*)(a->ws + WS_ST); const float* CD = (const float*)(a->ws + WS_CD); bf16* MIX = (bf16*)(a->ws + WS_MIX);
    const int tok0 = b * SEQ + c * 128, r = lane & 31, lh = lane >> 5;
    v4u rawx[7], rawb[7], rawc[7];
    { const int cg = tid & 15, t0 = (tid >> 4) * 4; const bf16* rowp = PROJ + (size_t)(tok0 + t0) * PP + g * 128 + cg * 8; conv_load(rowp + C_XS, c * 128 + t0, rawx); conv_load(rowp + C_B, c * 128 + t0, rawb); conv_load(rowp + C_C, c * 128 + t0, rawc); }
    ssd_dt(a, L, g, tok0, lds, tid, nullptr);
    { const int cg = tid & 15, t0 = (tid >> 4) * 4, tpos0 = c * 128 + t0, ch = cg * 8; const bf16* rowp = PROJ + (size_t)(tok0 + t0) * PP;
      const float* cwb = a->in[I_CONVW] + (size_t)L * 768 * 4; const float* cbb = a->in[I_CONVB] + L * 768;
      float o[4][8];
      conv_apply(rawx, cwb + (g * 128 + ch) * 4, cbb + g * 128 + ch, o);
#pragma unroll
      for (int i = 0; i < 8; ++i) { u32x2 w; w.x = pk2(o[0][i], o[1][i]); w.y = pk2(o[2][i], o[3][i]); *(LAS u32x2*)(XT + swz136(ch + i, t0)) = w; }
      conv_apply(rawb, cwb + (256 + g * 128 + ch) * 4, cbb + 256 + g * 128 + ch, o);
#pragma unroll
      for (int k = 0; k < 4; ++k) *(LAS v4u*)(Bm + (t0 + k) * 136 + ch) = pack8(o[k]);
      conv_apply(rawc, cwb + (512 + g * 128 + ch) * 4, cbb + 512 + g * 128 + ch, o);
#pragma unroll
      for (int k = 0; k < 4; ++k) *(LAS v4u*)(Cm + (t0 + k) * 136 + ch) = pack8(o[k]); }
    {
      float pv[4][8];
#pragma unroll
      for (int i = 0; i < 4; ++i)
#pragma unroll
          for (int e = 0; e < 8; ++e) pv[i][e] = 0.f;
      const v4u* sp = (const v4u*)(ST + (size_t)((b * 16) * 4 + 2 * g) * 64 * 128) + tid; constexpr size_t cstride = (size_t)4 * 64 * 128 / 8;
      float w0 = 1.f, w1 = 1.f;
      for (int jt = c - 1; jt >= 0; jt -= 8) {
          v4u ld[8][4];
#pragma unroll
          for (int u = 0; u < 8; ++u) { const int jc = (jt - u >= 0) ? jt - u : 0;
#pragma unroll
              for (int i = 0; i < 4; ++i) ld[u][i] = sp[(size_t)jc * cstride + i * 512]; }
#pragma unroll
          for (int u = 0; u < 8; ++u) { const int jj = jt - u; const bool ok = jj >= 0; const float ww0 = ok ? w0 : 0.f, ww1 = ok ? w1 : 0.f;
#pragma unroll
              for (int i = 0; i < 4; ++i) { float f[8]; unpack8(ld[u][i], f); const float ww = i < 2 ? ww0 : ww1;
#pragma unroll
                  for (int e = 0; e < 8; ++e) pv[i][e] += ww * f[e]; }
              if (ok) { w0 *= CD[(b * 16 + jj) * 4 + 2 * g]; w1 *= CD[(b * 16 + jj) * 4 + 2 * g + 1]; } } }
#pragma unroll
      for (int i = 0; i < 4; ++i) *(LAS v4u*)(PV + (i * 32 + (tid >> 4)) * 136 + (tid & 15) * 8) = pack8(pv[i]); }
    __syncthreads();
    const int lt = wave >> 1, pt = wave & 1;
    f32x16 cb[2];
#pragma unroll
    for (int q = 0; q < 2; ++q) { const int st = (wave & 1) * 2 + q; cb[q] = (f32x16){}; if (st <= lt) cb[q] = mma_tile(Cm + lt * 32 * 136, 136, Bm + st * 32 * 136, 136, 128, cb[q], r, lh); }
    f32x16 y[2];
#pragma unroll
    for (int hh = 0; hh < 2; ++hh) {
        __syncthreads();
#pragma unroll
        for (int q = 0; q < 2; ++q) { const int s = ((wave & 1) * 2 + q) * 32 + r; const float as = acs[s * 2 + hh], ds = dtv[s * 2 + hh];
#pragma unroll
            for (int reg = 0; reg < 16; ++reg) { const int l = lt * 32 + crow(reg, lh); const float val = (s <= l) ? cb[q][reg] * __expf(acs[l * 2 + hh] - as) * ds : 0.f; Bm[l * 136 + s] = f2b(val); } }
        __syncthreads();
        f32x16 a1 = {}, a2 = {};
        a1 = mma_tile_sw<false, true>(Bm, lt * 32, XT, hh * 64 + pt * 32, 32 * (lt + 1), a1, r, lh);
        a2 = mma_tile(Cm + lt * 32 * 136, 136, PV + (hh * 64 + pt * 32) * 136, 136, 128, a2, r, lh);
        const int ch = hh * 64 + pt * 32 + r; const float Dh = a->in[I_SSMD][L * 4 + 2 * g + hh];
#pragma unroll
        for (int reg = 0; reg < 16; ++reg) { const int l = lt * 32 + crow(reg, lh); const float xsv = bf2f(XT[swz136(ch, l)]); const float zz = bf2f(PROJ[(size_t)(tok0 + l) * PP + C_Z + g * 128 + ch]);
            const float yv = a1[reg] + __expf(acs[l * 2 + hh]) * a2[reg] + Dh * xsv; y[hh][reg] = yv * silu_f(zz); }
    }
    __syncthreads();
    LAS float* ybuf = (LAS float*)lds;
#pragma unroll
    for (int hh = 0; hh < 2; ++hh)
#pragma unroll
        for (int reg = 0; reg < 16; ++reg) { const int l = lt * 32 + crow(reg, lh); ybuf[l * 129 + hh * 64 + pt * 32 + r] = y[hh][reg]; }
    __syncthreads();
    { const int t = tid >> 2, ch0 = (tid & 3) * 32; float v[32]; float ss = 0.f;
#pragma unroll
      for (int i = 0; i < 32; ++i) { v[i] = ybuf[t * 129 + ch0 + i]; ss += v[i] * v[i]; }
      ss += __shfl_xor(ss, 1); ss += __shfl_xor(ss, 2);
      const float rstd = 1.0f / sqrtf(ss * (1.0f / 128.0f) + EPS); const float* nw = a->in[I_SSMNW] + L * 256 + g * 128 + ch0;
#pragma unroll
      for (int i = 0; i < 32; ++i) v[i] = v[i] * rstd * nw[i];
      bf16* op = MIX + (size_t)(tok0 + t) * DM + 256 + g * 128 + ch0;
#pragma unroll
      for (int i = 0; i < 4; ++i) *(v4u*)(op + 8 * i) = pack8(v + 8 * i); }
    __syncthreads();
}
typedef float f32x2_t __attribute__((ext_vector_type(2))); typedef __bf16 bf16x2_t __attribute__((ext_vector_type(2)));
DI unsigned cvtpk(float lo, float hi) { f32x2_t v = {lo, hi}; bf16x2_t b = __builtin_convertvector(v, bf16x2_t); return __builtin_bit_cast(unsigned, b); }
DI float xhalf_sum(float v) { auto rr = __builtin_amdgcn_permlane32_swap(__float_as_uint(v), __float_as_uint(v), false, false); return __uint_as_float(rr[0]) + __uint_as_float(rr[1]); }
DI float xhalf_max(float v) { auto rr = __builtin_amdgcn_permlane32_swap(__float_as_uint(v), __float_as_uint(v), false, false); return fmaxf(__uint_as_float(rr[0]), __uint_as_float(rr[1])); }
constexpr int ATT_TPS = 4;
constexpr int ATT_KP = 144, ATT_VP = 64 * ATT_TPS + 8, ATT_VOFF = 32 * ATT_TPS * ATT_KP, ATT_BUF = ATT_VOFF + 64 * ATT_VP;
DI void attn_block(KA a, int L, int b, int h, int s8, LAS unsigned char* lds, int tid, int wave, int lane) {
    OPQ(lane); OPQ(tid);
    const bf16* PROJ = (const bf16*)(a->ws + WS_PROJ); const bf16* VT = (const bf16*)(a->ws + WS_VT); bf16* MIX = (bf16*)(a->ws + WS_MIX);
    const int r = lane & 31, lh = lane >> 5; const size_t tokb = (size_t)b * SEQ;
    const int cw = wave >> 2, jS = s8 * 4 + (wave & 3), jL = 63 - jS, st0 = (63 - s8 * 4) / ATT_TPS;
    float p1 = 0.f, p2 = 0.f;
#pragma unroll 8
    for (int i = 0; i < 32; ++i) { p1 += a->in[I_LQ1][L * 32 + i] * a->in[I_LK1][L * 32 + i]; p2 += a->in[I_LQ2][L * 32 + i] * a->in[I_LK2][L * 32 + i]; }
    const float lam_init = (L == 0) ? 0.2f : 0.35550906f;
    const float lam = __expf(p1) - __expf(p2) + lam_init;
    const float slope2 = exp2f(-2.0f * (float)(h + 1)) * LOG2E, tstep = 32.f * slope2;
    const bf16* gk = PROJ + (tokb + (tid >> 3)) * PP + C_K + h * 64 + (tid & 7) * 8;
    const bf16* gv = VT + (size_t)(h * 64 + (tid >> 4)) * M + tokb + (tid & 15) * 8;
    const int lk = (tid >> 3) * ATT_KP + (tid & 7) * 16, lv = ATT_VOFF + (tid >> 4) * ATT_VP + (tid & 15) * 16;
    v4u sk[ATT_TPS / 2], sv[ATT_TPS / 2];
#define ATT_GLOAD(st_) do { _Pragma("unroll") for (int i_ = 0; i_ < ATT_TPS / 2; ++i_) { sk[i_] = *(const v4u*)(gk + ((size_t)(st_) * 32 * ATT_TPS + 64 * i_) * PP); sv[i_] = *(const v4u*)(gv + (size_t)32 * i_ * M + (st_) * 32 * ATT_TPS); } } while (0)
#define ATT_STORE(buf_) do { LAS unsigned char* d_ = lds + (buf_) * ATT_BUF; _Pragma("unroll") for (int i_ = 0; i_ < ATT_TPS / 2; ++i_) { *(LAS v4u*)(d_ + lk + 64 * i_ * ATT_KP) = sk[i_]; \
        *(LAS u32x2*)(d_ + lv + 32 * i_ * ATT_VP) = (u32x2){sv[i_].x, sv[i_].y}; *(LAS u32x2*)(d_ + lv + 32 * i_ * ATT_VP + 8) = (u32x2){sv[i_].z, sv[i_].w}; } } while (0)
    bf16x8 qf[2][2];
#pragma unroll
    for (int jb = 0; jb < 2; ++jb) { const bf16* qp = PROJ + (tokb + (jb == 0 ? jL : jS) * 32 + r) * PP + C_Q + h * 64 + cw * 32 + 8 * lh;
#pragma unroll
        for (int s = 0; s < 2; ++s) qf[jb][s] = *(const bf16x8*)(qp + s * 16); }
    f32x16 cinit;
#pragma unroll
    for (int reg = 0; reg < 16; ++reg) cinit[reg] = slope2 * (float)crow(reg, lh);
    f32x16 o[2][2];
#pragma unroll
    for (int jb = 0; jb < 2; ++jb)
#pragma unroll
        for (int d = 0; d < 2; ++d) o[jb][d] = (f32x16){};
    float kwmax = 0.f;
#pragma unroll 8
    for (int i = 0; i < 32; ++i) kwmax = fmaxf(kwmax, fabsf(a->in[I_KNW][L * 32 + i]));
    const float knorm = 5.65685425f * 1.01f * kwmax;
    float mref[2], lrun[2] = {0.f, 0.f};
#pragma unroll
    for (int jb = 0; jb < 2; ++jb) { float qs = 0.f;
#pragma unroll
        for (int s2 = 0; s2 < 2; ++s2)
#pragma unroll
            for (int e = 0; e < 8; ++e) { const float qv = bf2f((bf16)qf[jb][s2][e]); qs += qv * qv; }
        qs = xhalf_sum(qs); mref[jb] = sqrtf(qs) * knorm + 31.f * slope2; }
    ATT_GLOAD(st0);
    ATT_STORE(0);
    __syncthreads();
    int cur = 0;
    const int koff = r * ATT_KP + 16 * lh + cw * 64, voff = ATT_VOFF + r * ATT_VP + 8 * lh;
    for (int st = st0; st >= 0; --st) {
        if (st > 0) ATT_GLOAD(st - 1);
#pragma unroll 1
        for (int tl = ATT_TPS - 1; tl >= 0; --tl) {
            const int kt = st * ATT_TPS + tl;
            int act = (kt <= jL) ? 1 : 0; asm volatile("" : "+v"(act)); act = __builtin_amdgcn_readfirstlane(act);
            if (act) {
                const LAS unsigned char* kb = lds + cur * ATT_BUF + koff + tl * 32 * ATT_KP; const LAS unsigned char* vb = lds + cur * ATT_BUF + voff + tl * 64;
                const bf16x8 k0 = *(const LAS bf16x8*)kb, k1 = *(const LAS bf16x8*)(kb + 32);
                u32x2 vlo[2][2], vhi[2][2];
#pragma unroll
                for (int d = 0; d < 2; ++d)
#pragma unroll
                    for (int s = 0; s < 2; ++s) { vlo[d][s] = *(const LAS u32x2*)(vb + d * 32 * ATT_VP + 32 * s); vhi[d][s] = *(const LAS u32x2*)(vb + d * 32 * ATT_VP + 32 * s + 16); }
#pragma unroll
                for (int jb = 0; jb < 2; ++jb) {
                    const int jq = (jb == 0) ? jL : jS;
                    int on = (kt <= jq) ? 1 : 0; asm volatile("" : "+v"(on)); on = __builtin_amdgcn_readfirstlane(on);
                    if (on) {
                        int isdiag = (kt == jq) ? 1 : 0; asm volatile("" : "+v"(isdiag)); isdiag = __builtin_amdgcn_readfirstlane(isdiag);
                        f32x16 S = MFMA32(k0, qf[jb][0], cinit); S = MFMA32(k1, qf[jb][1], S);
                        if (isdiag) {
#pragma unroll
                            for (int reg = 0; reg < 16; ++reg) S[reg] = crow(reg, lh) > r ? -INFINITY : S[reg];
                        }
                        const float sh = tstep * (float)(kt - jq) - mref[jb];
                        float rs4[4] = {0.f, 0.f, 0.f, 0.f};
#pragma unroll
                        for (int reg = 0; reg < 16; ++reg) { S[reg] = __builtin_amdgcn_exp2f(S[reg] + sh); rs4[reg & 3] += S[reg]; }
                        lrun[jb] += (rs4[0] + rs4[1]) + (rs4[2] + rs4[3]);
                        u32x4 w0, w1;
                        w0.x = cvtpk(S[0], S[1]); w0.y = cvtpk(S[2], S[3]); w0.z = cvtpk(S[4], S[5]); w0.w = cvtpk(S[6], S[7]);
                        w1.x = cvtpk(S[8], S[9]); w1.y = cvtpk(S[10], S[11]); w1.z = cvtpk(S[12], S[13]); w1.w = cvtpk(S[14], S[15]);
                        const bf16x8 pb0 = __builtin_bit_cast(bf16x8, w0), pb1 = __builtin_bit_cast(bf16x8, w1);
#pragma unroll
                        for (int d = 0; d < 2; ++d) {
                            const u32x4 v0 = (u32x4){vlo[d][0].x, vlo[d][0].y, vhi[d][0].x, vhi[d][0].y}, v1 = (u32x4){vlo[d][1].x, vlo[d][1].y, vhi[d][1].x, vhi[d][1].y};
                            o[jb][d] = MFMA32(__builtin_bit_cast(bf16x8, v0), pb0, o[jb][d]);
                            o[jb][d] = MFMA32(__builtin_bit_cast(bf16x8, v1), pb1, o[jb][d]);
                        }
                    }
                }
            }
        }
        if (st > 0) ATT_STORE(cur ^ 1);
        __syncthreads();
        cur ^= 1;
    }
#undef ATT_GLOAD
#undef ATT_STORE
    lrun[0] = xhalf_sum(lrun[0]); lrun[1] = xhalf_sum(lrun[1]);
    const int give = (cw == 0) ? 1 : 0, keep = 1 - give;
    LAS float* xw = (LAS float*)lds + (size_t)wave * 2048;
    LAS const float* xr = (LAS const float*)lds + (size_t)(wave ^ 4) * 2048;
    { const float sc = (cw == 0 ? 1.0f : lam) / (give == 0 ? lrun[0] : lrun[1]);
#pragma unroll
      for (int d = 0; d < 2; ++d)
#pragma unroll
          for (int reg = 0; reg < 16; ++reg) xw[(d * 16 + reg) * 64 + lane] = (give == 0 ? o[0][d][reg] : o[1][d][reg]) * sc; }
    __syncthreads();
    { const float sck = (cw == 0 ? 1.0f : lam) / (keep == 0 ? lrun[0] : lrun[1]); const float sgn = (cw == 0) ? 1.0f : -1.0f;
      f32x16 v[2]; float ss = 0.f;
#pragma unroll
      for (int d = 0; d < 2; ++d)
#pragma unroll
          for (int reg = 0; reg < 16; ++reg) { const float mine = (keep == 0 ? o[0][d][reg] : o[1][d][reg]) * sck, other = xr[(d * 16 + reg) * 64 + lane]; const float val = sgn * (mine - other); v[d][reg] = val; ss += val * val; }
      ss = xhalf_sum(ss);
      const float rstd = (1.0f - lam_init) / sqrtf(ss * (1.0f / 64.0f) + EPS);
      const int jq = (keep == 0) ? jL : jS;
      bf16* op = MIX + (tokb + jq * 32 + r) * DM + 768 + h * 64;
#pragma unroll
      for (int d = 0; d < 2; ++d)
#pragma unroll
          for (int g4 = 0; g4 < 4; ++g4) { const int d0 = d * 32 + 8 * g4 + 4 * lh; const f32x4 w4 = *(const f32x4*)(a->in[I_SUBLN] + L * 64 + d0);
              u32x2 pk; pk.x = cvtpk(v[d][4 * g4] * rstd * w4.x, v[d][4 * g4 + 1] * rstd * w4.y); pk.y = cvtpk(v[d][4 * g4 + 2] * rstd * w4.z, v[d][4 * g4 + 3] * rstd * w4.w);
              *(u32x2*)(op + d0) = pk; } }
    __syncthreads();
}

#ifndef DIS_SSD1
#define DIS_SSD1 0
#endif
#ifndef DIS_SSD2
#define DIS_SSD2 0
#endif
#ifndef DIS_GMLP
#define DIS_GMLP 0
#endif
#ifndef DIS_POOL
#define DIS_POOL 0
#endif
#ifndef DIS_ATTN
#define DIS_ATTN 0
#endif
#ifndef DIS_GEMM
#define DIS_GEMM 0
#endif
#ifndef REP_P0
#define REP_P0 1
#endif
#ifndef REP_M1
#define REP_M1 1
#endif
#ifndef REP_SSD2
#define REP_SSD2 1
#endif
#ifndef REP_ATTN
#define REP_ATTN 1
#endif
#ifndef REP_N2
#define REP_N2 1
#endif
#ifndef REP_BAR
#define REP_BAR 1
#endif
#ifndef REP_G1
#define REP_G1 1
#endif
#ifndef REP_G3
#define REP_G3 1
#endif
#ifndef MK_SPLIT
#define MK_SPLIT 0
#endif
constexpr int N_PHASES = 13;
__global__ void __launch_bounds__(NWAVES * 64, 2) hybrid_fwd(Args args) {
    extern __shared__ __attribute__((aligned(16))) unsigned char lds_raw[];
    LAS unsigned char* lds = (LAS unsigned char*)lds_raw;
    const int tid = threadIdx.x, lane = tid & 63, wave = __builtin_amdgcn_readfirstlane(tid >> 6);
    const int G = gridDim.x; const int bx = blockIdx.x; const int vcu = (G % 8 == 0) ? (bx % 8) * (G / 8) + bx / 8 : bx;
    for (int u = tid; u < (LDS_BYTES - LDSCTL_OFF) / 4; u += NWAVES * 64) ((LAS unsigned*)(lds + LDSCTL_OFF))[u] = 0u;
    __syncthreads();
    int lo, hi;
    XcdBarrier bar;
    { KA ka = kargs(); lo = ka->ph_lo; hi = ka->ph_hi; gu32* ctl = (gu32*)(ka->ws + WS_CTL);
      bar.bar = (unsigned*)(ctl + CW_BAR); bar.x = 0; bar.st = nullptr;
      if (!MK_SPLIT) bar = xcd_barrier_post((unsigned*)(ctl + CW_BAR), (volatile LAS unsigned*)(lds + MISC_OFF) + 8); }
#define IN(k) (lo <= (k) && (k) < hi)
#define SEAM(k) do { if (IN(k) && IN((k) + 1)) for (int rb_ = 0; rb_ < REP_BAR; ++rb_) xcd_barrier(bar); } while (0)
    if (IN(0)) { KA ka = kargs(); for (int rep = 0; rep < REP_P0; ++rep) { weights_phase(ka, lds, 0, 0, WI_INP, vcu * NWAVES + wave, G * NWAVES, wave, lane); __syncthreads(); }
        prep_phase(ka->in[I_X], (bf16*)(ka->ws + WS_XN), (float*)(ka->ws + WS_RS), vcu, G, wave, lane); }
    SEAM(0);
#pragma unroll 1
    for (int L = 0; L < DEPTH; ++L) {
        const int pb = 1 + 6 * L;
        if (IN(pb)) { KA ka = kargs(); unsigned char* ws = ka->ws; const bf16* wb = (const bf16*)(ws + WS_W + (size_t)L * W_LAYER + W_IN); const bf16* XB = (const bf16*)(ws + WS_XN);
            const float* rs = (const float*)(ws + WS_RS) + (size_t)(2 * L) * RS_STRIDE;
            for (int rep = 0; rep < REP_G1; ++rep) {
            { pg8::Gemm g{XB, wb, M, PP, DM}; pg8::StaticOrder S; S.init(M, PP, G, bx);
              pg8::EpiInProj E{(bf16*)(ws + WS_PROJ), ka->in[I_QNW] + L * 32, ka->in[I_KNW] + L * 32, rs};
              pg8::gemm_phase<pg8::EpiInProj, pg8::StaticOrder, true, true>(lds, g, S, E); }
            { pg8::Gemm g{wb + (size_t)PP * DM, XB, 256, M, DM}; pg8::StaticOrder S; S.init(256, M, G, (bx + 192) % G);
              pg8::EpiVT E{(bf16*)(ws + WS_VT), rs};
              pg8::gemm_phase<pg8::EpiVT, pg8::StaticOrder, true, true>(lds, g, S, E); }
            }
            { const int nidle = G - G / 2; if (bx >= G / 2) weights_phase(ka, lds, L, WI_INP, WI_INP + WI_OUT + 2 * WI_G, (bx - G / 2) * NWAVES + wave, nidle * NWAVES, wave, lane); __syncthreads(); }
        }
        SEAM(pb);
        if (IN(pb + 1)) { KA ka = kargs();
            __syncthreads();
            for (int rep = 0; rep < REP_M1; ++rep) {
            if (!DIS_SSD1) for (int it = vcu; it < 256; it += G) ssd_pass1(ka, L, it >> 5, (it >> 1) & 15, it & 1, lds, tid, wave, lane);
            if (!DIS_GMLP) for (int it = vcu; it < 512; it += 2 * G) { if (it + G < 512) gmlp_pair(ka, L, it, it + G, lds, tid, wave, lane); else gmlp_item(ka, L, it >> 6, (it >> 2) & 15, it & 3, lds, tid, wave, lane); }
            if (!DIS_POOL) for (int it = vcu; it < 512; it += 2 * G) { if (it + G < 512) pool_pair(ka, L, it, it + G, lds, tid, wave, lane); else pool_item(ka, L, it >> 6, (it >> 2) & 15, it & 3, lds, tid, wave, lane); }
            }
        }
        SEAM(pb + 1);
        if (IN(pb + 2)) { KA ka = kargs();
            __syncthreads();
            for (int rep = 0; rep < REP_SSD2; ++rep)
            if (!DIS_SSD2) for (int it = vcu; it < 256; it += G) ssd_pass2(ka, L, it >> 5, (it >> 1) & 15, it & 1, lds, tid, wave, lane);
            for (int rep = 0; rep < REP_ATTN; ++rep)
            if (!DIS_ATTN) for (int it = vcu; it < 256; it += G) attn_block(ka, L, it >> 5, (it >> 3) & 3, it & 7, lds, tid, wave, lane);
        }
        SEAM(pb + 2);
        if (IN(pb + 3)) { KA ka = kargs(); unsigned char* ws = ka->ws;
            pg8::Gemm g{(const bf16*)(ws + WS_MIX), (const bf16*)(ws + WS_W + (size_t)L * W_LAYER + W_OUT), M, DM, DM}; pg8::StaticOrder S; S.init(M, DM, G, bx);
            pg8::EpiResid E{(const float*)nullptr, (const bf16*)(ws + WS_XN), (float*)nullptr, (bf16*)(ws + WS_XN), (float*)(ws + WS_RS) + (size_t)(2 * L + 1) * RS_STRIDE};
            pg8::gemm_phase<pg8::EpiResid, pg8::StaticOrder, true, true>(lds, g, S, E); }
        SEAM(pb + 3);
        if (IN(pb + 4)) for (int rep = 0; rep < REP_G3; ++rep) { KA ka = kargs(); unsigned char* ws = ka->ws;
            pg8::Gemm g{(const bf16*)(ws + WS_XN), (const bf16*)(ws + WS_W + (size_t)L * W_LAYER + W_GU), M, NGU, DM}; pg8::StaticOrder S; S.init(M, NGU, G, bx);
            pg8::EpiSwiGLU E{(bf16*)(ws + WS_H), (const float*)(ws + WS_RS) + (size_t)(2 * L + 1) * RS_STRIDE};
            pg8::gemm_phase<pg8::EpiSwiGLU, pg8::StaticOrder, true, true>(lds, g, S, E);
            { const int nidle = G - G / 2; if (bx >= G / 2) { weights_phase(ka, lds, L, WI_PER_L - WI_D, WI_PER_L, (bx - G / 2) * NWAVES + wave, nidle * NWAVES, wave, lane);
                if (L + 1 < DEPTH) weights_phase(ka, lds, L + 1, 0, WI_INP, (bx - G / 2) * NWAVES + wave, nidle * NWAVES, wave, lane); } __syncthreads(); } }
        SEAM(pb + 4);
        if (IN(pb + 5)) { KA ka = kargs(); unsigned char* ws = ka->ws; const bool more = (L + 1 < DEPTH);
            pg8::Gemm g{(const bf16*)(ws + WS_H), (const bf16*)(ws + WS_W + (size_t)L * W_LAYER + W_DN), M, DM, DFF}; pg8::StaticOrder S; S.init(M, DM, G, bx);
            pg8::EpiResid E{(const float*)nullptr, (const bf16*)(ws + WS_XN), more ? (float*)nullptr : ka->out, more ? (bf16*)(ws + WS_XN) : (bf16*)nullptr, more ? (float*)(ws + WS_RS) + (size_t)(2 * L + 2) * RS_STRIDE : (float*)nullptr};
            pg8::gemm_phase<pg8::EpiResid, pg8::StaticOrder, true, true>(lds, g, S, E); }
        if (L + 1 < DEPTH) SEAM(pb + 5);
    }
#undef IN
#undef SEAM
}

extern "C" void kernel_launch(void* const* d_in, const int* in_sizes, int n_in, void* d_out, int out_size, void* d_ws, size_t ws_size, hipStream_t stream) {
    static int grid = 0;
    if (grid == 0) {
        if (n_in != N_IN || in_sizes[0] != M * DM || out_size != M * DM || ws_size < WS_END) { fprintf(stderr, "kernel_launch: unexpected problem shape (n_in %d, in0 %d, out %d, ws %zu); nothing launched\n", n_in, n_in > 0 ? in_sizes[0] : -1, out_size, ws_size); grid = -1; return; }
        int dev = 0, cus = 0;
        if (hipGetDevice(&dev) != hipSuccess || hipDeviceGetAttribute(&cus, hipDeviceAttributeMultiprocessorCount, dev) != hipSuccess) { grid = -1; return; }
        if (hipFuncSetAttribute((const void*)hybrid_fwd, hipFuncAttributeMaxDynamicSharedMemorySize, LDS_BYTES) != hipSuccess) { fprintf(stderr, "kernel_launch: hipFuncSetAttribute failed\n"); grid = -1; return; }
        int per_cu = 0;
        if (hipOccupancyMaxActiveBlocksPerMultiprocessor(&per_cu, (const void*)hybrid_fwd, NWAVES * 64, LDS_BYTES) != hipSuccess || per_cu < 1) fprintf(stderr, "kernel_launch: occupancy query reports %d\n", per_cu);
        (void)hipGetLastError();
        grid = cus;
    }
    if (grid < 0) return;
    (void)hipMemsetAsync((char*)d_ws + WS_CTL, 0, CTL_ZERO_BYTES, stream);
    Args a{};
    for (int i = 0; i < N_IN; ++i) a.in[i] = (const float*)d_in[i];
    a.out = (float*)d_out; a.ws = (unsigned char*)d_ws;
#if MK_SPLIT
    for (int p = 0; p < N_PHASES; ++p) { a.ph_lo = p; a.ph_hi = p + 1; hipLaunchKernelGGL(hybrid_fwd, dim3(grid), dim3(NWAVES * 64), LDS_BYTES, stream, a); }
#else
    a.ph_lo = 0; a.ph_hi = N_PHASES;
    hipLaunchKernelGGL(hybrid_fwd, dim3(grid), dim3(NWAVES * 64), LDS_BYTES, stream, a);
#endif
}
```

```cpp
#include <hip/hip_runtime.h>
#include <cstdio>
#include <cstdint>
#include <cmath>
namespace pg8 {
#define PG8_LAS __attribute__((address_space(3)))
typedef unsigned short bf16_t;
typedef short bf16x8 __attribute__((ext_vector_type(8)));
typedef float f32x4 __attribute__((ext_vector_type(4)));
typedef unsigned u32x4 __attribute__((ext_vector_type(4)));
constexpr int BM = 256, BK = 64, HALF = 128, HTB = HALF * BK * 2  , STAGE_BYTES = 8 * HTB, NXCD = 8, WGM = 8;

__host__ __device__ __forceinline__ int lds_byte(int r, int c) { const int st = (r >> 4) * 2 + (c >> 5), rr = r & 15, cc = c & 31, ob = rr * 64 + cc * 2; return st * 1024 + (ob ^ (((ob >> 9) & 1) << 5)); }
__host__ __device__ __forceinline__ void stage_rc(int b, int& R, int& C) { const int st = b / 1024, sb = b % 1024, swz = sb ^ (((sb >> 9) & 1) << 5); R = (st >> 1) * 16 + swz / 64; C = (st & 1) * 32 + (swz % 64) / 2; }
__host__ __device__ __forceinline__ int perm32(int rho) { const int n = rho >> 4, i = rho & 15; return 8 * (i >> 2) + 4 * n + (i & 3); }

struct Unit { int pm, pn; };
struct Gemm { const bf16_t* A; const bf16_t* Bt; int M, N, K; };

struct StaticOrder {
    int nM, nN, nwg, G, c;
    __host__ __device__ void init(int M, int N, int G_, int c_) { nM = M / BM; nN = N / BM; nwg = nM * nN; G = G_; c = c_; }
    __host__ __device__ bool next(int i, Unit& u) const {
        const long L = (long)i * G + c; if (L >= nwg) return false;
        int wgid = (int)L; { const int q = nwg / NXCD, r = nwg % NXCD, xcd = wgid % NXCD, off = wgid / NXCD; wgid = (xcd < r ? xcd * (q + 1) : r * (q + 1) + (xcd - r) * q) + off; }
        const int nig = WGM * nN, gid = wgid / nig, fm = gid * WGM, gsz = (nM - fm) < WGM ? (nM - fm) : WGM;
        u.pm = fm + ((wgid % nig) % gsz); u.pn = (wgid % nig) / gsz; return true;
    }
    __device__ __forceinline__ void a_ready(const Unit&) const {}
    __device__ __forceinline__ void done(const Unit&) const {}
};

__device__ __forceinline__ unsigned cvt_pk_bf16(float lo, float hi) { unsigned r; asm volatile("v_cvt_pk_bf16_f32 %0, %1, %2" : "=v"(r) : "v"(lo), "v"(hi)); return r; }
typedef float f32x2 __attribute__((ext_vector_type(2)));
__device__ __forceinline__ f32x2 gelu_pk(f32x2 v) {
    const f32x2 av = __builtin_elementwise_abs(v), d = av * 0.2316418882f + 1.0f;
    f32x2 t; t.x = __builtin_amdgcn_rcpf(d.x); t.y = __builtin_amdgcn_rcpf(d.y);
    f32x2 q = t * 0.5307027145f + (-0.7265760135f); q = q * t + 0.7107068705f; q = q * t + (-0.142248368f); q = q * t + 0.127414796f; q = q * t;
    const f32x2 s = (v * v) * (-0.72134752044f);
    f32x2 e; e.x = __builtin_amdgcn_exp2f(s.x); e.y = __builtin_amdgcn_exp2f(s.y);
    const f32x2 m = v * (q * e), r = v - m;
    f32x2 o; o.x = v.x < 0.f ? m.x : r.x; o.y = v.y < 0.f ? m.y : r.y; return o;
}

template <int ACT  > struct EpiBf16 {
    static constexpr bool PERM = true, AFTER_DRAIN = false; static_assert(ACT == 0 || ACT == 1, "EpiBf16: ACT is 0 (none) or 1 (gelu_pk)");
    bf16_t* O; int ldc; const float* bias; int split_cols; size_t split_stride; float scale0;
    __device__ __forceinline__ void operator()(const f32x4 (&acc)[2][2][4][2], const Unit& u, int wr, int wc, int fr, int fq) const {
        const int row0 = u.pm * BM + wr * 64 + fr; int colt = u.pn * BM; bf16_t* base = O;
        float sc = 1.f; if (split_cols) { const int t = colt / split_cols; base += (size_t)t * split_stride; colt -= t * split_cols; if (t == 0) sc = scale0; }
        const int col0 = colt + wc * 32 + 8 * fq, bcol0 = u.pn * BM + wc * 32 + 8 * fq;
        f32x4 bv[2][2];
#pragma unroll
        for (int bj = 0; bj < 2; ++bj)
#pragma unroll
            for (int n = 0; n < 2; ++n) bv[bj][n] = bias ? *(const f32x4*)(bias + bcol0 + bj * HALF + 4 * n) : (f32x4){0.f, 0.f, 0.f, 0.f};
#pragma unroll
        for (int ai = 0; ai < 2; ++ai)
#pragma unroll
            for (int m = 0; m < 4; ++m) { bf16_t* rowp = base + (size_t)(row0 + ai * HALF + m * 16) * ldc + col0;
#pragma unroll
                for (int bj = 0; bj < 2; ++bj) { f32x4 v0 = acc[ai][bj][m][0] + bv[bj][0], v1 = acc[ai][bj][m][1] + bv[bj][1];
                    if (ACT == 1) { f32x2 a = gelu_pk((f32x2){v0[0], v0[1]}), b = gelu_pk((f32x2){v0[2], v0[3]}), c = gelu_pk((f32x2){v1[0], v1[1]}), d = gelu_pk((f32x2){v1[2], v1[3]});
                        v0 = (f32x4){a.x, a.y, b.x, b.y}; v1 = (f32x4){c.x, c.y, d.x, d.y}; }
                    v0 = v0 * sc; v1 = v1 * sc; u32x4 w; w.x = cvt_pk_bf16(v0[0], v0[1]); w.y = cvt_pk_bf16(v0[2], v0[3]); w.z = cvt_pk_bf16(v1[0], v1[1]); w.w = cvt_pk_bf16(v1[2], v1[3]);
                    *(u32x4*)(rowp + bj * HALF) = w; } }
    }
};
template <class Epi, class Sched, bool ALIGN_EPI = false, bool SP2 = false>
__device__ __forceinline__ void gemm_phase(PG8_LAS unsigned char* lds, const Gemm g, const Sched& S, const Epi& E) {
    int tid_ = threadIdx.x; asm volatile("" : "+v"(tid_));
    const int tid = tid_, wid = __builtin_amdgcn_readfirstlane(tid >> 6), lane = tid & 63, wr = wid >> 2, wc = wid & 3, fr = lane & 15, fq = lane >> 4;
    const int K = g.K, nt = K / BK;
    unsigned voffA[2], voffB[2];
#pragma unroll
    for (int i = 0; i < 2; ++i) { int R, C; stage_rc(tid * 16 + i * 8192, R, C); const int Rb = Epi::PERM ? ((R & ~31) + perm32(R & 31)) : R;
        voffA[i] = (unsigned)(R * K + C) * 2u; voffB[i] = (unsigned)(Rb * K + C) * 2u; }
    const size_t kstep = (size_t)(BK * 2);
    const size_t hstep = (size_t)HALF * K * 2;
    const size_t tstep = 2 * hstep;
    const unsigned ldsw = (unsigned)wid * 1024u;
    const int aoff = lds_byte(wr * 64 + fr, fq * 8), boff = lds_byte(wc * 32 + fr, fq * 8);
#define PG8_SA(b, h) (((b) * 2 + (h)) * HTB)
#define PG8_SB(b, h) ((4 + (b) * 2 + (h)) * HTB)
#define PG8_STAGE(bufoff, gbase, voff) do { _Pragma("unroll") for (int _i = 0; _i < 2; ++_i) \
        __builtin_amdgcn_global_load_lds((const unsigned*)((const char*)(gbase) + (voff)[_i]), (PG8_LAS unsigned*)(lds + (bufoff) + ldsw + _i * 8192), 16, 0, 0); } while (0)
#define PG8_LDA(dst, b, h) do { _Pragma("unroll") for (int m = 0; m < 4; ++m) _Pragma("unroll") for (int k = 0; k < 2; ++k) dst[m][k] = *(const PG8_LAS bf16x8*)(lds + PG8_SA(b, h) + aoff + m * 2048 + k * 1024); } while (0)
#define PG8_LDB(dst, b, h) do { _Pragma("unroll") for (int n = 0; n < 2; ++n) _Pragma("unroll") for (int k = 0; k < 2; ++k) dst[n][k] = *(const PG8_LAS bf16x8*)(lds + PG8_SB(b, h) + boff + n * 2048 + k * 1024); } while (0)
#define PG8_MMA(ai, bj, At, Bt) do { __builtin_amdgcn_s_setprio(1); _Pragma("unroll") for (int m = 0; m < 4; ++m) _Pragma("unroll") for (int n = 0; n < 2; ++n) _Pragma("unroll") for (int k = 0; k < 2; ++k) \
        acc[ai][bj][m][n] = __builtin_amdgcn_mfma_f32_16x16x32_bf16(Bt[n][k], At[m][k], acc[ai][bj][m][n], 0, 0, 0); __builtin_amdgcn_s_setprio(0); } while (0)
#define PG8_WAIT_V(n) asm volatile("s_waitcnt vmcnt(" #n ")" ::: "memory")
#define PG8_WAIT_L(n) asm volatile("s_waitcnt lgkmcnt(" #n ")" ::: "memory")
#define PG8_BAR __builtin_amdgcn_s_barrier()
#define PG8_SCHED __builtin_amdgcn_sched_barrier(0)
    Unit cur, nxt; int ui = 0;
    if (!S.next(0, cur)) return;
    f32x4 acc[2][2][4][2];
#pragma unroll
    for (int a = 0; a < 2; ++a)
#pragma unroll
        for (int b = 0; b < 2; ++b)
#pragma unroll
            for (int m = 0; m < 4; ++m)
#pragma unroll
                for (int n = 0; n < 2; ++n) acc[a][b][m][n] = (f32x4){0.f, 0.f, 0.f, 0.f};
    bf16x8 At[4][2], B0[2][2], B1[2][2];
    const char* cA = (const char*)g.A + (size_t)cur.pm * tstep; const char* cB = (const char*)g.Bt + (size_t)cur.pn * tstep;
    S.a_ready(cur);
    if constexpr (SP2) {
        PG8_STAGE(PG8_SB(0, 0), cB, voffB); PG8_STAGE(PG8_SB(0, 1), cB + hstep, voffB); PG8_STAGE(PG8_SA(0, 0), cA, voffA); PG8_STAGE(PG8_SA(0, 1), cA + hstep, voffA);
        if (wr == 1) PG8_BAR;
        PG8_WAIT_V(2); PG8_BAR;
        PG8_STAGE(PG8_SB(1, 0), cB + kstep, voffB); PG8_STAGE(PG8_SA(1, 0), cA + kstep, voffA); PG8_STAGE(PG8_SB(1, 1), cB + hstep + kstep, voffB);
        PG8_WAIT_V(6); PG8_BAR;
    } else {
        PG8_STAGE(PG8_SB(0, 0), cB, voffB); PG8_STAGE(PG8_SA(0, 0), cA, voffA); PG8_STAGE(PG8_SB(0, 1), cB + hstep, voffB); PG8_STAGE(PG8_SA(0, 1), cA + hstep, voffA);
        if (wr == 1) PG8_BAR;
        PG8_WAIT_V(4); PG8_BAR;
        PG8_STAGE(PG8_SB(1, 0), cB + kstep, voffB); PG8_STAGE(PG8_SA(1, 0), cA + kstep, voffA); PG8_STAGE(PG8_SB(1, 1), cB + hstep + kstep, voffB);
        PG8_WAIT_V(6); PG8_BAR;
    }
    for (;;) {
        const bool has_next = S.next(ui + 1, nxt);
        const char* nA = has_next ? (const char*)g.A + (size_t)nxt.pm * tstep : cA; const char* nB = has_next ? (const char*)g.Bt + (size_t)nxt.pn * tstep : cB;
        for (int t = 0; t < nt; t += 2) {
            const bool last = (t == nt - 2);
            const char* a1 = cA + (size_t)(t + 1) * kstep;
            const char* a2 = last ? nA : cA + (size_t)(t + 2) * kstep; const char* b2 = last ? nB : cB + (size_t)(t + 2) * kstep;
            const char* a3 = a2 + kstep; const char* b3 = b2 + kstep;
            if (last && has_next) S.a_ready(nxt);
            if constexpr (SP2) {
            PG8_LDB(B0, 0, 0); PG8_LDB(B1, 0, 1); PG8_SCHED; PG8_LDA(At, 0, 0); PG8_STAGE(PG8_SA(1, 1), a1 + hstep, voffA);
            PG8_WAIT_V(8); PG8_WAIT_L(0); PG8_BAR; PG8_MMA(0, 0, At, B0); PG8_MMA(0, 1, At, B1); PG8_BAR; PG8_SCHED;
            PG8_LDA(At, 0, 1); PG8_STAGE(PG8_SB(0, 0), b2, voffB); PG8_STAGE(PG8_SB(0, 1), b2 + hstep, voffB); PG8_STAGE(PG8_SA(0, 0), a2, voffA);
            PG8_WAIT_V(8); PG8_WAIT_L(0); PG8_BAR; PG8_MMA(1, 0, At, B0); PG8_MMA(1, 1, At, B1); PG8_BAR; PG8_SCHED;
            PG8_LDB(B0, 1, 0); PG8_LDB(B1, 1, 1); PG8_SCHED; PG8_LDA(At, 1, 0); PG8_STAGE(PG8_SA(0, 1), a2 + hstep, voffA);
            PG8_WAIT_V(8); PG8_WAIT_L(0); PG8_BAR; PG8_MMA(0, 0, At, B0); PG8_MMA(0, 1, At, B1); PG8_BAR; PG8_SCHED;
            PG8_LDA(At, 1, 1); PG8_STAGE(PG8_SB(1, 0), b3, voffB); PG8_STAGE(PG8_SB(1, 1), b3 + hstep, voffB); PG8_STAGE(PG8_SA(1, 0), a3, voffA);
            PG8_WAIT_V(8); PG8_WAIT_L(0); PG8_BAR; PG8_MMA(1, 0, At, B0); PG8_MMA(1, 1, At, B1); PG8_BAR; PG8_SCHED;
            } else {
            PG8_LDB(B0, 0, 0); PG8_SCHED; PG8_LDA(At, 0, 0); PG8_STAGE(PG8_SA(1, 1), a1 + hstep, voffA);
            PG8_WAIT_L(8); PG8_BAR; PG8_WAIT_L(0); PG8_MMA(0, 0, At, B0); PG8_BAR; PG8_SCHED;
            PG8_LDB(B1, 0, 1); PG8_STAGE(PG8_SB(0, 0), b2, voffB);
            PG8_BAR; PG8_WAIT_L(0); PG8_MMA(0, 1, At, B1); PG8_BAR;
            PG8_LDA(At, 0, 1); PG8_STAGE(PG8_SA(0, 0), a2, voffA);
            PG8_BAR; PG8_WAIT_L(0); PG8_MMA(1, 0, At, B0); PG8_BAR; PG8_SCHED;
            PG8_STAGE(PG8_SB(0, 1), b2 + hstep, voffB);
            PG8_WAIT_V(6); PG8_BAR; PG8_MMA(1, 1, At, B1); PG8_BAR;
            PG8_LDB(B0, 1, 0); PG8_SCHED; PG8_LDA(At, 1, 0); PG8_STAGE(PG8_SA(0, 1), a2 + hstep, voffA);
            PG8_WAIT_L(8); PG8_BAR; PG8_WAIT_L(0); PG8_MMA(0, 0, At, B0); PG8_BAR; PG8_SCHED;
            PG8_LDB(B1, 1, 1); PG8_STAGE(PG8_SB(1, 0), b3, voffB);
            PG8_BAR; PG8_WAIT_L(0); PG8_MMA(0, 1, At, B1); PG8_BAR;
            PG8_LDA(At, 1, 1); PG8_STAGE(PG8_SA(1, 0), a3, voffA);
            PG8_BAR; PG8_WAIT_L(0); PG8_MMA(1, 0, At, B0); PG8_BAR; PG8_SCHED;
            PG8_STAGE(PG8_SB(1, 1), b3 + hstep, voffB);
            PG8_WAIT_V(6); PG8_BAR; PG8_MMA(1, 1, At, B1); PG8_BAR;
            }
        }
        if constexpr (ALIGN_EPI) { if (wr == 0) PG8_BAR; }
        if constexpr (!Epi::AFTER_DRAIN) { E(acc, cur, wr, wc, fr, fq); S.done(cur); }
        if (!has_next) break;
#pragma unroll
        for (int a = 0; a < 2; ++a)
#pragma unroll
            for (int b = 0; b < 2; ++b)
#pragma unroll
                for (int m = 0; m < 4; ++m)
#pragma unroll
                    for (int n = 0; n < 2; ++n) acc[a][b][m][n] = (f32x4){0.f, 0.f, 0.f, 0.f};
        cur = nxt; cA = nA; cB = nB; ++ui;
        if constexpr (ALIGN_EPI) { if (wr == 1) PG8_BAR; }
    }
    PG8_WAIT_V(0);
    if constexpr (!ALIGN_EPI) { if (wr == 0) PG8_BAR; }
    PG8_BAR;
    if constexpr (Epi::AFTER_DRAIN) { E.fused(acc, cur, wr, wc, fr, fq, lds, wid, lane); S.done(cur); }
#undef PG8_SA
#undef PG8_SB
#undef PG8_STAGE
#undef PG8_LDA
#undef PG8_LDB
#undef PG8_MMA
#undef PG8_WAIT_V
#undef PG8_WAIT_L
#undef PG8_BAR
#undef PG8_SCHED
}
}
#define GAS __attribute__((address_space(1)))
#define LAS __attribute__((address_space(3)))
typedef unsigned short bf16;
typedef unsigned v4u __attribute__((ext_vector_type(4)));
typedef float f32x4 __attribute__((ext_vector_type(4)));
typedef short bf16x8 __attribute__((ext_vector_type(8)));
typedef GAS unsigned gu32;
typedef GAS unsigned long long gu64;
#define RLX_AGENT __ATOMIC_RELAXED, __HIP_MEMORY_SCOPE_AGENT
#define LDS_WAIT() asm volatile("s_waitcnt lgkmcnt(0)" ::: "memory")
#define VM_WAIT() asm volatile("s_waitcnt vmcnt(0)" ::: "memory")
__device__ __forceinline__ unsigned long long rt() { return __builtin_amdgcn_s_memrealtime(); }
__device__ __forceinline__ unsigned f2bf(float f) { unsigned u = __builtin_bit_cast(unsigned, f); return (u + 0x7fffu + ((u >> 16) & 1u)) >> 16; }
__device__ __forceinline__ unsigned pk2(float lo, float hi) { return f2bf(lo) | (f2bf(hi) << 16); }

#define XB_TMO      128
#define XB_XCNT(j)  (256  + 64 * (j))
#define XB_XSUB(j)  (1280 + 64 * (j))
#define XB_XGEN(j)  (2304 + 64 * (j))
#define XB_TOP      3328
#define XB_TOPGEN   3392
#define XCD_BAR_WORDS 3456
#define XB_SPIN_CAP (1u << 18)

__device__ __forceinline__ unsigned xb_ld(unsigned* p)              { return __hip_atomic_load(p, __ATOMIC_RELAXED, __HIP_MEMORY_SCOPE_AGENT); }
__device__ __forceinline__ unsigned xb_add(unsigned* p, unsigned v) { return __hip_atomic_fetch_add(p, v, __ATOMIC_RELAXED, __HIP_MEMORY_SCOPE_AGENT); }
__device__ __forceinline__ unsigned xb_xcc_id() { return (unsigned)__builtin_amdgcn_s_getreg((3 << 11) | 20) & 0xFu; }
#define XB_SPIN(cond, bar) do { unsigned _sp = 0; while (cond) { __builtin_amdgcn_s_sleep(1); \
    if ((++_sp & 255u) == 0u) { if (xb_ld(&(bar)[XB_TMO])) break; if (_sp > XB_SPIN_CAP) { atomicAdd(&(bar)[XB_TMO], 1u); break; } } } } while (0)

struct XcdBarrier {
    unsigned* bar; unsigned x;
    volatile LAS unsigned* st;
};

__device__ __forceinline__ XcdBarrier xcd_barrier_post(unsigned* bar, volatile LAS unsigned* st) {
    XcdBarrier b; b.bar = bar; b.x = xb_xcc_id(); b.st = st;
    if (threadIdx.x == 0) (void)xb_add(&bar[XB_XCNT(b.x)], 1u);
    return b;
}
__device__ __forceinline__ void xcd_barrier_complete(unsigned* bar, unsigned x, unsigned& nloc, unsigned& nx) {
    const unsigned G = gridDim.x * gridDim.y * gridDim.z;
    unsigned sum, cnt, mine, sp = 0u;
    for (;;) {
        sum = 0u; cnt = 0u; mine = 0u;
#pragma unroll
        for (unsigned j = 0; j < 16; ++j) { const unsigned c = xb_ld(&bar[XB_XCNT(j)]); sum += c; cnt += (c > 0u) ? 1u : 0u; mine = (j == x) ? c : mine; }
        if (sum == G) break;
        __builtin_amdgcn_s_sleep(1);
        if ((++sp & 255u) == 0u) { if (xb_ld(&bar[XB_TMO])) break; if (sp > XB_SPIN_CAP) { atomicAdd(&bar[XB_TMO], 1u); break; } }
    }
    nloc = mine > 0u ? mine : 1u; nx = cnt > 0u ? cnt : 1u;
}

__device__ __forceinline__ void xcd_barrier(const XcdBarrier& b) {
    asm volatile("s_waitcnt vmcnt(0)" ::: "memory");
    __syncthreads();
    if (threadIdx.x == 0) {
        unsigned* bar = b.bar;
        __builtin_amdgcn_s_waitcnt(0);
        unsigned nloc = b.st[0], nx = b.st[1];
        if (nloc == 0u) { xcd_barrier_complete(bar, b.x, nloc, nx); b.st[0] = nloc; b.st[1] = nx; }
        const unsigned old = xb_add(&bar[XB_XSUB(b.x)], 1u);
        const unsigned gen = old / nloc;
        if (old + 1u == (gen + 1u) * nloc) {
            __builtin_amdgcn_fence(__ATOMIC_RELEASE, "agent");
            asm volatile("s_waitcnt vmcnt(0)" ::: "memory");
            const unsigned og = xb_add(&bar[XB_TOP], 1u);
            const unsigned tg = og / nx;
            if (og + 1u == (tg + 1u) * nx) xb_add(&bar[XB_TOPGEN], 1u);
            else XB_SPIN(xb_ld(&bar[XB_TOPGEN]) == tg, bar);
            __builtin_amdgcn_fence(__ATOMIC_ACQUIRE, "agent");
            xb_add(&bar[XB_XGEN(b.x)], 1u);
            asm volatile("s_waitcnt vmcnt(0)" ::: "memory");
        } else {
            XB_SPIN(xb_ld(&bar[XB_TOPGEN]) == gen, bar);
            __builtin_amdgcn_fence(__ATOMIC_ACQUIRE, "agent");
            asm volatile("s_waitcnt vmcnt(0)" ::: "memory");
        }
    }
    __syncthreads();
}
typedef unsigned u32x4 __attribute__((ext_vector_type(4)));

constexpr int NWAVES = 8;
constexpr int BATCH = 8, SEQ = 2048, DM = 1024, M = BATCH * SEQ, DEPTH = 2;
constexpr int DIN = 2564, PP = 2304, NPROJ = 2560, DFF = 2816, NGU = 2 * DFF;
constexpr float EPS = 1e-6f;
constexpr float LOG2E = 1.4426950408889634f;
constexpr int C_U = 0, C_V = 256, C_Z = 512, C_XS = 768, C_B = 1024, C_C = 1280, C_POOL = 1536, C_Q = 1792, C_K = 2048;
enum { I_X = 0, I_N1W, I_WIN, I_GMNW, I_GMWS, I_GMBS, I_CONVW, I_CONVB, I_DTB, I_ALOG, I_SSMD, I_SSMNW, I_POOLW, I_POOLS,
       I_QNW, I_KNW, I_LQ1, I_LK1, I_LQ2, I_LK2, I_SUBLN, I_WOUT, I_N2W, I_WG, I_WU, I_WD, N_IN };

constexpr size_t MiB = 1u << 20;
constexpr size_t WS_CTL = 0, WS_RS = 64 * 1024, RS_STRIDE = (size_t)16384 * 4, CTL_ZERO_BYTES = 64 * 1024 + 4 * 262144;
constexpr size_t WS_W = 2 * MiB, W_LAYER = 24 * MiB, W_IN = 0, W_OUT = 5 * MiB, W_GU = 7 * MiB, W_DN = 18 * MiB;
constexpr size_t WS_XN = 50 * MiB, WS_DT = 82 * MiB, WS_CD = 82 * MiB + 512 * 1024, WS_ST = 83 * MiB, WS_VT = 99 * MiB;
constexpr size_t WS_PROJ = 107 * MiB, WS_MIX = 179 * MiB, WS_H = 107 * MiB, WS_END = 211 * MiB;
constexpr int CW_BAR = 4096;

constexpr int SCR_BYTES = 147456;
constexpr int LDSCTL_OFF = SCR_BYTES, MISC_OFF = LDSCTL_OFF + 320;
constexpr int LDS_BYTES = SCR_BYTES + 1024;

typedef float f32x16 __attribute__((ext_vector_type(16)));
typedef unsigned u32x2 __attribute__((ext_vector_type(2)));
#define DI __device__ __forceinline__
#define OPQ(x) asm volatile("" : "+v"(x))
#define MFMA32(a, b, c) __builtin_amdgcn_mfma_f32_32x32x16_bf16((a), (b), (c), 0, 0, 0)

DI float bf2f(bf16 u) { return __uint_as_float((unsigned)u << 16); }
DI float bflo(unsigned w) { return __uint_as_float(w << 16); }
DI float bfhi(unsigned w) { return __uint_as_float(w & 0xffff0000u); }
DI bf16 f2b(float f) { return (bf16)f2bf(f); }
DI int crow(int reg, int h) { return (reg & 3) + 8 * (reg >> 2) + 4 * h; }
DI float wave_sum(float v) {
#pragma unroll
    for (int o = 1; o < 64; o <<= 1) v += __shfl_xor(v, o);
    return v;
}
DI void unpack8(v4u w, float* f) { f[0] = bflo(w.x); f[1] = bfhi(w.x); f[2] = bflo(w.y); f[3] = bfhi(w.y); f[4] = bflo(w.z); f[5] = bfhi(w.z); f[6] = bflo(w.w); f[7] = bfhi(w.w); }
DI v4u pack8(const float* f) { v4u o; o.x = pk2(f[0], f[1]); o.y = pk2(f[2], f[3]); o.z = pk2(f[4], f[5]); o.w = pk2(f[6], f[7]); return o; }
DI float silu_f(float x) { return x * __builtin_amdgcn_rcpf(1.f + __builtin_amdgcn_exp2f(-x * LOG2E)); }
DI float gelu_tanh_f(float x) { const float y = 0.7978845608f * (x + 0.044715f * x * x * x); return x * __builtin_amdgcn_rcpf(1.f + __builtin_amdgcn_exp2f(-2.f * LOG2E * y)); }

DI f32x16 mma_tile(const LAS bf16* A, int pa, const LAS bf16* Bt, int pb, int K, f32x16 acc, int r, int lh) {
    const LAS bf16* ap = A + r * pa + 8 * lh; const LAS bf16* bp = Bt + r * pb + 8 * lh;
    for (int k = 0; k < K; k += 16) { const bf16x8 a = *(const LAS bf16x8*)(ap + k); const bf16x8 b = *(const LAS bf16x8*)(bp + k); acc = MFMA32(a, b, acc); }
    return acc;
}

DI int swz136(int row, int t) { return row * 136 + ((((t >> 3) ^ (row >> 3)) & 15) << 3) + (t & 7); }
template <bool SWA, bool SWB>
DI f32x16 mma_tile_sw(const LAS bf16* Abuf, int rowA0, const LAS bf16* Bbuf, int rowB0, int K, f32x16 acc, int r, int lh) {
    const int ra = rowA0 + r, rb = rowB0 + r; const int xa = SWA ? ((ra >> 3) & 15) : 0, xb = SWB ? ((rb >> 3) & 15) : 0;
    const LAS bf16* ap = Abuf + ra * 136; const LAS bf16* bp = Bbuf + rb * 136;
    for (int k = 0; k < K; k += 16) { const int kb = (k >> 3) + lh; const bf16x8 a = *(const LAS bf16x8*)(ap + ((kb ^ xa) << 3)); const bf16x8 b = *(const LAS bf16x8*)(bp + ((kb ^ xb) << 3)); acc = MFMA32(a, b, acc); }
    return acc;
}

struct Args { const float* in[N_IN]; float* out; unsigned char* ws; int ph_lo, ph_hi; };
typedef const Args __attribute__((address_space(4)))* KA;
DI KA kargs() { KA p = (KA)__builtin_amdgcn_kernarg_segment_ptr(); asm volatile("" : "+s"(p)); return p; }

namespace pg8 {
struct EpiInProj {
    static constexpr bool PERM = true, AFTER_DRAIN = false;
    bf16_t* O; const float* qw; const float* kw; const float* rs;
    __device__ __forceinline__ void operator()(const f32x4 (&acc)[2][2][4][2], const Unit& u, int wr, int wc, int fr, int fq) const {
        const int row0 = u.pm * BM + wr * 64 + fr, col0 = u.pn * BM + wc * 32 + 8 * fq;
        const int mode = (u.pn < 2) ? 1 : (u.pn == 7 ? 2 : (u.pn == 8 ? 3 : 0));
        f32x4 w0 = (f32x4){1.f, 1.f, 1.f, 1.f}, w1 = w0;
        if (mode >= 2) { const float* wp = (mode == 2 ? qw : kw) + 8 * fq; w0 = *(const f32x4*)wp; w1 = *(const f32x4*)(wp + 4);
            if (mode == 2) { const float sc = 0.17677669529663687f * 1.4426950408889634f; w0 = w0 * sc; w1 = w1 * sc; } }
        float rstv[2][4];
#pragma unroll
        for (int ai = 0; ai < 2; ++ai)
#pragma unroll
            for (int m = 0; m < 4; ++m) { const f32x4 q4 = *(const f32x4*)(rs + (size_t)(row0 + ai * HALF + m * 16) * 4); rstv[ai][m] = 1.0f / sqrtf(((q4[0] + q4[1]) + (q4[2] + q4[3])) * (1.0f / DM) + EPS); }
#pragma unroll
        for (int ai = 0; ai < 2; ++ai)
#pragma unroll
            for (int m = 0; m < 4; ++m) { bf16_t* rowp = O + (size_t)(row0 + ai * HALF + m * 16) * PP + col0;
                const float rst = rstv[ai][m];
#pragma unroll
                for (int bj = 0; bj < 2; ++bj) { f32x4 v0 = acc[ai][bj][m][0] * rst, v1 = acc[ai][bj][m][1] * rst;
                    if (mode == 1) {
#pragma unroll
                        for (int j = 0; j < 4; ++j) { v0[j] = gelu_tanh_f(v0[j]); v1[j] = gelu_tanh_f(v1[j]); }
                    } else if (mode >= 2) {
                        float ss = (v0[0] * v0[0] + v0[1] * v0[1]) + (v0[2] * v0[2] + v0[3] * v0[3]) + (v1[0] * v1[0] + v1[1] * v1[1]) + (v1[2] * v1[2] + v1[3] * v1[3]);
                        ss += __shfl_xor(ss, 16); ss += __shfl_xor(ss, 32);
                        const float rstd = 1.0f / sqrtf(ss * (1.0f / 32.0f) + EPS);
                        v0 = v0 * rstd * w0; v1 = v1 * rstd * w1;
                    }
                    u32x4 w; w.x = cvt_pk_bf16(v0[0], v0[1]); w.y = cvt_pk_bf16(v0[2], v0[3]); w.z = cvt_pk_bf16(v1[0], v1[1]); w.w = cvt_pk_bf16(v1[2], v1[3]);
                    *(u32x4*)(rowp + bj * HALF) = w; } }
    }
};
struct EpiResid {
    static constexpr bool PERM = true, AFTER_DRAIN = false;
    const float* base32; const bf16_t* base16; float* out32; bf16_t* xb; float* rs;
    __device__ __forceinline__ void rows(const f32x4 (&acc)[2][2][4][2], const u32x4 (&raw)[4][2], int ai, int m0, int m1, int row0, int col0, int pn, int fq) const {
#pragma unroll
        for (int m = m0; m < m1; ++m) { const int row = row0 + ai * HALF + m * 16; const size_t off = (size_t)row * DM + col0; float ss = 0.f;
#pragma unroll
            for (int bj = 0; bj < 2; ++bj) { const size_t o = off + bj * HALF; const u32x4 w = raw[m][bj];
                const f32x4 p0 = (f32x4){__uint_as_float(w.x << 16), __uint_as_float(w.x & 0xffff0000u), __uint_as_float(w.y << 16), __uint_as_float(w.y & 0xffff0000u)};
                const f32x4 p1 = (f32x4){__uint_as_float(w.z << 16), __uint_as_float(w.z & 0xffff0000u), __uint_as_float(w.w << 16), __uint_as_float(w.w & 0xffff0000u)};
                const f32x4 v0 = p0 + acc[ai][bj][m][0], v1 = p1 + acc[ai][bj][m][1];
                if (out32) { *(f32x4*)(out32 + o) = v0; *(f32x4*)(out32 + o + 4) = v1; }
                if (xb) { ss += ((v0[0] * v0[0] + v0[1] * v0[1]) + (v0[2] * v0[2] + v0[3] * v0[3])) + ((v1[0] * v1[0] + v1[1] * v1[1]) + (v1[2] * v1[2] + v1[3] * v1[3]));
                    u32x4 wo; wo.x = cvt_pk_bf16(v0[0], v0[1]); wo.y = cvt_pk_bf16(v0[2], v0[3]); wo.z = cvt_pk_bf16(v1[0], v1[1]); wo.w = cvt_pk_bf16(v1[2], v1[3]); *(u32x4*)(xb + o) = wo; } }
            if (xb) { ss += __shfl_xor(ss, 16); ss += __shfl_xor(ss, 32); if (fq == 0) __hip_atomic_fetch_add(rs + (size_t)row * 4 + pn, ss, __ATOMIC_RELAXED, __HIP_MEMORY_SCOPE_WORKGROUP); }     }
    }
    __device__ __forceinline__ void load8(u32x4 (&raw)[4][2], int ai, int row0, int col0) const {
#pragma unroll
        for (int m = 0; m < 4; ++m) { const size_t off = (size_t)(row0 + ai * HALF + m * 16) * DM + col0;
#pragma unroll
            for (int bj = 0; bj < 2; ++bj) raw[m][bj] = *(const u32x4*)(base16 + off + bj * HALF); }
    }
    __device__ __forceinline__ void operator()(const f32x4 (&acc)[2][2][4][2], const Unit& u, int wr, int wc, int fr, int fq) const {
        const int row0 = u.pm * BM + wr * 64 + fr, col0 = u.pn * BM + wc * 32 + 8 * fq;
        u32x4 raw0[4][2], raw1[4][2];
        load8(raw0, 0, row0, col0);
        asm volatile("" ::: "memory");
        rows(acc, raw0, 0, 0, 2, row0, col0, u.pn, fq);
        asm volatile("" ::: "memory");
        load8(raw1, 1, row0, col0);
        asm volatile("" ::: "memory");
        rows(acc, raw0, 0, 2, 4, row0, col0, u.pn, fq);
        asm volatile("" ::: "memory");
        rows(acc, raw1, 1, 0, 4, row0, col0, u.pn, fq);
    }
};
struct EpiSwiGLU {
    static constexpr bool PERM = true, AFTER_DRAIN = false;
    bf16_t* O; const float* rs;
    __device__ __forceinline__ void operator()(const f32x4 (&acc)[2][2][4][2], const Unit& u, int wr, int wc, int fr, int fq) const {
        const int row0 = u.pm * BM + wr * 64 + fr, col0 = u.pn * HALF + wc * 32 + 8 * fq;
        float rstv[2][4];
#pragma unroll
        for (int ai = 0; ai < 2; ++ai)
#pragma unroll
            for (int m = 0; m < 4; ++m) { const f32x4 q4 = *(const f32x4*)(rs + (size_t)(row0 + ai * HALF + m * 16) * 4); rstv[ai][m] = 1.0f / sqrtf(((q4[0] + q4[1]) + (q4[2] + q4[3])) * (1.0f / DM) + EPS); }
#pragma unroll
        for (int ai = 0; ai < 2; ++ai)
#pragma unroll
            for (int m = 0; m < 4; ++m) { bf16_t* rowp = O + (size_t)(row0 + ai * HALF + m * 16) * DFF + col0;
                f32x4 h0, h1; const float rst = rstv[ai][m];
#pragma unroll
                for (int j = 0; j < 4; ++j) { h0[j] = silu_f(acc[ai][0][m][0][j] * rst) * (acc[ai][1][m][0][j] * rst); h1[j] = silu_f(acc[ai][0][m][1][j] * rst) * (acc[ai][1][m][1][j] * rst); }
                u32x4 w; w.x = cvt_pk_bf16(h0[0], h0[1]); w.y = cvt_pk_bf16(h0[2], h0[3]); w.z = cvt_pk_bf16(h1[0], h1[1]); w.w = cvt_pk_bf16(h1[2], h1[3]);
                *(u32x4*)rowp = w; }
    }
};
struct EpiVT {
    static constexpr bool PERM = true, AFTER_DRAIN = false;
    bf16_t* O; const float* rs;
    __device__ __forceinline__ void operator()(const f32x4 (&acc)[2][2][4][2], const Unit& u, int wr, int wc, int fr, int fq) const {
        const int row0 = u.pm * BM + wr * 64 + fr, col0 = u.pn * BM + wc * 32 + 8 * fq;
        f32x4 sc[2][2];
#pragma unroll
        for (int bj = 0; bj < 2; ++bj)
#pragma unroll
            for (int n = 0; n < 2; ++n) {
#pragma unroll
                for (int j = 0; j < 4; ++j) { const f32x4 q4 = *(const f32x4*)(rs + (size_t)(col0 + bj * HALF + 4 * n + j) * 4); sc[bj][n][j] = 1.0f / sqrtf(((q4[0] + q4[1]) + (q4[2] + q4[3])) * (1.0f / DM) + EPS); } }
#pragma unroll
        for (int ai = 0; ai < 2; ++ai)
#pragma unroll
            for (int m = 0; m < 4; ++m) { bf16_t* rowp = O + (size_t)(row0 + ai * HALF + m * 16) * M + col0;
#pragma unroll
                for (int bj = 0; bj < 2; ++bj) { const f32x4 v0 = acc[ai][bj][m][0] * sc[bj][0], v1 = acc[ai][bj][m][1] * sc[bj][1];
                    u32x4 w; w.x = cvt_pk_bf16(v0[0], v0[1]); w.y = cvt_pk_bf16(v0[2], v0[3]); w.z = cvt_pk_bf16(v1[0], v1[1]); w.w = cvt_pk_bf16(v1[2], v1[3]);
                    *(u32x4*)(rowp + bj * HALF) = w; } }
    }
};
}

DI void tr_item(const float* src, int pitch, int k0, int c0, bf16* dst, int drow0, int Kd, LAS float* scr, int lane, const float* ksc) {
#pragma unroll 8
    for (int i = 0; i < 32; ++i) { const int kk = 2 * i + (lane >> 5); scr[kk * 33 + (lane & 31)] = src[(size_t)(k0 + kk) * pitch + c0 + (lane & 31)]; }
    LDS_WAIT(); asm volatile("" ::: "memory");
    const int c = lane & 7;
    f32x4 k0v = (f32x4){1.f, 1.f, 1.f, 1.f}, k1v = k0v; if (ksc) { k0v = *(const f32x4*)(ksc + k0 + 8 * c); k1v = *(const f32x4*)(ksc + k0 + 8 * c + 4); }
#pragma unroll
    for (int j = 0; j < 4; ++j) { const int n = (lane >> 3) + 8 * j; const LAS float* s = scr + (8 * c) * 33 + n;
        v4u o; o.x = pk2(s[0 * 33] * k0v[0], s[1 * 33] * k0v[1]); o.y = pk2(s[2 * 33] * k0v[2], s[3 * 33] * k0v[3]); o.z = pk2(s[4 * 33] * k1v[0], s[5 * 33] * k1v[1]); o.w = pk2(s[6 * 33] * k1v[2], s[7 * 33] * k1v[3]);
        *(v4u*)(dst + (size_t)(drow0 + n) * Kd + k0 + 8 * c) = o; }
    LDS_WAIT(); asm volatile("" ::: "memory");
}
constexpr int WI_INP = 16 * 80, WI_OUT = 16 * 32, WI_G = 16 * 88, WI_D = 44 * 32, WI_PER_L = WI_INP + WI_OUT + 2 * WI_G + WI_D;
DI void weights_phase(KA a, LAS unsigned char* lds, int L, int lo, int hi, int rank, int nranks, int wave, int lane) {
    OPQ(lane);
    LAS float* scr = (LAS float*)(lds + wave * 16384);
    unsigned char* wb = a->ws + WS_W + (size_t)L * W_LAYER;
    for (int it = lo + rank; it < hi; it += nranks) {
        int r = it;
        if (r < WI_INP) { const int kb = r / 80, nb = r % 80, d0 = nb * 32; tr_item(a->in[I_WIN] + (size_t)L * DM * DIN, DIN, kb * 64, d0 < 1536 ? d0 : d0 + 4, (bf16*)(wb + W_IN), d0, DM, scr, lane, a->in[I_N1W] + L * DM); continue; } r -= WI_INP;
        if (r < WI_OUT) { const int kb = r / 32, nb = r % 32; tr_item(a->in[I_WOUT] + (size_t)L * DM * DM, DM, kb * 64, nb * 32, (bf16*)(wb + W_OUT), nb * 32, DM, scr, lane, nullptr); continue; } r -= WI_OUT;
        if (r < WI_G) { const int kb = r / 88, nb = r % 88, c0 = nb * 32; tr_item(a->in[I_WG] + (size_t)L * DM * DFF, DFF, kb * 64, c0, (bf16*)(wb + W_GU), (c0 >> 7) * 256 + (c0 & 127), DM, scr, lane, a->in[I_N2W] + L * DM); continue; } r -= WI_G;
        if (r < WI_G) { const int kb = r / 88, nb = r % 88, c0 = nb * 32; tr_item(a->in[I_WU] + (size_t)L * DM * DFF, DFF, kb * 64, c0, (bf16*)(wb + W_GU), (c0 >> 7) * 256 + 128 + (c0 & 127), DM, scr, lane, a->in[I_N2W] + L * DM); continue; } r -= WI_G;
        { const int kb = r / 32, nb = r % 32; tr_item(a->in[I_WD] + (size_t)L * DFF * DM, DM, kb * 64, nb * 32, (bf16*)(wb + W_DN), nb * 32, DFF, scr, lane, nullptr); }
    }
}
DI void prep_phase(const float* xsrc, bf16* XB, float* rs, int vcu, int G, int wave, int lane) {
    OPQ(lane);
    for (int m = vcu * NWAVES + wave; m < M; m += G * NWAVES) {
        const f32x4* xr = (const f32x4*)(xsrc + (size_t)m * DM) + lane;
        f32x4 v[4]; float s = 0.f;
#pragma unroll
        for (int j = 0; j < 4; ++j) { v[j] = xr[64 * j]; s += (v[j].x * v[j].x + v[j].y * v[j].y) + (v[j].z * v[j].z + v[j].w * v[j].w); }
        s = wave_sum(s);
        unsigned long long* o8 = (unsigned long long*)(XB + (size_t)m * DM) + lane;
#pragma unroll
        for (int j = 0; j < 4; ++j) o8[64 * j] = (unsigned long long)pk2(v[j].x, v[j].y) | ((unsigned long long)pk2(v[j].z, v[j].w) << 32);
        if (lane == 0) rs[(size_t)m * 4] = s;
    }
}

DI void gmlp_item(KA a, int L, int b, int c, int h, LAS unsigned char* lds, int tid, int wave, int lane) {
    OPQ(lane); OPQ(tid);
    LAS bf16* Wm = (LAS bf16*)lds; LAS bf16* vT = (LAS bf16*)(lds + 34816);
    const bf16* PROJ = (const bf16*)(a->ws + WS_PROJ); bf16* MIX = (bf16*)(a->ws + WS_MIX);
    const int tok0 = b * SEQ + c * 128;
    const float* ws = a->in[I_GMWS] + (size_t)(L * 4 + h) * 16384;
#pragma unroll
    for (int i = 0; i < 8; ++i) { const int idx = tid + 512 * i, t = idx >> 5, s4 = (idx & 31) * 4; const f32x4 w = *(const f32x4*)(ws + t * 128 + s4);
        u32x2 p; p.x = pk2(s4 <= t ? w.x : 0.f, s4 + 1 <= t ? w.y : 0.f); p.y = pk2(s4 + 2 <= t ? w.z : 0.f, s4 + 3 <= t ? w.w : 0.f);
        *(LAS u32x2*)(Wm + t * 136 + s4) = p; }
    { const int t = tid >> 2, qd = tid & 3; const bf16* vp = PROJ + (size_t)(tok0 + t) * PP + C_V + h * 64 + qd * 16;
      float f[16]; unpack8(*(const v4u*)vp, f); unpack8(*(const v4u*)(vp + 8), f + 8);
      float ss = 0.f;
#pragma unroll
      for (int i = 0; i < 16; ++i) ss += f[i] * f[i];
      ss += __shfl_xor(ss, 1); ss += __shfl_xor(ss, 2);
      const float rstd = 1.0f / sqrtf(ss * (1.0f / 64.0f) + EPS); const float* gw = a->in[I_GMNW] + L * 256 + h * 64 + qd * 16;
#pragma unroll
      for (int i = 0; i < 16; ++i) vT[(qd * 16 + i) * 136 + t] = f2b(f[i] * rstd * gw[i]); }
    __syncthreads();
    { const int tt = wave >> 1, dtl = wave & 1, r = lane & 31, lh = lane >> 5;
      f32x16 acc = {}; acc = mma_tile(Wm + tt * 32 * 136, 136, vT + dtl * 32 * 136, 136, 32 * (tt + 1), acc, r, lh);
      const float* bs = a->in[I_GMBS] + (L * 4 + h) * 128; const int d = dtl * 32 + r;
#pragma unroll
      for (int reg = 0; reg < 16; ++reg) { const int t = tt * 32 + crow(reg, lh); const float u = bf2f(PROJ[(size_t)(tok0 + t) * PP + C_U + h * 64 + d]);
          MIX[(size_t)(tok0 + t) * DM + h * 64 + d] = f2b(u * (acc[reg] + bs[t])); } }
    __syncthreads();
}
template <int WIN> DI void pool_win(const bf16* hp, int tpos, float* s) {
    float cur[16];
#pragma unroll
    for (int i = 0; i < 16; ++i) s[i] = 0.f;
#pragma unroll
    for (int j = 0; j < WIN; ++j) { const bool ok = tpos - j >= 0; const bf16* pp = ok ? hp - (size_t)j * PP : hp; float f[16]; unpack8(*(const v4u*)pp, f); unpack8(*(const v4u*)(pp + 8), f + 8);
#pragma unroll
        for (int i = 0; i < 16; ++i) { if (j == 0) cur[i] = f[i]; s[i] += ok ? f[i] : 0.f; } }
    const int cnt = (tpos + 1 < WIN) ? tpos + 1 : WIN; const float inv = 1.0f / (float)cnt;
#pragma unroll
    for (int i = 0; i < 16; ++i) s[i] = s[i] * inv - cur[i];
}
DI void pool_item(KA a, int L, int b, int c, int g, LAS unsigned char* lds, int tid, int wave, int lane) {
    OPQ(lane); OPQ(tid);
    LAS bf16* P = (LAS bf16*)lds; LAS bf16* WT = (LAS bf16*)(lds + 18432);
    const bf16* PROJ = (const bf16*)(a->ws + WS_PROJ); bf16* MIX = (bf16*)(a->ws + WS_MIX);
    const int tok0 = b * SEQ + c * 128;
    { const int t = tid >> 2, qd = tid & 3, tpos = c * 128 + t;
      const bf16* hp = PROJ + (size_t)(b * SEQ + tpos) * PP + C_POOL + g * 64 + qd * 16;
      float s[16];
      switch (g) { case 0: pool_win<2>(hp, tpos, s); break; case 1: pool_win<4>(hp, tpos, s); break; case 2: pool_win<8>(hp, tpos, s); break; default: pool_win<16>(hp, tpos, s); break; }
      *(LAS v4u*)(P + t * 72 + qd * 16) = pack8(s); *(LAS v4u*)(P + t * 72 + qd * 16 + 8) = pack8(s + 8); }
    { const float* pw = a->in[I_POOLW] + (size_t)(L * 4 + g) * 4096;
#pragma unroll
      for (int i = 0; i < 8; ++i) { const int idx = tid + 512 * i, d = idx >> 6, e = idx & 63; WT[e * 72 + d] = f2b(pw[d * 64 + e]); } }
    __syncthreads();
    { const int tt = wave >> 1, et = wave & 1, r = lane & 31, lh = lane >> 5;
      f32x16 acc = {}; acc = mma_tile(P + tt * 32 * 72, 72, WT + et * 32 * 72, 72, 64, acc, r, lh);
      const int e = et * 32 + r; const float sc = a->in[I_POOLS][L * 256 + g * 64 + e];
#pragma unroll
      for (int reg = 0; reg < 16; ++reg) { const int t = tt * 32 + crow(reg, lh); MIX[(size_t)(tok0 + t) * DM + 512 + g * 64 + e] = f2b(acc[reg] * sc); } }
    __syncthreads();
}
DI void gmlp_pair(KA a, int L, int itA, int itB, LAS unsigned char* lds, int tid, int wave, int lane) {
    OPQ(lane); OPQ(tid);
    const bf16* PROJ = (const bf16*)(a->ws + WS_PROJ); bf16* MIX = (bf16*)(a->ws + WS_MIX);
    constexpr int REG = 52224;
    int tok0[2], hq[2]; const int its[2] = {itA, itB};
#pragma unroll
    for (int q = 0; q < 2; ++q) { tok0[q] = (its[q] >> 6) * SEQ + ((its[q] >> 2) & 15) * 128; hq[q] = its[q] & 3; }
    f32x4 wv[2][8]; v4u vv[2][2];
    const int vt = tid >> 2, vqd = tid & 3;
#pragma unroll
    for (int q = 0; q < 2; ++q) { const float* ws = a->in[I_GMWS] + (size_t)(L * 4 + hq[q]) * 16384;
#pragma unroll
        for (int i = 0; i < 8; ++i) { const int idx = tid + 512 * i; wv[q][i] = *(const f32x4*)(ws + (idx >> 5) * 128 + (idx & 31) * 4); }
        const bf16* vp = PROJ + (size_t)(tok0[q] + vt) * PP + C_V + hq[q] * 64 + vqd * 16; vv[q][0] = *(const v4u*)vp; vv[q][1] = *(const v4u*)(vp + 8); }
#pragma unroll
    for (int q = 0; q < 2; ++q) { LAS bf16* Wm = (LAS bf16*)(lds + q * REG); LAS bf16* vT = (LAS bf16*)(lds + q * REG + 34816);
#pragma unroll
        for (int i = 0; i < 8; ++i) { const int idx = tid + 512 * i, t = idx >> 5, s4 = (idx & 31) * 4; const f32x4 w = wv[q][i];
            u32x2 p; p.x = pk2(s4 <= t ? w.x : 0.f, s4 + 1 <= t ? w.y : 0.f); p.y = pk2(s4 + 2 <= t ? w.z : 0.f, s4 + 3 <= t ? w.w : 0.f);
            *(LAS u32x2*)(Wm + t * 136 + s4) = p; }
        float f[16]; unpack8(vv[q][0], f); unpack8(vv[q][1], f + 8);
        float ss = 0.f;
#pragma unroll
        for (int i = 0; i < 16; ++i) ss += f[i] * f[i];
        ss += __shfl_xor(ss, 1); ss += __shfl_xor(ss, 2);
        const float rstd = 1.0f / sqrtf(ss * (1.0f / 64.0f) + EPS); const float* gw = a->in[I_GMNW] + L * 256 + hq[q] * 64 + vqd * 16;
#pragma unroll
        for (int i = 0; i < 16; ++i) vT[(vqd * 16 + i) * 136 + vt] = f2b(f[i] * rstd * gw[i]); }
    __syncthreads();
    { const int tt = wave >> 1, dtl = wave & 1, r = lane & 31, lh = lane >> 5, d = dtl * 32 + r;
      float uu[2][16];
#pragma unroll
      for (int q = 0; q < 2; ++q)
#pragma unroll
          for (int reg = 0; reg < 16; ++reg) uu[q][reg] = bf2f(PROJ[(size_t)(tok0[q] + tt * 32 + crow(reg, lh)) * PP + C_U + hq[q] * 64 + d]);
      f32x16 acc[2];
#pragma unroll
      for (int q = 0; q < 2; ++q) { acc[q] = (f32x16){}; acc[q] = mma_tile((LAS bf16*)(lds + q * REG) + tt * 32 * 136, 136, (LAS bf16*)(lds + q * REG + 34816) + dtl * 32 * 136, 136, 32 * (tt + 1), acc[q], r, lh); }
#pragma unroll
      for (int q = 0; q < 2; ++q) { const float* bs = a->in[I_GMBS] + (L * 4 + hq[q]) * 128;
#pragma unroll
          for (int reg = 0; reg < 16; ++reg) { const int t = tt * 32 + crow(reg, lh); MIX[(size_t)(tok0[q] + t) * DM + hq[q] * 64 + d] = f2b(uu[q][reg] * (acc[q][reg] + bs[t])); } } }
    __syncthreads();
}
DI void pool_pair(KA a, int L, int itA, int itB, LAS unsigned char* lds, int tid, int wave, int lane) {
    OPQ(lane); OPQ(tid);
    const bf16* PROJ = (const bf16*)(a->ws + WS_PROJ); bf16* MIX = (bf16*)(a->ws + WS_MIX);
    constexpr int R_OFF = 0, P_OFF = 144 * 72 * 2, W_OFF = P_OFF + 128 * 72 * 2, REG = W_OFF + 64 * 72 * 2;
    const int its[2] = {itA, itB};
    v4u rv[2][3]; float wq[2][8];
#pragma unroll
    for (int q = 0; q < 2; ++q) { const int b = its[q] >> 6, c = (its[q] >> 2) & 15, g = its[q] & 3;
#pragma unroll
        for (int i = 0; i < 3; ++i) { const int idx = tid + 512 * i, row = idx >> 3, ch = idx & 7, tp = c * 128 - 16 + row; const bool ok = (idx < 144 * 8) && tp >= 0;
            rv[q][i] = *(const v4u*)(PROJ + (size_t)(b * SEQ + (ok ? tp : c * 128)) * PP + C_POOL + g * 64 + ch * 8); if (!ok) rv[q][i] = (v4u){0u, 0u, 0u, 0u}; }
        const float* pw = a->in[I_POOLW] + (size_t)(L * 4 + g) * 4096;
#pragma unroll
        for (int i = 0; i < 8; ++i) wq[q][i] = pw[tid + 512 * i]; }
#pragma unroll
    for (int q = 0; q < 2; ++q) { LAS bf16* R = (LAS bf16*)(lds + q * REG + R_OFF); LAS bf16* WT = (LAS bf16*)(lds + q * REG + W_OFF);
#pragma unroll
        for (int i = 0; i < 3; ++i) { const int idx = tid + 512 * i; if (idx < 144 * 8) *(LAS v4u*)(R + (idx >> 3) * 72 + (idx & 7) * 8) = rv[q][i]; }
#pragma unroll
        for (int i = 0; i < 8; ++i) { const int idx = tid + 512 * i, d = idx >> 6, e = idx & 63; WT[e * 72 + d] = f2b(wq[q][i]); } }
    __syncthreads();
    { const int t = tid >> 2, qd = tid & 3;
#pragma unroll
      for (int q = 0; q < 2; ++q) { const int c = (its[q] >> 2) & 15, g = its[q] & 3, win = 2 << g, tpos = c * 128 + t, cnt = (tpos + 1 < win) ? tpos + 1 : win;
          const LAS bf16* R = (const LAS bf16*)(lds + q * REG + R_OFF) + (t + 16) * 72 + qd * 16; LAS bf16* P = (LAS bf16*)(lds + q * REG + P_OFF);
          float sacc[16], cur[16];
          unpack8(*(const LAS v4u*)R, cur); unpack8(*(const LAS v4u*)(R + 8), cur + 8);
#pragma unroll
          for (int i = 0; i < 16; ++i) sacc[i] = cur[i];
          for (int jw = 1; jw < win; ++jw) { float f[16]; unpack8(*(const LAS v4u*)(R - jw * 72), f); unpack8(*(const LAS v4u*)(R - jw * 72 + 8), f + 8);
#pragma unroll
              for (int i = 0; i < 16; ++i) sacc[i] += f[i]; }
          const float inv = 1.0f / (float)cnt;
#pragma unroll
          for (int i = 0; i < 16; ++i) sacc[i] = sacc[i] * inv - cur[i];
          *(LAS v4u*)(P + t * 72 + qd * 16) = pack8(sacc); *(LAS v4u*)(P + t * 72 + qd * 16 + 8) = pack8(sacc + 8); } }
    __syncthreads();
    { const int tt = wave >> 1, et = wave & 1, r = lane & 31, lh = lane >> 5, e = et * 32 + r;
#pragma unroll
      for (int q = 0; q < 2; ++q) { const int b = its[q] >> 6, c = (its[q] >> 2) & 15, g = its[q] & 3, tok0 = b * SEQ + c * 128;
          f32x16 acc = {}; acc = mma_tile((LAS bf16*)(lds + q * REG + P_OFF) + tt * 32 * 72, 72, (LAS bf16*)(lds + q * REG + W_OFF) + et * 32 * 72, 72, 64, acc, r, lh);
          const float sc = a->in[I_POOLS][L * 256 + g * 64 + e];
#pragma unroll
          for (int reg = 0; reg < 16; ++reg) { const int tr = tt * 32 + crow(reg, lh); MIX[(size_t)(tok0 + tr) * DM + 512 + g * 64 + e] = f2b(acc[reg] * sc); } } }
    __syncthreads();
}
constexpr int SSD_DT = 139264, SSD_AR = SSD_DT + 1024, SSD_ACS = SSD_AR + 1024;
DI void ssd_dt(KA a, int L, int g, int tok0, LAS unsigned char* lds, int tid, const LAS float* dtraw) {
    LAS float* dtv = (LAS float*)(lds + SSD_DT); LAS float* wtot = (LAS float*)(lds + SSD_AR); LAS float* acs = (LAS float*)(lds + SSD_ACS);
    const float* DT = (const float*)(a->ws + WS_DT);
    const int hh = (tid >> 7) & 1, t = tid & 127, h = 2 * g + hh, ln = tid & 63, wv = tid >> 6;
    if (tid < 256) { const float x = (dtraw ? dtraw[t * 2 + hh] : DT[(size_t)(tok0 + t) * 4 + h]) + a->in[I_DTB][L * 4 + h]; const float ey = __expf(x); const float sp = x > 20.f ? x : (ey < 0.01f ? ey * (1.f - ey * (0.5f - ey * (1.f / 3.f))) : __logf(1.f + ey));
        float s = -sp * __expf(a->in[I_ALOG][L * 4 + h]);
#pragma unroll
        for (int o = 1; o < 64; o <<= 1) { const float n = __shfl_up(s, o); if (ln >= o) s += n; }
        dtv[t * 2 + hh] = sp; acs[t * 2 + hh] = s; if (ln == 63) wtot[wv] = s; }
    __syncthreads();
    if (tid < 256 && (wv & 1)) acs[t * 2 + hh] += wtot[wv - 1];
    __syncthreads();
}
DI void conv_load(const bf16* p, int tpos0, v4u (&raw)[7]) {
#pragma unroll
    for (int rr = 0; rr < 7; ++rr) { const bool ok = tpos0 - 3 + rr >= 0; raw[rr] = *(const v4u*)(ok ? p + (ptrdiff_t)(rr - 3) * PP : p); if (!ok) raw[rr] = (v4u){0u, 0u, 0u, 0u}; }
}
DI void conv_apply(const v4u (&raw)[7], const float* cw, const float* cb, float (&out)[4][8]) {
    f32x4 w[8];
#pragma unroll
    for (int i = 0; i < 8; ++i) w[i] = *(const f32x4*)(cw + 4 * i);
    const f32x4 b0 = *(const f32x4*)cb, b1 = *(const f32x4*)(cb + 4);
    const float bias[8] = {b0.x, b0.y, b0.z, b0.w, b1.x, b1.y, b1.z, b1.w};
    float x[7][8];
#pragma unroll
    for (int rr = 0; rr < 7; ++rr) unpack8(raw[rr], x[rr]);
#pragma unroll
    for (int k = 0; k < 4; ++k)
#pragma unroll
        for (int i = 0; i < 8; ++i) { float acc = bias[i];
#pragma unroll
            for (int jj = 0; jj < 4; ++jj) acc += x[k + jj][i] * w[i][jj];
            out[k][i] = silu_f(acc); }
}
DI void ssd_pass1(KA a, int L, int b, int c, int g, LAS unsigned char* lds, int tid, int wave, int lane) {
    OPQ(lane); OPQ(tid);
    LAS bf16* XwT = (LAS bf16*)lds; LAS bf16* BT = (LAS bf16*)(lds + 34816);
    LAS float* dtv = (LAS float*)(lds + SSD_DT); LAS float* acs = (LAS float*)(lds + SSD_ACS);
    const bf16* PROJ = (const bf16*)(a->ws + WS_PROJ); bf16* ST = (bf16*)(a->ws + WS_ST); float* CD = (float*)(a->ws + WS_CD);
    const int tok0 = b * SEQ + c * 128;
    v4u rawx[7], rawb[7];
    { const int cg = tid & 15, t0 = (tid >> 4) * 4; const bf16* rowp = PROJ + (size_t)(tok0 + t0) * PP + g * 128 + cg * 8; conv_load(rowp + C_XS, c * 128 + t0, rawx); conv_load(rowp + C_B, c * 128 + t0, rawb); }
    {
      LAS float* Wd = (LAS float*)(lds + 69632); LAS float* dtraw = (LAS float*)(lds + SSD_DT + 3072);
      const float* win = a->in[I_WIN] + (size_t)L * DM * DIN + 1536 + 2 * g; const float* nw = a->in[I_N1W] + L * DM;
      for (int k = tid; k < DM; k += NWAVES * 64) { const float w = nw[k]; Wd[2 * k] = w * win[(size_t)k * DIN]; Wd[2 * k + 1] = w * win[(size_t)k * DIN + 1]; }
      __syncthreads();
      const bf16* XB = (const bf16*)(a->ws + WS_XN); const float* rs = (const float*)(a->ws + WS_RS) + (size_t)(2 * L) * RS_STRIDE; float* DTg = (float*)(a->ws + WS_DT);
      const int t4 = tid >> 4, l16 = tid & 15; const bf16* xr = XB + (size_t)(tok0 + t4) * DM + l16 * 8;
      float a0[4] = {0.f, 0.f, 0.f, 0.f}, a1[4] = {0.f, 0.f, 0.f, 0.f};
#pragma unroll 4
      for (int mm = 0; mm < 8; ++mm) { const int k = mm * 128 + l16 * 8; f32x4 w[4];
#pragma unroll
          for (int e = 0; e < 4; ++e) w[e] = *(const LAS f32x4*)(Wd + 2 * k + 4 * e);
#pragma unroll
          for (int i = 0; i < 4; ++i) { float f[8]; unpack8(*(const v4u*)(xr + (size_t)i * 32 * DM + mm * 128), f);
#pragma unroll
              for (int e = 0; e < 4; ++e) { a0[i] += f[2 * e] * w[e][0] + f[2 * e + 1] * w[e][2]; a1[i] += f[2 * e] * w[e][1] + f[2 * e + 1] * w[e][3]; } } }
#pragma unroll
      for (int i = 0; i < 4; ++i) {
#pragma unroll
          for (int o = 1; o < 16; o <<= 1) { a0[i] += __shfl_xor(a0[i], o); a1[i] += __shfl_xor(a1[i], o); }
          if (l16 == 0) { const int t = t4 + 32 * i; const f32x4 q4 = *(const f32x4*)(rs + (size_t)(tok0 + t) * 4); const float rst = 1.0f / sqrtf(((q4[0] + q4[1]) + (q4[2] + q4[3])) * (1.0f / DM) + EPS);
              const float d0 = a0[i] * rst, d1 = a1[i] * rst; dtraw[t * 2] = d0; dtraw[t * 2 + 1] = d1; DTg[(size_t)(tok0 + t) * 4 + 2 * g] = d0; DTg[(size_t)(tok0 + t) * 4 + 2 * g + 1] = d1; } }
      __syncthreads();
      ssd_dt(a, L, g, tok0, lds, tid, dtraw); }
    { const int cg = tid & 15, t0 = (tid >> 4) * 4, tpos0 = c * 128 + t0, ch = cg * 8, hh = cg >> 3; const bf16* rowp = PROJ + (size_t)(tok0 + t0) * PP;
      const float* cwb = a->in[I_CONVW] + (size_t)L * 768 * 4; const float* cbb = a->in[I_CONVB] + L * 768;
      float o[4][8];
      conv_apply(rawx, cwb + (g * 128 + ch) * 4, cbb + g * 128 + ch, o);
      float wg[4]; const float aend = acs[127 * 2 + hh];
#pragma unroll
      for (int k = 0; k < 4; ++k) wg[k] = dtv[(t0 + k) * 2 + hh] * __expf(aend - acs[(t0 + k) * 2 + hh]);
#pragma unroll
      for (int i = 0; i < 8; ++i) { u32x2 w; w.x = pk2(o[0][i] * wg[0], o[1][i] * wg[1]); w.y = pk2(o[2][i] * wg[2], o[3][i] * wg[3]); *(LAS u32x2*)(XwT + swz136(ch + i, t0)) = w; }
      conv_apply(rawb, cwb + (256 + g * 128 + ch) * 4, cbb + 256 + g * 128 + ch, o);
#pragma unroll
      for (int i = 0; i < 8; ++i) { u32x2 w; w.x = pk2(o[0][i], o[1][i]); w.y = pk2(o[2][i], o[3][i]); *(LAS u32x2*)(BT + swz136(ch + i, t0)) = w; } }
    __syncthreads();
    { const int rt = wave >> 1, r = lane & 31, lh = lane >> 5, hh = rt >> 1, h = 2 * g + hh;
#pragma unroll
      for (int q = 0; q < 2; ++q) { const int ct = (wave & 1) * 2 + q; f32x16 acc = {}; acc = mma_tile_sw<true, true>(XwT, rt * 32, BT, ct * 32, 128, acc, r, lh);
#pragma unroll
          for (int reg = 0; reg < 16; ++reg) { const int p = (rt & 1) * 32 + crow(reg, lh); ST[((size_t)((b * 16 + c) * 4 + h) * 64 + p) * 128 + ct * 32 + r] = f2b(acc[reg]); } } }
    if (tid < 2) CD[(b * 16 + c) * 4 + 2 * g + tid] = __expf(acs[127 * 2 + tid]);
    __syncthreads();
}
DI void ssd_pass2(KA a, int L, int b, int c, int g, LAS unsigned char* lds, int tid, int wave, int lane) {
    OPQ(lane); OPQ(tid);
    LAS bf16* Cm = (LAS bf16*)lds; LAS bf16* Bm = (LAS bf16*)(lds + 34816); LAS bf16* XT = (LAS bf16*)(lds + 69632); LAS bf16* PV = (LAS bf16*)(lds + 104448);
    LAS float* dtv = (LAS float*)(lds + SSD_DT); LAS float* acs = (LAS float*)(lds + SSD_ACS);
    const bf16* PROJ = (const bf16*)(a->ws + WS_PROJ); const bf16* ST = (const bf16*)(a->ws + WS_ST); const float* CD = (const float*)(a->ws + WS_CD); bf16* MIX = (bf16*)(a->ws + WS_MIX);
    const int tok0 = b * SEQ + c * 128, r = lane & 31, lh = lane >> 5;
    v4u rawx[7], rawb[7], rawc[7];
    { const int cg = tid & 15, t0 = (tid >> 4) * 4; const bf16* rowp = PROJ + (size_t)(tok0 + t0) * PP + g * 128 + cg * 8; conv_load(rowp + C_XS, c * 128 + t0, rawx); conv_load(rowp + C_B, c * 128 + t0, rawb); conv_load(rowp + C_C, c * 128 + t0, rawc); }
    ssd_dt(a, L, g, tok0, lds, tid, nullptr);
    { const int cg = tid & 15, t0 = (tid >> 4) * 4, tpos0 = c * 128 + t0, ch = cg * 8; const bf16* rowp = PROJ + (size_t)(tok0 + t0) * PP;
      const float* cwb = a->in[I_CONVW] + (size_t)L * 768 * 4; const float* cbb = a->in[I_CONVB] + L * 768;
      float o[4][8];
      conv_apply(rawx, cwb + (g * 128 + ch) * 4, cbb + g * 128 + ch, o);
#pragma unroll
      for (int i = 0; i < 8; ++i) { u32x2 w; w.x = pk2(o[0][i], o[1][i]); w.y = pk2(o[2][i], o[3][i]); *(LAS u32x2*)(XT + swz136(ch + i, t0)) = w; }
      conv_apply(rawb, cwb + (256 + g * 128 + ch) * 4, cbb + 256 + g * 128 + ch, o);
#pragma unroll
      for (int k = 0; k < 4; ++k) *(LAS v4u*)(Bm + (t0 + k) * 136 + ch) = pack8(o[k]);
      conv_apply(rawc, cwb + (512 + g * 128 + ch) * 4, cbb + 512 + g * 128 + ch, o);
#pragma unroll
      for (int k = 0; k < 4; ++k) *(LAS v4u*)(Cm + (t0 + k) * 136 + ch) = pack8(o[k]); }
    {
      float pv[4][8];
#pragma unroll
      for (int i = 0; i < 4; ++i)
#pragma unroll
          for (int e = 0; e < 8; ++e) pv[i][e] = 0.f;
      const v4u* sp = (const v4u*)(ST + (size_t)((b * 16) * 4 + 2 * g) * 64 * 128) + tid; constexpr size_t cstride = (size_t)4 * 64 * 128 / 8;
      float w0 = 1.f, w1 = 1.f;
      for (int jt = c - 1; jt >= 0; jt -= 8) {
          v4u ld[8][4];
#pragma unroll
          for (int u = 0; u < 8; ++u) { const int jc = (jt - u >= 0) ? jt - u : 0;
#pragma unroll
              for (int i = 0; i < 4; ++i) ld[u][i] = sp[(size_t)jc * cstride + i * 512]; }
#pragma unroll
          for (int u = 0; u < 8; ++u) { const int jj = jt - u; const bool ok = jj >= 0; const float ww0 = ok ? w0 : 0.f, ww1 = ok ? w1 : 0.f;
#pragma unroll
              for (int i = 0; i < 4; ++i) { float f[8]; unpack8(ld[u][i], f); const float ww = i < 2 ? ww0 : ww1;
#pragma unroll
                  for (int e = 0; e < 8; ++e) pv[i][e] += ww * f[e]; }
              if (ok) { w0 *= CD[(b * 16 + jj) * 4 + 2 * g]; w1 *= CD[(b * 16 + jj) * 4 + 2 * g + 1]; } } }
#pragma unroll
      for (int i = 0; i < 4; ++i) *(LAS v4u*)(PV + (i * 32 + (tid >> 4)) * 136 + (tid & 15) * 8) = pack8(pv[i]); }
    __syncthreads();
    const int lt = wave >> 1, pt = wave & 1;
    f32x16 cb[2];
#pragma unroll
    for (int q = 0; q < 2; ++q) { const int st = (wave & 1) * 2 + q; cb[q] = (f32x16){}; if (st <= lt) cb[q] = mma_tile(Cm + lt * 32 * 136, 136, Bm + st * 32 * 136, 136, 128, cb[q], r, lh); }
    f32x16 y[2];
#pragma unroll
    for (int hh = 0; hh < 2; ++hh) {
        __syncthreads();
#pragma unroll
        for (int q = 0; q < 2; ++q) { const int s = ((wave & 1) * 2 + q) * 32 + r; const float as = acs[s * 2 + hh], ds = dtv[s * 2 + hh];
#pragma unroll
            for (int reg = 0; reg < 16; ++reg) { const int l = lt * 32 + crow(reg, lh); const float val = (s <= l) ? cb[q][reg] * __expf(acs[l * 2 + hh] - as) * ds : 0.f; Bm[l * 136 + s] = f2b(val); } }
        __syncthreads();
        f32x16 a1 = {}, a2 = {};
        a1 = mma_tile_sw<false, true>(Bm, lt * 32, XT, hh * 64 + pt * 32, 32 * (lt + 1), a1, r, lh);
        a2 = mma_tile(Cm + lt * 32 * 136, 136, PV + (hh * 64 + pt * 32) * 136, 136, 128, a2, r, lh);
        const int ch = hh * 64 + pt * 32 + r; const float Dh = a->in[I_SSMD][L * 4 + 2 * g + hh];
#pragma unroll
        for (int reg = 0; reg < 16; ++reg) { const int l = lt * 32 + crow(reg, lh); const float xsv = bf2f(XT[swz136(ch, l)]); const float zz = bf2f(PROJ[(size_t)(tok0 + l) * PP + C_Z + g * 128 + ch]);
            const float yv = a1[reg] + __expf(acs[l * 2 + hh]) * a2[reg] + Dh * xsv; y[hh][reg] = yv * silu_f(zz); }
    }
    __syncthreads();
    LAS float* ybuf = (LAS float*)lds;
#pragma unroll
    for (int hh = 0; hh < 2; ++hh)
#pragma unroll
        for (int reg = 0; reg < 16; ++reg) { const int l = lt * 32 + crow(reg, lh); ybuf[l * 129 + hh * 64 + pt * 32 + r] = y[hh][reg]; }
    __syncthreads();
    { const int t = tid >> 2, ch0 = (tid & 3) * 32; float v[32]; float ss = 0.f;
#pragma unroll
      for (int i = 0; i < 32; ++i) { v[i] = ybuf[t * 129 + ch0 + i]; ss += v[i] * v[i]; }
      ss += __shfl_xor(ss, 1); ss += __shfl_xor(ss, 2);
      const float rstd = 1.0f / sqrtf(ss * (1.0f / 128.0f) + EPS); const float* nw = a->in[I_SSMNW] + L * 256 + g * 128 + ch0;
#pragma unroll
      for (int i = 0; i < 32; ++i) v[i] = v[i] * rstd * nw[i];
      bf16* op = MIX + (size_t)(tok0 + t) * DM + 256 + g * 128 + ch0;
#pragma unroll
      for (int i = 0; i < 4; ++i) *(v4u*)(op + 8 * i) = pack8(v + 8 * i); }
    __syncthreads();
}
typedef float f32x2_t __attribute__((ext_vector_type(2))); typedef __bf16 bf16x2_t __attribute__((ext_vector_type(2)));
DI unsigned cvtpk(float lo, float hi) { f32x2_t v = {lo, hi}; bf16x2_t b = __builtin_convertvector(v, bf16x2_t); return __builtin_bit_cast(unsigned, b); }
DI float xhalf_sum(float v) { auto rr = __builtin_amdgcn_permlane32_swap(__float_as_uint(v), __float_as_uint(v), false, false); return __uint_as_float(rr[0]) + __uint_as_float(rr[1]); }
DI float xhalf_max(float v) { auto rr = __builtin_amdgcn_permlane32_swap(__float_as_uint(v), __float_as_uint(v), false, false); return fmaxf(__uint_as_float(rr[0]), __uint_as_float(rr[1])); }
constexpr int ATT_TPS = 4;
constexpr int ATT_KP = 144, ATT_VP = 64 * ATT_TPS + 8, ATT_VOFF = 32 * ATT_TPS * ATT_KP, ATT_BUF = ATT_VOFF + 64 * ATT_VP;
DI void attn_block(KA a, int L, int b, int h, int s8, LAS unsigned char* lds, int tid, int wave, int lane) {
    OPQ(lane); OPQ(tid);
    const bf16* PROJ = (const bf16*)(a->ws + WS_PROJ); const bf16* VT = (const bf16*)(a->ws + WS_VT); bf16* MIX = (bf16*)(a->ws + WS_MIX);
    const int r = lane & 31, lh = lane >> 5; const size_t tokb = (size_t)b * SEQ;
    const int cw = wave >> 2, jS = s8 * 4 + (wave & 3), jL = 63 - jS, st0 = (63 - s8 * 4) / ATT_TPS;
    float p1 = 0.f, p2 = 0.f;
#pragma unroll 8
    for (int i = 0; i < 32; ++i) { p1 += a->in[I_LQ1][L * 32 + i] * a->in[I_LK1][L * 32 + i]; p2 += a->in[I_LQ2][L * 32 + i] * a->in[I_LK2][L * 32 + i]; }
    const float lam_init = (L == 0) ? 0.2f : 0.35550906f;
    const float lam = __expf(p1) - __expf(p2) + lam_init;
    const float slope2 = exp2f(-2.0f * (float)(h + 1)) * LOG2E, tstep = 32.f * slope2;
    const bf16* gk = PROJ + (tokb + (tid >> 3)) * PP + C_K + h * 64 + (tid & 7) * 8;
    const bf16* gv = VT + (size_t)(h * 64 + (tid >> 4)) * M + tokb + (tid & 15) * 8;
    const int lk = (tid >> 3) * ATT_KP + (tid & 7) * 16, lv = ATT_VOFF + (tid >> 4) * ATT_VP + (tid & 15) * 16;
    v4u sk[ATT_TPS / 2], sv[ATT_TPS / 2];
#define ATT_GLOAD(st_) do { _Pragma("unroll") for (int i_ = 0; i_ < ATT_TPS / 2; ++i_) { sk[i_] = *(const v4u*)(gk + ((size_t)(st_) * 32 * ATT_TPS + 64 * i_) * PP); sv[i_] = *(const v4u*)(gv + (size_t)32 * i_ * M + (st_) * 32 * ATT_TPS); } } while (0)
#define ATT_STORE(buf_) do { LAS unsigned char* d_ = lds + (buf_) * ATT_BUF; _Pragma("unroll") for (int i_ = 0; i_ < ATT_TPS / 2; ++i_) { *(LAS v4u*)(d_ + lk + 64 * i_ * ATT_KP) = sk[i_]; \
        *(LAS u32x2*)(d_ + lv + 32 * i_ * ATT_VP) = (u32x2){sv[i_].x, sv[i_].y}; *(LAS u32x2*)(d_ + lv + 32 * i_ * ATT_VP + 8) = (u32x2){sv[i_].z, sv[i_].w}; } } while (0)
    bf16x8 qf[2][2];
#pragma unroll
    for (int jb = 0; jb < 2; ++jb) { const bf16* qp = PROJ + (tokb + (jb == 0 ? jL : jS) * 32 + r) * PP + C_Q + h * 64 + cw * 32 + 8 * lh;
#pragma unroll
        for (int s = 0; s < 2; ++s) qf[jb][s] = *(const bf16x8*)(qp + s * 16); }
    f32x16 cinit;
#pragma unroll
    for (int reg = 0; reg < 16; ++reg) cinit[reg] = slope2 * (float)crow(reg, lh);
    f32x16 o[2][2];
#pragma unroll
    for (int jb = 0; jb < 2; ++jb)
#pragma unroll
        for (int d = 0; d < 2; ++d) o[jb][d] = (f32x16){};
    float kwmax = 0.f;
#pragma unroll 8
    for (int i = 0; i < 32; ++i) kwmax = fmaxf(kwmax, fabsf(a->in[I_KNW][L * 32 + i]));
    const float knorm = 5.65685425f * 1.01f * kwmax;
    float mref[2], lrun[2] = {0.f, 0.f};
#pragma unroll
    for (int jb = 0; jb < 2; ++jb) { float qs = 0.f;
#pragma unroll
        for (int s2 = 0; s2 < 2; ++s2)
#pragma unroll
            for (int e = 0; e < 8; ++e) { const float qv = bf2f((bf16)qf[jb][s2][e]); qs += qv * qv; }
        qs = xhalf_sum(qs); mref[jb] = sqrtf(qs) * knorm + 31.f * slope2; }
    ATT_GLOAD(st0);
    ATT_STORE(0);
    __syncthreads();
    int cur = 0;
    const int koff = r * ATT_KP + 16 * lh + cw * 64, voff = ATT_VOFF + r * ATT_VP + 8 * lh;
    for (int st = st0; st >= 0; --st) {
        if (st > 0) ATT_GLOAD(st - 1);
#pragma unroll 1
        for (int tl = ATT_TPS - 1; tl >= 0; --tl) {
            const int kt = st * ATT_TPS + tl;
            int act = (kt <= jL) ? 1 : 0; asm volatile("" : "+v"(act)); act = __builtin_amdgcn_readfirstlane(act);
            if (act) {
                const LAS unsigned char* kb = lds + cur * ATT_BUF + koff + tl * 32 * ATT_KP; const LAS unsigned char* vb = lds + cur * ATT_BUF + voff + tl * 64;
                const bf16x8 k0 = *(const LAS bf16x8*)kb, k1 = *(const LAS bf16x8*)(kb + 32);
                u32x2 vlo[2][2], vhi[2][2];
#pragma unroll
                for (int d = 0; d < 2; ++d)
#pragma unroll
                    for (int s = 0; s < 2; ++s) { vlo[d][s] = *(const LAS u32x2*)(vb + d * 32 * ATT_VP + 32 * s); vhi[d][s] = *(const LAS u32x2*)(vb + d * 32 * ATT_VP + 32 * s + 16); }
#pragma unroll
                for (int jb = 0; jb < 2; ++jb) {
                    const int jq = (jb == 0) ? jL : jS;
                    int on = (kt <= jq) ? 1 : 0; asm volatile("" : "+v"(on)); on = __builtin_amdgcn_readfirstlane(on);
                    if (on) {
                        int isdiag = (kt == jq) ? 1 : 0; asm volatile("" : "+v"(isdiag)); isdiag = __builtin_amdgcn_readfirstlane(isdiag);
                        f32x16 S = MFMA32(k0, qf[jb][0], cinit); S = MFMA32(k1, qf[jb][1], S);
                        if (isdiag) {
#pragma unroll
                            for (int reg = 0; reg < 16; ++reg) S[reg] = crow(reg, lh) > r ? -INFINITY : S[reg];
                        }
                        const float sh = tstep * (float)(kt - jq) - mref[jb];
                        float rs4[4] = {0.f, 0.f, 0.f, 0.f};
#pragma unroll
                        for (int reg = 0; reg < 16; ++reg) { S[reg] = __builtin_amdgcn_exp2f(S[reg] + sh); rs4[reg & 3] += S[reg]; }
                        lrun[jb] += (rs4[0] + rs4[1]) + (rs4[2] + rs4[3]);
                        u32x4 w0, w1;
                        w0.x = cvtpk(S[0], S[1]); w0.y = cvtpk(S[2], S[3]); w0.z = cvtpk(S[4], S[5]); w0.w = cvtpk(S[6], S[7]);
                        w1.x = cvtpk(S[8], S[9]); w1.y = cvtpk(S[10], S[11]); w1.z = cvtpk(S[12], S[13]); w1.w = cvtpk(S[14], S[15]);
                        const bf16x8 pb0 = __builtin_bit_cast(bf16x8, w0), pb1 = __builtin_bit_cast(bf16x8, w1);
#pragma unroll
                        for (int d = 0; d < 2; ++d) {
                            const u32x4 v0 = (u32x4){vlo[d][0].x, vlo[d][0].y, vhi[d][0].x, vhi[d][0].y}, v1 = (u32x4){vlo[d][1].x, vlo[d][1].y, vhi[d][1].x, vhi[d][1].y};
                            o[jb][d] = MFMA32(__builtin_bit_cast(bf16x8, v0), pb0, o[jb][d]);
                            o[jb][d] = MFMA32(__builtin_bit_cast(bf16x8, v1), pb1, o[jb][d]);
                        }
                    }
                }
            }
        }
        if (st > 0) ATT_STORE(cur ^ 1);
        __syncthreads();
        cur ^= 1;
    }
#undef ATT_GLOAD
#undef ATT_STORE
    lrun[0] = xhalf_sum(lrun[0]); lrun[1] = xhalf_sum(lrun[1]);
    const int give = (cw == 0) ? 1 : 0, keep = 1 - give;
    LAS float* xw = (LAS float*)lds + (size_t)wave * 2048;
    LAS const float* xr = (LAS const float*)lds + (size_t)(wave ^ 4) * 2048;
    { const float sc = (cw == 0 ? 1.0f : lam) / (give == 0 ? lrun[0] : lrun[1]);
#pragma unroll
      for (int d = 0; d < 2; ++d)
#pragma unroll
          for (int reg = 0; reg < 16; ++reg) xw[(d * 16 + reg) * 64 + lane] = (give == 0 ? o[0][d][reg] : o[1][d][reg]) * sc; }
    __syncthreads();
    { const float sck = (cw == 0 ? 1.0f : lam) / (keep == 0 ? lrun[0] : lrun[1]); const float sgn = (cw == 0) ? 1.0f : -1.0f;
      f32x16 v[2]; float ss = 0.f;
#pragma unroll
      for (int d = 0; d < 2; ++d)
#pragma unroll
          for (int reg = 0; reg < 16; ++reg) { const float mine = (keep == 0 ? o[0][d][reg] : o[1][d][reg]) * sck, other = xr[(d * 16 + reg) * 64 + lane]; const float val = sgn * (mine - other); v[d][reg] = val; ss += val * val; }
      ss = xhalf_sum(ss);
      const float rstd = (1.0f - lam_init) / sqrtf(ss * (1.0f / 64.0f) + EPS);
      const int jq = (keep == 0) ? jL : jS;
      bf16* op = MIX + (tokb + jq * 32 + r) * DM + 768 + h * 64;
#pragma unroll
      for (int d = 0; d < 2; ++d)
#pragma unroll
          for (int g4 = 0; g4 < 4; ++g4) { const int d0 = d * 32 + 8 * g4 + 4 * lh; const f32x4 w4 = *(const f32x4*)(a->in[I_SUBLN] + L * 64 + d0);
              u32x2 pk; pk.x = cvtpk(v[d][4 * g4] * rstd * w4.x, v[d][4 * g4 + 1] * rstd * w4.y); pk.y = cvtpk(v[d][4 * g4 + 2] * rstd * w4.z, v[d][4 * g4 + 3] * rstd * w4.w);
              *(u32x2*)(op + d0) = pk; } }
    __syncthreads();
}

#ifndef DIS_SSD1
#define DIS_SSD1 0
#endif
#ifndef DIS_SSD2
#define DIS_SSD2 0
#endif
#ifndef DIS_GMLP
#define DIS_GMLP 0
#endif
#ifndef DIS_POOL
#define DIS_POOL 0
#endif
#ifndef DIS_ATTN
#define DIS_ATTN 0
#endif
#ifndef DIS_GEMM
#define DIS_GEMM 0
#endif
#ifndef REP_P0
#define REP_P0 1
#endif
#ifndef REP_M1
#define REP_M1 1
#endif
#ifndef REP_SSD2
#define REP_SSD2 1
#endif
#ifndef REP_ATTN
#define REP_ATTN 1
#endif
#ifndef REP_N2
#define REP_N2 1
#endif
#ifndef REP_BAR
#define REP_BAR 1
#endif
#ifndef REP_G1
#define REP_G1 1
#endif
#ifndef REP_G3
#define REP_G3 1
#endif
#ifndef MK_SPLIT
#define MK_SPLIT 0
#endif
constexpr int N_PHASES = 13;
__global__ void __launch_bounds__(NWAVES * 64, 2) hybrid_fwd(Args args) {
    extern __shared__ __attribute__((aligned(16))) unsigned char lds_raw[];
    LAS unsigned char* lds = (LAS unsigned char*)lds_raw;
    const int tid = threadIdx.x, lane = tid & 63, wave = __builtin_amdgcn_readfirstlane(tid >> 6);
    const int G = gridDim.x; const int bx = blockIdx.x; const int vcu = (G % 8 == 0) ? (bx % 8) * (G / 8) + bx / 8 : bx;
    for (int u = tid; u < (LDS_BYTES - LDSCTL_OFF) / 4; u += NWAVES * 64) ((LAS unsigned*)(lds + LDSCTL_OFF))[u] = 0u;
    __syncthreads();
    int lo, hi;
    XcdBarrier bar;
    { KA ka = kargs(); lo = ka->ph_lo; hi = ka->ph_hi; gu32* ctl = (gu32*)(ka->ws + WS_CTL);
      bar.bar = (unsigned*)(ctl + CW_BAR); bar.x = 0; bar.st = nullptr;
      if (!MK_SPLIT) bar = xcd_barrier_post((unsigned*)(ctl + CW_BAR), (volatile LAS unsigned*)(lds + MISC_OFF) + 8); }
#define IN(k) (lo <= (k) && (k) < hi)
#define SEAM(k) do { if (IN(k) && IN((k) + 1)) for (int rb_ = 0; rb_ < REP_BAR; ++rb_) xcd_barrier(bar); } while (0)
    if (IN(0)) { KA ka = kargs(); for (int rep = 0; rep < REP_P0; ++rep) { weights_phase(ka, lds, 0, 0, WI_INP, vcu * NWAVES + wave, G * NWAVES, wave, lane); __syncthreads(); }
        prep_phase(ka->in[I_X], (bf16*)(ka->ws + WS_XN), (float*)(ka->ws + WS_RS), vcu, G, wave, lane); }
    SEAM(0);
#pragma unroll 1
    for (int L = 0; L < DEPTH; ++L) {
        const int pb = 1 + 6 * L;
        if (IN(pb)) { KA ka = kargs(); unsigned char* ws = ka->ws; const bf16* wb = (const bf16*)(ws + WS_W + (size_t)L * W_LAYER + W_IN); const bf16* XB = (const bf16*)(ws + WS_XN);
            const float* rs = (const float*)(ws + WS_RS) + (size_t)(2 * L) * RS_STRIDE;
            for (int rep = 0; rep < REP_G1; ++rep) {
            { pg8::Gemm g{XB, wb, M, PP, DM}; pg8::StaticOrder S; S.init(M, PP, G, bx);
              pg8::EpiInProj E{(bf16*)(ws + WS_PROJ), ka->in[I_QNW] + L * 32, ka->in[I_KNW] + L * 32, rs};
              pg8::gemm_phase<pg8::EpiInProj, pg8::StaticOrder, true, true>(lds, g, S, E); }
            { pg8::Gemm g{wb + (size_t)PP * DM, XB, 256, M, DM}; pg8::StaticOrder S; S.init(256, M, G, (bx + 192) % G);
              pg8::EpiVT E{(bf16*)(ws + WS_VT), rs};
              pg8::gemm_phase<pg8::EpiVT, pg8::StaticOrder, true, true>(lds, g, S, E); }
            }
            { const int nidle = G - G / 2; if (bx >= G / 2) weights_phase(ka, lds, L, WI_INP, WI_INP + WI_OUT + 2 * WI_G, (bx - G / 2) * NWAVES + wave, nidle * NWAVES, wave, lane); __syncthreads(); }
        }
        SEAM(pb);
        if (IN(pb + 1)) { KA ka = kargs();
            __syncthreads();
            for (int rep = 0; rep < REP_M1; ++rep) {
            if (!DIS_SSD1) for (int it = vcu; it < 256; it += G) ssd_pass1(ka, L, it >> 5, (it >> 1) & 15, it & 1, lds, tid, wave, lane);
            if (!DIS_GMLP) for (int it = vcu; it < 512; it += 2 * G) { if (it + G < 512) gmlp_pair(ka, L, it, it + G, lds, tid, wave, lane); else gmlp_item(ka, L, it >> 6, (it >> 2) & 15, it & 3, lds, tid, wave, lane); }
            if (!DIS_POOL) for (int it = vcu; it < 512; it += 2 * G) { if (it + G < 512) pool_pair(ka, L, it, it + G, lds, tid, wave, lane); else pool_item(ka, L, it >> 6, (it >> 2) & 15, it & 3, lds, tid, wave, lane); }
            }
        }
        SEAM(pb + 1);
        if (IN(pb + 2)) { KA ka = kargs();
            __syncthreads();
            for (int rep = 0; rep < REP_SSD2; ++rep)
            if (!DIS_SSD2) for (int it = vcu; it < 256; it += G) ssd_pass2(ka, L, it >> 5, (it >> 1) & 15, it & 1, lds, tid, wave, lane);
            for (int rep = 0; rep < REP_ATTN; ++rep)
            if (!DIS_ATTN) for (int it = vcu; it < 256; it += G) attn_block(ka, L, it >> 5, (it >> 3) & 3, it & 7, lds, tid, wave, lane);
        }
        SEAM(pb + 2);
        if (IN(pb + 3)) { KA ka = kargs(); unsigned char* ws = ka->ws;
            pg8::Gemm g{(const bf16*)(ws + WS_MIX), (const bf16*)(ws + WS_W + (size_t)L * W_LAYER + W_OUT), M, DM, DM}; pg8::StaticOrder S; S.init(M, DM, G, bx);
            pg8::EpiResid E{(const float*)nullptr, (const bf16*)(ws + WS_XN), (float*)nullptr, (bf16*)(ws + WS_XN), (float*)(ws + WS_RS) + (size_t)(2 * L + 1) * RS_STRIDE};
            pg8::gemm_phase<pg8::EpiResid, pg8::StaticOrder, true, true>(lds, g, S, E); }
        SEAM(pb + 3);
        if (IN(pb + 4)) for (int rep = 0; rep < REP_G3; ++rep) { KA ka = kargs(); unsigned char* ws = ka->ws;
            pg8::Gemm g{(const bf16*)(ws + WS_XN), (const bf16*)(ws + WS_W + (size_t)L * W_LAYER + W_GU), M, NGU, DM}; pg8::StaticOrder S; S.init(M, NGU, G, bx);
            pg8::EpiSwiGLU E{(bf16*)(ws + WS_H), (const float*)(ws + WS_RS) + (size_t)(2 * L + 1) * RS_STRIDE};
            pg8::gemm_phase<pg8::EpiSwiGLU, pg8::StaticOrder, true, true>(lds, g, S, E);
            { const int nidle = G - G / 2; if (bx >= G / 2) { weights_phase(ka, lds, L, WI_PER_L - WI_D, WI_PER_L, (bx - G / 2) * NWAVES + wave, nidle * NWAVES, wave, lane);
                if (L + 1 < DEPTH) weights_phase(ka, lds, L + 1, 0, WI_INP, (bx - G / 2) * NWAVES + wave, nidle * NWAVES, wave, lane); } __syncthreads(); } }
        SEAM(pb + 4);
        if (IN(pb + 5)) { KA ka = kargs(); unsigned char* ws = ka->ws; const bool more = (L + 1 < DEPTH);
            pg8::Gemm g{(const bf16*)(ws + WS_H), (const bf16*)(ws + WS_W + (size_t)L * W_LAYER + W_DN), M, DM, DFF}; pg8::StaticOrder S; S.init(M, DM, G, bx);
            pg8::EpiResid E{(const float*)nullptr, (const bf16*)(ws + WS_XN), more ? (float*)nullptr : ka->out, more ? (bf16*)(ws + WS_XN) : (bf16*)nullptr, more ? (float*)(ws + WS_RS) + (size_t)(2 * L + 2) * RS_STRIDE : (float*)nullptr};
            pg8::gemm_phase<pg8::EpiResid, pg8::StaticOrder, true, true>(lds, g, S, E); }
        if (L + 1 < DEPTH) SEAM(pb + 5);
    }
#undef IN
#undef SEAM
}

extern "C" void kernel_launch(void* const* d_in, const int* in_sizes, int n_in, void* d_out, int out_size, void* d_ws, size_t ws_size, hipStream_t stream) {
    static int grid = 0;
    if (grid == 0) {
        if (n_in != N_IN || in_sizes[0] != M * DM || out_size != M * DM || ws_size < WS_END) { fprintf(stderr, "kernel_launch: unexpected problem shape (n_in %d, in0 %d, out %d, ws %zu); nothing launched\n", n_in, n_in > 0 ? in_sizes[0] : -1, out_size, ws_size); grid = -1; return; }
        int dev = 0, cus = 0;
        if (hipGetDevice(&dev) != hipSuccess || hipDeviceGetAttribute(&cus, hipDeviceAttributeMultiprocessorCount, dev) != hipSuccess) { grid = -1; return; }
        if (hipFuncSetAttribute((const void*)hybrid_fwd, hipFuncAttributeMaxDynamicSharedMemorySize, LDS_BYTES) != hipSuccess) { fprintf(stderr, "kernel_launch: hipFuncSetAttribute failed\n"); grid = -1; return; }
        int per_cu = 0;
        if (hipOccupancyMaxActiveBlocksPerMultiprocessor(&per_cu, (const void*)hybrid_fwd, NWAVES * 64, LDS_BYTES) != hipSuccess || per_cu < 1) fprintf(stderr, "kernel_launch: occupancy query reports %d\n", per_cu);
        (void)hipGetLastError();
        grid = cus;
    }
    if (grid < 0) return;
    (void)hipMemsetAsync((char*)d_ws + WS_CTL, 0, CTL_ZERO_BYTES, stream);
    Args a{};
    for (int i = 0; i < N_IN; ++i) a.in[i] = (const float*)d_in[i];
    a.out = (float*)d_out; a.ws = (unsigned char*)d_ws;
#if MK_SPLIT
    for (int p = 0; p < N_PHASES; ++p) { a.ph_lo = p; a.ph_hi = p + 1; hipLaunchKernelGGL(hybrid_fwd, dim3(grid), dim3(NWAVES * 64), LDS_BYTES, stream, a); }
#else
    a.ph_lo = 0; a.ph_hi = N_PHASES;
    hipLaunchKernelGGL(hybrid_fwd, dim3(grid), dim3(NWAVES * 64), LDS_BYTES, stream, a);
#endif
}
```
